# Optimizing an MI355X kernel written in HIP

```python
import math
import jax, jax.numpy as jnp
from jax import lax
import numpy as np

D_MODEL = 2048
BATCH = 2
SEQ = 8192
DEPTH = 4

GRID_W = 64
CTX_LEN = 256
EPS = 1e-6
N_SUB = 3
N_MOD = 3 * N_SUB
D_FF = 5632
S5_W = D_MODEL // 2
S5_H = 16
S5_G = S5_W // S5_H
S5_P = 64
S5_DT_MIN = 1e-3
S5_DT_MAX = 1e-1
CONV_W = D_MODEL // 2
CONV_K = 3
MIX_IN = S5_W + 3 * CONV_W
MIX_OUT = S5_W + CONV_W
ATTN_DH = 64
ATTN_H = D_MODEL // (2 * ATTN_DH)
ATTN_VD = 2 * ATTN_DH
ROPE_PAIRS_AXIS = ATTN_DH // 4
ROPE_BASE = 10000.0
Q_BLOCK = 128
N_EVEN = (DEPTH + 1) // 2
N_ODD = DEPTH // 2

kernel_name = 'hybrid_s5_conv_diffattn_dit_block'

F32 = jnp.float32


def rms_norm(x, g):
    xf = x.astype(F32)
    y = xf * lax.rsqrt(jnp.mean(xf * xf, axis=-1, keepdims=True) + EPS)
    return (y * g.astype(F32)).astype(x.dtype)


def ada_params(cvec, w, b):
    m = jnp.dot(jax.nn.silu(cvec), w) + b
    return m.reshape(m.shape[:-1] + (N_MOD, D_MODEL))


def mod_in(x, g, m, s):
    return rms_norm(x, g) * (1.0 + m[:, :, 3 * s + 1]) + m[:, :, 3 * s]


def mod_out(x, y, g, m, s, weight):
    return x + weight * m[:, :, 3 * s + 2] * rms_norm(y, g)


def ffn_sublayer(x, m, s, g_pre, g_post, wg, wu, wd):
    h = mod_in(x, g_pre, m, s)
    y = jnp.dot(jax.nn.silu(jnp.dot(h, wg)) * jnp.dot(h, wu), wd)
    return mod_out(x, y, g_post, m, s, 0.5)


def s5_discretize(lam_re, lam_im, log_step, b_re, b_im):
    lam_re, lam_im = lam_re.astype(F32), lam_im.astype(F32)
    dt = jnp.exp(log_step.astype(F32))[:, None]
    mag = jnp.exp(lam_re * dt)
    a_re, a_im = mag * jnp.cos(lam_im * dt), mag * jnp.sin(lam_im * dt)
    inv = 1.0 / (lam_re * lam_re + lam_im * lam_im)
    co_re = ((a_re - 1.0) * lam_re + a_im * lam_im) * inv
    co_im = (a_im * lam_re - (a_re - 1.0) * lam_im) * inv
    b_re, b_im = b_re.astype(F32), b_im.astype(F32)
    bb_re = co_re[..., None] * b_re - co_im[..., None] * b_im
    bb_im = co_re[..., None] * b_im + co_im[..., None] * b_re
    return a_re, a_im, bb_re, bb_im


def _linrec_combine(e1, e2):
    a1r, a1i, b1r, b1i = e1
    a2r, a2i, b2r, b2i = e2
    return (a1r * a2r - a1i * a2i, a1r * a2i + a1i * a2r,
            a2r * b1r - a2i * b1i + b2r, a2r * b1i + a2i * b1r + b2i)


def s5_scan(a_re, a_im, bu_re, bu_im, h0_re, h0_im, reverse):
    first = bu_re.shape[1] - 1 if reverse else 0
    bu_re = bu_re.at[:, first].add(a_re * h0_re - a_im * h0_im)
    bu_im = bu_im.at[:, first].add(a_re * h0_im + a_im * h0_re)
    shape = (1,) + bu_re.shape[1:]
    ar = jnp.broadcast_to(a_re, shape)
    ai = jnp.broadcast_to(a_im, shape)
    _, _, h_re, h_im = lax.associative_scan(_linrec_combine, (ar, ai, bu_re, bu_im), reverse=reverse, axis=1)
    return h_re, h_im


def s5_readout(y, u, d, w_glu, b_glu):
    z = jax.nn.gelu(y.reshape(u.shape) + d.astype(F32) * u.astype(F32))
    return (z * jax.nn.sigmoid(jnp.dot(z, w_glu.astype(F32)) + b_glu.astype(F32))).astype(u.dtype)


def s5_mix(u_c, u_l, lam_re, lam_im, log_step, b_re, b_im, c_re, c_im, d, w_glu, b_glu, need_ctx):
    def groups(u):
        return u.astype(F32).reshape(u.shape[:2] + (S5_G, S5_H))
    uc, ul = groups(u_c), groups(u_l)
    zeros = jnp.zeros((uc.shape[0], S5_G, S5_P), F32)
    ys_c, ys_l = [], []
    for direction, reverse in ((0, False), (1, True)):
        a_re, a_im, bb_re, bb_im = s5_discretize(lam_re[direction], lam_im[direction], log_step[direction],
                                                 b_re[direction], b_im[direction])
        cr, ci = c_re[direction].astype(F32), c_im[direction].astype(F32)

        def drive(u):
            return jnp.einsum('gph,blgh->blgp', bb_re, u), jnp.einsum('gph,blgh->blgp', bb_im, u)

        def read(h_re, h_im):
            return jnp.einsum('ghp,blgp->blgh', cr, h_re) - jnp.einsum('ghp,blgp->blgh', ci, h_im)

        hc_re, hc_im = s5_scan(a_re, a_im, *drive(uc), zeros, zeros, reverse)
        end = 0 if reverse else -1
        hl_re, hl_im = s5_scan(a_re, a_im, *drive(ul), hc_re[:, end], hc_im[:, end], reverse)
        ys_l.append(read(hl_re, hl_im))
        if need_ctx:
            ys_c.append(read(hc_re, hc_im))
    out_l = s5_readout(ys_l[0] + ys_l[1], u_l, d, w_glu, b_glu)
    out_c = s5_readout(ys_c[0] + ys_c[1], u_c, d, w_glu, b_glu) if need_ctx else None
    return out_c, out_l


def centred_conv(v, w, b):
    n = v.shape[1]
    pad = CONV_K // 2
    vp = jnp.pad(v, ((0, 0), (pad, CONV_K - 1 - pad), (0, 0)))
    return sum(vp[:, j:j + n] * w[j] for j in range(CONV_K)) + b


def even_mixer(h_c, h_l, w_in, w_out, lam_re, lam_im, log_step, b_re, b_im, c_re, c_im, d, w_glu, b_glu,
               conv_w, conv_b, need_ctx):
    def split(h):
        p = jnp.dot(h, w_in)
        bg, cg, v = jnp.split(p[..., S5_W:], 3, axis=-1)
        return p[..., :S5_W], bg, cg, v
    u_c, bg_c, cg_c, v_c = split(h_c)
    u_l, bg_l, cg_l, v_l = split(h_l)
    s5_c, s5_l = s5_mix(u_c, u_l, lam_re, lam_im, log_step, b_re, b_im, c_re, c_im, d, w_glu, b_glu, need_ctx)
    conv_l = bg_l * centred_conv(cg_l * v_l, conv_w, conv_b)
    y_l = jnp.dot(jnp.concatenate([s5_l, conv_l], axis=-1), w_out)
    if not need_ctx:
        return None, y_l
    conv_c = bg_c * centred_conv(cg_c * v_c, conv_w, conv_b)
    y_c = jnp.dot(jnp.concatenate([s5_c, conv_c], axis=-1), w_out)
    return y_c, y_l


def axial_rope_tables(n):
    rows = n // GRID_W
    row = jnp.repeat(jnp.arange(rows), GRID_W).astype(F32)
    col = jnp.tile(jnp.arange(GRID_W), rows).astype(F32)
    freqs = jnp.power(ROPE_BASE, -jnp.arange(ROPE_PAIRS_AXIS, dtype=F32) / ROPE_PAIRS_AXIS)
    ang = jnp.concatenate([row[:, None] * freqs, col[:, None] * freqs], axis=-1)
    return jnp.cos(ang), jnp.sin(ang)


def apply_rope(x, cos, sin):
    half = ATTN_DH // 2
    cos = cos[None, :, None, None, :].astype(x.dtype)
    sin = sin[None, :, None, None, :].astype(x.dtype)
    x1, x2 = x[..., :half], x[..., half:]
    return jnp.concatenate([x1 * cos - x2 * sin, x1 * sin + x2 * cos], axis=-1)


def diff_attend(q, k, v, lam):
    s = jnp.einsum('bqhcd,bkhcd->bhcqk', q.astype(F32), k) * (ATTN_DH ** -0.5)
    p = jax.nn.softmax(s, axis=-1)
    a = p[:, :, 0] - lam * p[:, :, 1]
    return jnp.einsum('bhqk,bkhe->bqhe', a.astype(v.dtype), v)


def diff_attn_mixer(h_c, h_l, w_qkv, w_o, lam_vecs, subln, lam_init, need_ctx):
    bsz, n_lat = h_l.shape[:2]

    def qkv(h):
        n = h.shape[1]
        q, k, v = jnp.split(jnp.dot(h, w_qkv), 3, axis=-1)
        return (q.reshape(bsz, n, ATTN_H, 2, ATTN_DH), k.reshape(bsz, n, ATTN_H, 2, ATTN_DH),
                v.reshape(bsz, n, ATTN_H, ATTN_VD))
    q_c, k_c, v_c = qkv(h_c)
    q_l, k_l, v_l = qkv(h_l)
    cos, sin = axial_rope_tables(n_lat)
    q_l, k_l = apply_rope(q_l, cos, sin), apply_rope(k_l, cos, sin)
    lv = lam_vecs.astype(F32)
    lam = jnp.exp(jnp.sum(lv[0] * lv[1])) - jnp.exp(jnp.sum(lv[2] * lv[3])) + lam_init

    def finish(o):
        o = rms_norm(o, subln) * (1.0 - lam_init)
        return jnp.dot(o.reshape(o.shape[:2] + (D_MODEL,)), w_o)

    k_all = jnp.concatenate([k_c, k_l], axis=1).astype(F32)
    v_all = jnp.concatenate([v_c, v_l], axis=1)
    n_blk = n_lat // Q_BLOCK
    qb = q_l.reshape(bsz, n_blk, Q_BLOCK, ATTN_H, 2, ATTN_DH).swapaxes(0, 1)
    o_l = lax.map(lambda qq: diff_attend(qq, k_all, v_all, lam), qb)
    o_l = o_l.swapaxes(0, 1).reshape(bsz, n_lat, ATTN_H, ATTN_VD)
    y_l = finish(o_l)
    if not need_ctx:
        return None, y_l
    y_c = finish(diff_attend(q_c, k_c.astype(F32), v_c, lam))
    return y_c, y_l


def setup_inputs(seed: int = 0) -> dict:
    key = jax.random.key(seed)
    ks = jax.random.split(key, 32)
    nrm = jax.random.normal
    lam_im = jnp.broadcast_to(jnp.pi * jnp.arange(S5_P, dtype=F32), (N_EVEN, 2, S5_G, S5_P))
    return {
        'x': nrm(ks[0], (BATCH, SEQ, D_MODEL), F32),
        'c': nrm(ks[1], (BATCH, D_MODEL), F32),
        'ctx': nrm(ks[2], (BATCH, CTX_LEN, D_MODEL), F32),
        'c_ctx': nrm(ks[3], (D_MODEL,), F32),
        'w_mod': nrm(ks[4], (DEPTH, D_MODEL, N_MOD * D_MODEL), F32) * (0.5 * D_MODEL ** -0.5),
        'b_mod': nrm(ks[5], (DEPTH, N_MOD * D_MODEL), F32) * 0.02,
        'norm_g': 1.0 + 0.02 * nrm(ks[6], (DEPTH, 2 * N_SUB, D_MODEL), F32),
        'ffn_wg': nrm(ks[7], (DEPTH, 2, D_MODEL, D_FF), F32) * D_MODEL ** -0.5,
        'ffn_wu': nrm(ks[8], (DEPTH, 2, D_MODEL, D_FF), F32) * D_MODEL ** -0.5,
        'ffn_wd': nrm(ks[9], (DEPTH, 2, D_FF, D_MODEL), F32) * D_FF ** -0.5,
        'mix_w_in': nrm(ks[10], (N_EVEN, D_MODEL, MIX_IN), F32) * D_MODEL ** -0.5,
        'mix_w_out': nrm(ks[11], (N_EVEN, MIX_OUT, D_MODEL), F32) * MIX_OUT ** -0.5,
        's5_lam_re': -0.5 + 0.01 * nrm(ks[12], (N_EVEN, 2, S5_G, S5_P), F32),
        's5_lam_im': lam_im + 0.01 * nrm(ks[13], (N_EVEN, 2, S5_G, S5_P), F32),
        's5_log_step': jax.random.uniform(ks[14], (N_EVEN, 2, S5_G), F32,
                                          minval=math.log(S5_DT_MIN), maxval=math.log(S5_DT_MAX)),
        's5_b_re': nrm(ks[15], (N_EVEN, 2, S5_G, S5_P, S5_H), F32) * (2 * S5_H) ** -0.5,
        's5_b_im': nrm(ks[16], (N_EVEN, 2, S5_G, S5_P, S5_H), F32) * (2 * S5_H) ** -0.5,
        's5_c_re': nrm(ks[17], (N_EVEN, 2, S5_G, S5_H, S5_P), F32) * S5_P ** -0.5,
        's5_c_im': nrm(ks[18], (N_EVEN, 2, S5_G, S5_H, S5_P), F32) * S5_P ** -0.5,
        's5_d': nrm(ks[19], (N_EVEN, S5_W), F32) * 0.3,
        's5_w_glu': nrm(ks[20], (N_EVEN, S5_W, S5_W), F32) * S5_W ** -0.5,
        's5_b_glu': nrm(ks[21], (N_EVEN, S5_W), F32) * 0.02,
        'conv_w': nrm(ks[22], (N_EVEN, CONV_K, CONV_W), F32) * CONV_K ** -0.5,
        'conv_b': nrm(ks[23], (N_EVEN, CONV_W), F32) * 0.02,
        'attn_w_qkv': nrm(ks[24], (N_ODD, D_MODEL, 3 * D_MODEL), F32) * D_MODEL ** -0.5,
        'attn_w_o': nrm(ks[25], (N_ODD, D_MODEL, D_MODEL), F32) * D_MODEL ** -0.5,
        'attn_lambda': nrm(ks[26], (N_ODD, 4, ATTN_DH), F32) * 0.1,
        'attn_subln': 1.0 + 0.02 * nrm(ks[27], (N_ODD, ATTN_VD), F32),
    }


def reference(x, c, ctx, c_ctx, w_mod, b_mod, norm_g, ffn_wg, ffn_wu, ffn_wd, mix_w_in, mix_w_out,
              s5_lam_re, s5_lam_im, s5_log_step, s5_b_re, s5_b_im, s5_c_re, s5_c_im, s5_d, s5_w_glu, s5_b_glu,
              conv_w, conv_b, attn_w_qkv, attn_w_o, attn_lambda, attn_subln):
    for layer in range(DEPTH):
        need_ctx = layer < DEPTH - 1
        m_l = ada_params(c, w_mod[layer], b_mod[layer])[:, None]
        m_c = ada_params(c_ctx, w_mod[layer], b_mod[layer])[None, None]
        g = norm_g[layer]
        x = ffn_sublayer(x, m_l, 0, g[0], g[1], ffn_wg[layer, 0], ffn_wu[layer, 0], ffn_wd[layer, 0])
        ctx = ffn_sublayer(ctx, m_c, 0, g[0], g[1], ffn_wg[layer, 0], ffn_wu[layer, 0], ffn_wd[layer, 0])
        h_l = mod_in(x, g[2], m_l, 1)
        h_c = mod_in(ctx, g[2], m_c, 1)
        i = layer // 2
        if layer % 2 == 0:
            y_c, y_l = even_mixer(h_c, h_l, mix_w_in[i], mix_w_out[i], s5_lam_re[i], s5_lam_im[i], s5_log_step[i],
                                  s5_b_re[i], s5_b_im[i], s5_c_re[i], s5_c_im[i], s5_d[i], s5_w_glu[i], s5_b_glu[i],
                                  conv_w[i], conv_b[i], need_ctx)
        else:
            lam_init = 0.8 - 0.6 * math.exp(-0.3 * layer)
            y_c, y_l = diff_attn_mixer(h_c, h_l, attn_w_qkv[i], attn_w_o[i], attn_lambda[i], attn_subln[i],
                                       lam_init, need_ctx)
        x = mod_out(x, y_l, g[3], m_l, 1, 1.0)
        x = ffn_sublayer(x, m_l, 2, g[4], g[5], ffn_wg[layer, 1], ffn_wu[layer, 1], ffn_wd[layer, 1])
        if need_ctx:
            ctx = mod_out(ctx, y_c, g[3], m_c, 1, 1.0)
            ctx = ffn_sublayer(ctx, m_c, 2, g[4], g[5], ffn_wg[layer, 1], ffn_wu[layer, 1], ffn_wd[layer, 1])
    return x
```

```cpp
#include <hip/hip_runtime.h>
#include <cstdio>
#include <cstdint>
#include <cmath>
namespace pg8 {
#define PG8_LAS __attribute__((address_space(3)))
typedef unsigned short bf16_t;
typedef short bf16x8 __attribute__((ext_vector_type(8)));
typedef float f32x4 __attribute__((ext_vector_type(4)));
typedef unsigned u32x4 __attribute__((ext_vector_type(4)));
constexpr int BM = 256, BK = 64, HALF = 128, HTB = HALF * BK * 2  , STAGE_BYTES = 8 * HTB, NXCD = 8, WGM = 4;

__host__ __device__ __forceinline__ int lds_byte(int r, int c) { const int st = (r >> 4) * 2 + (c >> 5), rr = r & 15, cc = c & 31, ob = rr * 64 + cc * 2; return st * 1024 + (ob ^ (((ob >> 9) & 1) << 5)); }
__host__ __device__ __forceinline__ void stage_rc(int b, int& R, int& C) { const int st = b / 1024, sb = b % 1024, swz = sb ^ (((sb >> 9) & 1) << 5); R = (st >> 1) * 16 + swz / 64; C = (st & 1) * 32 + (swz % 64) / 2; }
__host__ __device__ __forceinline__ int perm32(int rho) { const int n = rho >> 4, i = rho & 15; return 8 * (i >> 2) + 4 * n + (i & 3); }

struct Unit { int pm, pn, kz, kind; };
struct Gemm { const bf16_t* A; const bf16_t* Bt; int M, N, K, ld; };

struct StaticOrder {
    int nM, nN, nwg, G, c, pm0, wgm;
    __host__ __device__ void init(int M, int N, int G_, int c_, int pm0_ = 0, int wgm_ = WGM) { nM = M / BM; nN = N / BM; nwg = nM * nN; G = G_; c = c_; pm0 = pm0_; wgm = wgm_; }
    __host__ __device__ bool next(int i, Unit& u) const {
        const long L = (long)i * G + c; if (L >= nwg) return false;
        int wgid = (int)L; { const int q = nwg / NXCD, r = nwg % NXCD, xcd = wgid % NXCD, off = wgid / NXCD; wgid = (xcd < r ? xcd * (q + 1) : r * (q + 1) + (xcd - r) * q) + off; }
        const int nig = wgm * nN, gid = wgid / nig, fm = gid * wgm, gsz = (nM - fm) < wgm ? (nM - fm) : wgm;
        u.pm = pm0 + fm + ((wgid % nig) % gsz); u.pn = (wgid % nig) / gsz; u.kz = 0; u.kind = 0; return true;
    }
    __device__ __forceinline__ void a_ready(const Unit&) const {}
    __device__ __forceinline__ void done(const Unit&) const {}
};

__device__ __forceinline__ unsigned cvt_pk_bf16(float lo, float hi) { unsigned r; asm volatile("v_cvt_pk_bf16_f32 %0, %1, %2" : "=v"(r) : "v"(lo), "v"(hi)); return r; }
typedef float f32x2 __attribute__((ext_vector_type(2)));
typedef unsigned u32x2 __attribute__((ext_vector_type(2)));
__device__ __forceinline__ float sigmoid_f(float v) { return __builtin_amdgcn_rcpf(1.0f + __builtin_amdgcn_exp2f(-1.4426950408889634f * v)); }
__device__ __forceinline__ float bf_lo(unsigned w) { return __uint_as_float(w << 16); }
__device__ __forceinline__ float bf_hi(unsigned w) { return __uint_as_float(w & 0xffff0000u); }
__device__ __forceinline__ u32x4 pack8(const f32x4 v0, const f32x4 v1) { u32x4 w; w.x = cvt_pk_bf16(v0[0], v0[1]); w.y = cvt_pk_bf16(v0[2], v0[3]); w.z = cvt_pk_bf16(v1[0], v1[1]); w.w = cvt_pk_bf16(v1[2], v1[3]); return w; }

struct EpiPlain {
    static constexpr bool PERM = true, AFTER_DRAIN = false;
    bf16_t* O; int ldc;
    __device__ __forceinline__ void operator()(const f32x4 (&acc)[2][2][4][2], const Unit& u, int wr, int wc, int fr, int fq) const {
        const int row0 = u.pm * BM + wr * 64 + fr, col0 = u.pn * BM + wc * 32 + 8 * fq;
#pragma unroll
        for (int ai = 0; ai < 2; ++ai)
#pragma unroll
            for (int m = 0; m < 4; ++m) { bf16_t* rowp = O + (size_t)(row0 + ai * HALF + m * 16) * ldc + col0;
#pragma unroll
                for (int bj = 0; bj < 2; ++bj) *(u32x4*)(rowp + bj * HALF) = pack8(acc[ai][bj][m][0], acc[ai][bj][m][1]); }
    }
};
struct EpiSwiGLU {
    static constexpr bool PERM = true, AFTER_DRAIN = false;
    bf16_t* O; int ldc;
    __device__ __forceinline__ void operator()(const f32x4 (&acc)[2][2][4][2], const Unit& u, int wr, int wc, int fr, int fq) const {
        const int row0 = u.pm * BM + wr * 64 + fr, col0 = u.pn * HALF + wc * 32 + 8 * fq;
#pragma unroll
        for (int ai = 0; ai < 2; ++ai)
#pragma unroll
            for (int m = 0; m < 4; ++m) { bf16_t* rowp = O + (size_t)(row0 + ai * HALF + m * 16) * ldc + col0;
                const f32x4 g0 = acc[ai][0][m][0], g1 = acc[ai][0][m][1];
                f32x4 t0 = g0 * -1.4426950408889634f, t1 = g1 * -1.4426950408889634f;
#pragma unroll
                for (int e = 0; e < 4; ++e) { t0[e] = __builtin_amdgcn_exp2f(t0[e]); t1[e] = __builtin_amdgcn_exp2f(t1[e]); }
                t0 = t0 + 1.0f; t1 = t1 + 1.0f;
#pragma unroll
                for (int e = 0; e < 4; ++e) { t0[e] = __builtin_amdgcn_rcpf(t0[e]); t1[e] = __builtin_amdgcn_rcpf(t1[e]); }
                const f32x4 h0 = (g0 * acc[ai][1][m][0]) * t0, h1 = (g1 * acc[ai][1][m][1]) * t1;
                *(u32x4*)rowp = pack8(h0, h1); }
    }
};
struct EpiGLU {
    static constexpr bool PERM = true, AFTER_DRAIN = false;
    const bf16_t* Z; int ldz; const float* bias; bf16_t* O; int ldo;
    __device__ __forceinline__ void operator()(const f32x4 (&acc)[2][2][4][2], const Unit& u, int wr, int wc, int fr, int fq) const {
        const int row0 = u.pm * BM + wr * 64 + fr, col0 = u.pn * BM + wc * 32 + 8 * fq;
        f32x4 bv[2][2];
#pragma unroll
        for (int bj = 0; bj < 2; ++bj)
#pragma unroll
            for (int n = 0; n < 2; ++n) bv[bj][n] = *(const f32x4*)(bias + col0 + bj * HALF + 4 * n);
#pragma unroll
        for (int ai = 0; ai < 2; ++ai)
#pragma unroll
            for (int m = 0; m < 4; ++m) { const size_t r = (size_t)(row0 + ai * HALF + m * 16);
#pragma unroll
                for (int bj = 0; bj < 2; ++bj) { const u32x4 zw = *(const u32x4*)(Z + r * ldz + col0 + bj * HALF);
                    const f32x4 v0 = acc[ai][bj][m][0] + bv[bj][0], v1 = acc[ai][bj][m][1] + bv[bj][1];
                    f32x4 o0, o1;
                    o0[0] = bf_lo(zw.x) * sigmoid_f(v0[0]); o0[1] = bf_hi(zw.x) * sigmoid_f(v0[1]); o0[2] = bf_lo(zw.y) * sigmoid_f(v0[2]); o0[3] = bf_hi(zw.y) * sigmoid_f(v0[3]);
                    o1[0] = bf_lo(zw.z) * sigmoid_f(v1[0]); o1[1] = bf_hi(zw.z) * sigmoid_f(v1[1]); o1[2] = bf_lo(zw.w) * sigmoid_f(v1[2]); o1[3] = bf_hi(zw.w) * sigmoid_f(v1[3]);
                    *(u32x4*)(O + r * ldo + col0 + bj * HALF) = pack8(o0, o1); } }
    }
};
struct EpiQKV {
    static constexpr bool PERM = true, AFTER_DRAIN = false;
    bf16_t* O; int ldc; const float* cs; float qscale;
    __device__ __forceinline__ void operator()(const f32x4 (&acc)[2][2][4][2], const Unit& u, int wr, int wc, int fr, int fq) const {
        const int row0 = u.pm * BM + wr * 64 + fr;
        if (u.pn >= 16) {
            const int col0 = u.pn * BM + wc * 32 + 8 * fq;
#pragma unroll
            for (int ai = 0; ai < 2; ++ai)
#pragma unroll
                for (int m = 0; m < 4; ++m) { bf16_t* rowp = O + (size_t)(row0 + ai * HALF + m * 16) * ldc + col0;
#pragma unroll
                    for (int bj = 0; bj < 2; ++bj) *(u32x4*)(rowp + bj * HALF) = pack8(acc[ai][bj][m][0], acc[ai][bj][m][1]); }
            return;
        }
        const float sc = (u.pn < 8) ? qscale : 1.0f;
        const bool rope = (u.pm < 64);
        const int col1 = u.pn * BM + 64 * wc + 8 * fq;
#pragma unroll
        for (int ai = 0; ai < 2; ++ai) {
            f32x4 ta[4], tb[4], tc[4], td[4];
#pragma unroll
            for (int m = 0; m < 4; ++m) { const int row = row0 + ai * HALF + m * 16;
                if (rope) { const int t = row & 8191; const int pos = (fq < 2) ? (t >> 6) : (t & 63);
                    const f32x4* tp = (const f32x4*)(cs + (size_t)(pos * 16 + 8 * (fq & 1)) * 2);
                    ta[m] = tp[0]; tb[m] = tp[1]; tc[m] = tp[2]; td[m] = tp[3];
                } else { ta[m] = tb[m] = tc[m] = td[m] = (f32x4){1.f, 0.f, 1.f, 0.f}; } }
#pragma unroll
            for (int m = 0; m < 4; ++m) { const int row = row0 + ai * HALF + m * 16;
                const f32x4 a = ta[m], b = tb[m], c = tc[m], d = td[m];
                const f32x4 c0 = (f32x4){a[0], a[2], b[0], b[2]}, s0 = (f32x4){a[1], a[3], b[1], b[3]}, c1 = (f32x4){c[0], c[2], d[0], d[2]}, s1 = (f32x4){c[1], c[3], d[1], d[3]};
                const f32x4 x10 = acc[ai][0][m][0], x11 = acc[ai][0][m][1], x20 = acc[ai][1][m][0], x21 = acc[ai][1][m][1];
                const f32x4 o10 = (x10 * c0 - x20 * s0) * sc, o11 = (x11 * c1 - x21 * s1) * sc, o20 = (x10 * s0 + x20 * c0) * sc, o21 = (x11 * s1 + x21 * c1) * sc;
                bf16_t* rowp = O + (size_t)row * ldc + col1;
                *(u32x4*)rowp = pack8(o10, o11); *(u32x4*)(rowp + 32) = pack8(o20, o21); }
        }
    }
};

struct SplitOrder {
    int pm0, nN, nz, total, G, c;
    __host__ __device__ void init(int pm0_, int npm, int N, int nz_, int G_, int c_) { pm0 = pm0_; nN = N / BM; nz = nz_; total = npm * nN * nz; G = G_; c = c_; }
    __host__ __device__ bool next(int i, Unit& u) const { const long L = (long)i * G + c; if (L >= total) return false; const int l = (int)L; u.kz = l % nz; const int r = l / nz; u.pn = r % nN; u.pm = pm0 + r / nN; u.kind = 1; return true; }
    __device__ __forceinline__ void a_ready(const Unit&) const {}
    __device__ __forceinline__ void done(const Unit&) const {}
};
struct EpiPartial {
    static constexpr bool PERM = true, AFTER_DRAIN = false;
    float* P; int ldc, row0; size_t zstride;
    __device__ __forceinline__ void operator()(const f32x4 (&acc)[2][2][4][2], const Unit& u, int wr, int wc, int fr, int fq) const {
        const int r0 = u.pm * BM + wr * 64 + fr - row0, col0 = u.pn * BM + wc * 32 + 8 * fq;
        float* base = P + (size_t)u.kz * zstride;
#pragma unroll
        for (int ai = 0; ai < 2; ++ai)
#pragma unroll
            for (int m = 0; m < 4; ++m) { float* rowp = base + (size_t)(r0 + ai * HALF + m * 16) * ldc + col0;
#pragma unroll
                for (int bj = 0; bj < 2; ++bj) { *(f32x4*)(rowp + bj * HALF) = acc[ai][bj][m][0]; *(f32x4*)(rowp + bj * HALF + 4) = acc[ai][bj][m][1]; } }
    }
};

struct MixedOrder {
    StaticOrder A; SplitOrder B; int nA;
    __host__ __device__ void init(int M, int N, int pm0, int npm, int nz, int G, int c) { A.init(M, N, G, c); B.init(pm0, npm, N, nz, G, c); nA = (A.nwg > c) ? (A.nwg - c + G - 1) / G : 0; }
    __host__ __device__ bool next(int i, Unit& u) const { return i < nA ? A.next(i, u) : B.next(i - nA, u); }
    __device__ __forceinline__ void a_ready(const Unit&) const {}
    __device__ __forceinline__ void done(const Unit&) const {}
};

template <class Epi, class Sched, bool ALIGN_EPI = false, bool SP2 = false>
__device__ __forceinline__ void gemm_phase(PG8_LAS unsigned char* lds, const Gemm g, const Sched& S, const Epi& E) {
    int tid_ = threadIdx.x; asm volatile("" : "+v"(tid_));
    const int tid = tid_, wid = __builtin_amdgcn_readfirstlane(tid >> 6), lane = tid & 63, wr = wid >> 2, wc = wid & 3, fr = lane & 15, fq = lane >> 4;
    const int K = g.K, nt = K / BK;
    unsigned voffA[2], voffB[2];
#pragma unroll
    for (int i = 0; i < 2; ++i) { int R, C; stage_rc(tid * 16 + i * 8192, R, C); const int Rb = Epi::PERM ? ((R & ~31) + perm32(R & 31)) : R;
        voffA[i] = (unsigned)(R * g.ld + C) * 2u; voffB[i] = (unsigned)(Rb * g.ld + C) * 2u; }
    const size_t kstep = (size_t)(BK * 2);
    const size_t hstep = (size_t)HALF * g.ld * 2; const size_t zstep = (size_t)K * 2;
    const size_t tstep = 2 * hstep;
    const unsigned ldsw = (unsigned)wid * 1024u;
    const int aoff = lds_byte(wr * 64 + fr, fq * 8), boff = lds_byte(wc * 32 + fr, fq * 8);
#define PG8_SA(b, h) (((b) * 2 + (h)) * HTB)
#define PG8_SB(b, h) ((4 + (b) * 2 + (h)) * HTB)
#define PG8_STAGE(bufoff, gbase, voff) do { _Pragma("unroll") for (int _i = 0; _i < 2; ++_i) \
        __builtin_amdgcn_global_load_lds((const unsigned*)((const char*)(gbase) + (voff)[_i]), (PG8_LAS unsigned*)(lds + (bufoff) + ldsw + _i * 8192), 16, 0, 0); } while (0)
#define PG8_LDA(dst, b, h) do { _Pragma("unroll") for (int m = 0; m < 4; ++m) _Pragma("unroll") for (int k = 0; k < 2; ++k) dst[m][k] = *(const PG8_LAS bf16x8*)(lds + PG8_SA(b, h) + aoff + m * 2048 + k * 1024); } while (0)
#define PG8_LDB(dst, b, h) do { _Pragma("unroll") for (int n = 0; n < 2; ++n) _Pragma("unroll") for (int k = 0; k < 2; ++k) dst[n][k] = *(const PG8_LAS bf16x8*)(lds + PG8_SB(b, h) + boff + n * 2048 + k * 1024); } while (0)
#define PG8_MMA(ai, bj, At, Bt) do { __builtin_amdgcn_s_setprio(1); _Pragma("unroll") for (int m = 0; m < 4; ++m) _Pragma("unroll") for (int n = 0; n < 2; ++n) _Pragma("unroll") for (int k = 0; k < 2; ++k) \
        acc[ai][bj][m][n] = __builtin_amdgcn_mfma_f32_16x16x32_bf16(Bt[n][k], At[m][k], acc[ai][bj][m][n], 0, 0, 0); __builtin_amdgcn_s_setprio(0); } while (0)
#define PG8_WAIT_V(n) asm volatile("s_waitcnt vmcnt(" #n ")" ::: "memory")
#define PG8_WAIT_L(n) asm volatile("s_waitcnt lgkmcnt(" #n ")" ::: "memory")
#define PG8_BAR __builtin_amdgcn_s_barrier()
#define PG8_SCHED __builtin_amdgcn_sched_barrier(0)
    Unit cur, nxt; int ui = 0;
    if (!S.next(0, cur)) return;
    f32x4 acc[2][2][4][2];
#pragma unroll
    for (int a = 0; a < 2; ++a)
#pragma unroll
        for (int b = 0; b < 2; ++b)
#pragma unroll
            for (int m = 0; m < 4; ++m)
#pragma unroll
                for (int n = 0; n < 2; ++n) acc[a][b][m][n] = (f32x4){0.f, 0.f, 0.f, 0.f};
    bf16x8 At[4][2], B0[2][2], B1[2][2];
    const char* cA = (const char*)g.A + (size_t)cur.pm * tstep + (size_t)cur.kz * zstep; const char* cB = (const char*)g.Bt + (size_t)cur.pn * tstep + (size_t)cur.kz * zstep;
    S.a_ready(cur);
    if constexpr (SP2) {
        PG8_STAGE(PG8_SB(0, 0), cB, voffB); PG8_STAGE(PG8_SB(0, 1), cB + hstep, voffB); PG8_STAGE(PG8_SA(0, 0), cA, voffA); PG8_STAGE(PG8_SA(0, 1), cA + hstep, voffA);
        if (wr == 1) PG8_BAR;
        PG8_WAIT_V(2); PG8_BAR;
        PG8_STAGE(PG8_SB(1, 0), cB + kstep, voffB); PG8_STAGE(PG8_SA(1, 0), cA + kstep, voffA); PG8_STAGE(PG8_SB(1, 1), cB + hstep + kstep, voffB);
        PG8_WAIT_V(6); PG8_BAR;
    } else {
        PG8_STAGE(PG8_SB(0, 0), cB, voffB); PG8_STAGE(PG8_SA(0, 0), cA, voffA); PG8_STAGE(PG8_SB(0, 1), cB + hstep, voffB); PG8_STAGE(PG8_SA(0, 1), cA + hstep, voffA);
        if (wr == 1) PG8_BAR;
        PG8_WAIT_V(4); PG8_BAR;
        PG8_STAGE(PG8_SB(1, 0), cB + kstep, voffB); PG8_STAGE(PG8_SA(1, 0), cA + kstep, voffA); PG8_STAGE(PG8_SB(1, 1), cB + hstep + kstep, voffB);
        PG8_WAIT_V(6); PG8_BAR;
    }
    for (;;) {
        const bool has_next = S.next(ui + 1, nxt);
        const char* nA = has_next ? (const char*)g.A + (size_t)nxt.pm * tstep + (size_t)nxt.kz * zstep : cA; const char* nB = has_next ? (const char*)g.Bt + (size_t)nxt.pn * tstep + (size_t)nxt.kz * zstep : cB;
        for (int t = 0; t < nt; t += 2) {
            const bool last = (t == nt - 2);
            const char* a1 = cA + (size_t)(t + 1) * kstep;
            const char* a2 = last ? nA : cA + (size_t)(t + 2) * kstep; const char* b2 = last ? nB : cB + (size_t)(t + 2) * kstep;
            const char* a3 = a2 + kstep; const char* b3 = b2 + kstep;
            if (last && has_next) S.a_ready(nxt);
            if constexpr (SP2) {
            PG8_LDB(B0, 0, 0); PG8_LDB(B1, 0, 1); PG8_SCHED; PG8_LDA(At, 0, 0); PG8_STAGE(PG8_SA(1, 1), a1 + hstep, voffA);
            PG8_WAIT_V(8); PG8_WAIT_L(0); PG8_BAR; PG8_MMA(0, 0, At, B0); PG8_MMA(0, 1, At, B1); PG8_BAR; PG8_SCHED;
            PG8_LDA(At, 0, 1); PG8_STAGE(PG8_SB(0, 0), b2, voffB); PG8_STAGE(PG8_SB(0, 1), b2 + hstep, voffB); PG8_STAGE(PG8_SA(0, 0), a2, voffA);
            PG8_WAIT_V(8); PG8_WAIT_L(0); PG8_BAR; PG8_MMA(1, 0, At, B0); PG8_MMA(1, 1, At, B1); PG8_BAR; PG8_SCHED;
            PG8_LDB(B0, 1, 0); PG8_LDB(B1, 1, 1); PG8_SCHED; PG8_LDA(At, 1, 0); PG8_STAGE(PG8_SA(0, 1), a2 + hstep, voffA);
            PG8_WAIT_V(8); PG8_WAIT_L(0); PG8_BAR; PG8_MMA(0, 0, At, B0); PG8_MMA(0, 1, At, B1); PG8_BAR; PG8_SCHED;
            PG8_LDA(At, 1, 1); PG8_STAGE(PG8_SB(1, 0), b3, voffB); PG8_STAGE(PG8_SB(1, 1), b3 + hstep, voffB); PG8_STAGE(PG8_SA(1, 0), a3, voffA);
            PG8_WAIT_V(8); PG8_WAIT_L(0); PG8_BAR; PG8_MMA(1, 0, At, B0); PG8_MMA(1, 1, At, B1); PG8_BAR; PG8_SCHED;
            } else {
            PG8_LDB(B0, 0, 0); PG8_SCHED; PG8_LDA(At, 0, 0); PG8_STAGE(PG8_SA(1, 1), a1 + hstep, voffA);
            PG8_WAIT_L(8); PG8_BAR; PG8_WAIT_L(0); PG8_MMA(0, 0, At, B0); PG8_BAR; PG8_SCHED;
            PG8_LDB(B1, 0, 1); PG8_STAGE(PG8_SB(0, 0), b2, voffB);
            PG8_BAR; PG8_WAIT_L(0); PG8_MMA(0, 1, At, B1); PG8_BAR;
            PG8_LDA(At, 0, 1); PG8_STAGE(PG8_SA(0, 0), a2, voffA);
            PG8_BAR; PG8_WAIT_L(0); PG8_MMA(1, 0, At, B0); PG8_BAR; PG8_SCHED;
            PG8_STAGE(PG8_SB(0, 1), b2 + hstep, voffB);
            PG8_WAIT_V(6); PG8_BAR; PG8_MMA(1, 1, At, B1); PG8_BAR;
            PG8_LDB(B0, 1, 0); PG8_SCHED; PG8_LDA(At, 1, 0); PG8_STAGE(PG8_SA(0, 1), a2 + hstep, voffA);
            PG8_WAIT_L(8); PG8_BAR; PG8_WAIT_L(0); PG8_MMA(0, 0, At, B0); PG8_BAR; PG8_SCHED;
            PG8_LDB(B1, 1, 1); PG8_STAGE(PG8_SB(1, 0), b3, voffB);
            PG8_BAR; PG8_WAIT_L(0); PG8_MMA(0, 1, At, B1); PG8_BAR;
            PG8_LDA(At, 1, 1); PG8_STAGE(PG8_SA(1, 0), a3, voffA);
            PG8_BAR; PG8_WAIT_L(0); PG8_MMA(1, 0, At, B0); PG8_BAR; PG8_SCHED;
            PG8_STAGE(PG8_SB(1, 1), b3 + hstep, voffB);
            PG8_WAIT_V(6); PG8_BAR; PG8_MMA(1, 1, At, B1); PG8_BAR;
            }
        }
        if constexpr (ALIGN_EPI) { if (wr == 0) PG8_BAR; }
        if constexpr (!Epi::AFTER_DRAIN) { E(acc, cur, wr, wc, fr, fq); S.done(cur); }
        if (!has_next) break;
#pragma unroll
        for (int a = 0; a < 2; ++a)
#pragma unroll
            for (int b = 0; b < 2; ++b)
#pragma unroll
                for (int m = 0; m < 4; ++m)
#pragma unroll
                    for (int n = 0; n < 2; ++n) acc[a][b][m][n] = (f32x4){0.f, 0.f, 0.f, 0.f};
        cur = nxt; cA = nA; cB = nB; ++ui;
        if constexpr (ALIGN_EPI) { if (wr == 1) PG8_BAR; }
    }
    PG8_WAIT_V(0);
    if constexpr (!ALIGN_EPI) { if (wr == 0) PG8_BAR; }
    PG8_BAR;
    if constexpr (Epi::AFTER_DRAIN) { E.fused(acc, cur, wr, wc, fr, fq, lds, wid, lane); S.done(cur); }
#undef PG8_SA
#undef PG8_SB
#undef PG8_STAGE
#undef PG8_LDA
#undef PG8_LDB
#undef PG8_MMA
#undef PG8_WAIT_V
#undef PG8_WAIT_L
#undef PG8_BAR
#undef PG8_SCHED
}
}
namespace att {
typedef unsigned short bf16_t;
using bf16x8 = __attribute__((ext_vector_type(8))) short;
using s16x4  = __attribute__((ext_vector_type(4))) short;
using f32x16 = __attribute__((ext_vector_type(16))) float;
using u32x4  = __attribute__((ext_vector_type(4))) unsigned;
constexpr int NW = 8, QBLK = 32, KVBLK = 64;
constexpr int LDQ = 6144, LDO = 4096;
constexpr int SHM_V = KVBLK * 128 * 2, SHM_K = KVBLK * 64 * 2;
constexpr float THR = 8.f;
#define ASBAR() __builtin_amdgcn_sched_barrier(0)
__device__ __forceinline__ int crow(int r, int hi) { return (r & 3) + 8 * (r >> 2) + 4 * hi; }
__device__ __forceinline__ unsigned cvtpk(float lo, float hi) { unsigned r; asm volatile("v_cvt_pk_bf16_f32 %0, %1, %2" : "=v"(r) : "v"(lo), "v"(hi)); return r; }
template <bool FIRST = false> __device__ __forceinline__ void partialSM(f32x16& p0, f32x16& p1, float& m_reg, float& alpha, f32x16& negm) {
  float pmax = p0[0];
#pragma unroll
  for (int r = 1; r < 16; ++r) pmax = fmaxf(pmax, p0[r]);
#pragma unroll
  for (int r = 0; r < 16; ++r) pmax = fmaxf(pmax, p1[r]);
  { auto rr = __builtin_amdgcn_permlane32_swap(__float_as_uint(pmax), __float_as_uint(pmax), false, false);
    pmax = fmaxf(__uint_as_float(rr[0]), __uint_as_float(rr[1])); }
  if (!FIRST && __builtin_expect(__all(pmax <= THR), 1)) { alpha = 1.f; }
  else { const float dl = FIRST ? pmax : fmaxf(pmax, 0.f); m_reg += dl;
#pragma unroll
    for (int r = 0; r < 16; ++r) { p0[r] -= dl; p1[r] -= dl; }
#pragma unroll
    for (int r = 0; r < 16; ++r) negm[r] = -m_reg;
    asm volatile("" : "+v"(negm));
    alpha = __builtin_amdgcn_exp2f(-dl); }
#pragma unroll
  for (int r = 0; r < 16; ++r) p0[r] = __builtin_amdgcn_exp2f(p0[r]);
}
__device__ __forceinline__ void finishSM(f32x16& p0, f32x16& p1, float alpha, float& l_reg, bf16x8& pa0, bf16x8& pa1, bf16x8& pa2, bf16x8& pa3) {
#pragma unroll
  for (int r = 0; r < 16; ++r) p1[r] = __builtin_amdgcn_exp2f(p1[r]);
  float ps = 0;
#pragma unroll
  for (int r = 0; r < 16; ++r) ps += p0[r];
#pragma unroll
  for (int r = 0; r < 16; ++r) ps += p1[r];
  { auto rr = __builtin_amdgcn_permlane32_swap(__float_as_uint(ps), __float_as_uint(ps), false, false);
    ps = __uint_as_float(rr[0]) + __uint_as_float(rr[1]); }
  l_reg = l_reg * alpha + ps;
#define PK4(P, BASE, OUT) do { unsigned a0 = cvtpk(P[BASE + 0], P[BASE + 1]), a1 = cvtpk(P[BASE + 2], P[BASE + 3]);   \
    unsigned b0 = cvtpk(P[BASE + 4], P[BASE + 5]), b1 = cvtpk(P[BASE + 6], P[BASE + 7]);                              \
    auto r0 = __builtin_amdgcn_permlane32_swap(a0, b0, false, false); auto r1 = __builtin_amdgcn_permlane32_swap(a1, b1, false, false); \
    u32x4 w = {r0[0], r1[0], r0[1], r1[1]}; OUT = *reinterpret_cast<bf16x8*>(&w); } while (0)
  PK4(p0, 0, pa0); PK4(p0, 8, pa1); PK4(p1, 0, pa2); PK4(p1, 8, pa3);
#undef PK4
}
__device__ __forceinline__ int k_off(int key, int ch) { return ch * 1024 + (key << 4); }
__device__ __forceinline__ void kload8(bf16x8 (&kf)[8], const char* Ks, int r32, int hi) {
#pragma unroll
  for (int d0 = 0; d0 < 4; ++d0) { const int ch = 2 * d0 + hi;
    kf[2 * d0] = *reinterpret_cast<const bf16x8*>(Ks + k_off(r32, ch)); kf[2 * d0 + 1] = *reinterpret_cast<const bf16x8*>(Ks + k_off(32 + r32, ch)); }
}
__device__ __forceinline__ void qkt(f32x16& p0, f32x16& p1, const bf16x8 (&kf)[8], const bf16x8* qr, const f32x16& negm) {
  p0 = __builtin_amdgcn_mfma_f32_32x32x16_bf16(kf[0], qr[0], negm, 0, 0, 0); p1 = __builtin_amdgcn_mfma_f32_32x32x16_bf16(kf[1], qr[0], negm, 0, 0, 0);
  asm volatile("" :: "v"(kf[0]), "v"(kf[1]));
#pragma unroll
  for (int d0 = 1; d0 < 4; ++d0) { p0 = __builtin_amdgcn_mfma_f32_32x32x16_bf16(kf[2 * d0], qr[d0], p0, 0, 0, 0); p1 = __builtin_amdgcn_mfma_f32_32x32x16_bf16(kf[2 * d0 + 1], qr[d0], p1, 0, 0, 0); }
}
__device__ __forceinline__ int v_st(int k, int c) { const int kk = (k & ~0xC) | ((k & 4) << 1) | ((k & 8) >> 1); return ((kk >> 3) * 4 + (c >> 5)) * 512 + ((kk & 7) * 32 + (c & 31)) * 2; }
__device__ __forceinline__ int v_rd_base(int lane) { return ((lane & 3) << 3) | (((lane >> 2) & 3) << 6) | (((lane >> 4) & 1) << 5) | (((lane >> 5) & 1) << 8); }
constexpr int v_rd_off(int d0, int ks, int half) { return d0 * 512 + ks * 4096 + half * 2048; }
template <int OFF> __device__ __forceinline__ s16x4 tr_read(int vb) {
  s16x4 r; asm volatile("ds_read_b64_tr_b16 %0, %1 offset:%2" : "=&v"(r) : "v"(vb), "i"(OFF) : "memory"); return r;
}
template <int D0> __device__ __forceinline__ void pv_one(f32x16& od, int vb, bf16x8 pa0, bf16x8 pa1, bf16x8 pa2, bf16x8 pa3) {
  const s16x4 l0 = tr_read<v_rd_off(D0, 0, 0)>(vb), h0 = tr_read<v_rd_off(D0, 0, 1)>(vb), l1 = tr_read<v_rd_off(D0, 1, 0)>(vb), h1 = tr_read<v_rd_off(D0, 1, 1)>(vb);
  const s16x4 l2 = tr_read<v_rd_off(D0, 2, 0)>(vb), h2 = tr_read<v_rd_off(D0, 2, 1)>(vb), l3 = tr_read<v_rd_off(D0, 3, 0)>(vb), h3 = tr_read<v_rd_off(D0, 3, 1)>(vb);
  asm volatile("s_waitcnt lgkmcnt(0)" ::: "memory"); ASBAR();
#define PK(L, H) (bf16x8){L[0], L[1], L[2], L[3], H[0], H[1], H[2], H[3]}
  od = __builtin_amdgcn_mfma_f32_32x32x16_bf16(PK(l0, h0), pa0, od, 0, 0, 0);
  od = __builtin_amdgcn_mfma_f32_32x32x16_bf16(PK(l1, h1), pa1, od, 0, 0, 0);
  od = __builtin_amdgcn_mfma_f32_32x32x16_bf16(PK(l2, h2), pa2, od, 0, 0, 0);
  od = __builtin_amdgcn_mfma_f32_32x32x16_bf16(PK(l3, h3), pa3, od, 0, 0, 0);
#undef PK
}
__device__ __forceinline__ void pv_d0(f32x16* o, int vb, bf16x8 pa0, bf16x8 pa1, bf16x8 pa2, bf16x8 pa3) {
  pv_one<0>(o[0], vb, pa0, pa1, pa2, pa3); pv_one<1>(o[1], vb, pa0, pa1, pa2, pa3); pv_one<2>(o[2], vb, pa0, pa1, pa2, pa3); pv_one<3>(o[3], vb, pa0, pa1, pa2, pa3);
}
constexpr int NSLOT = 3, LDS_KR = 0, LDS_VR = NSLOT * SHM_K, LDS_WS = LDS_VR + NSLOT * SHM_V;
constexpr int SHM_ATTN = LDS_WS + NW * 64 * 4;
#define AT_LAS __attribute__((address_space(3)))
__device__ __forceinline__ void attn_unit(const bf16_t* __restrict__ QKV, bf16_t* __restrict__ OC, int qrow0, int qcol, int kcol, int vcol, int ocol,
                                          int lat0, int nlat, int ctx0, int NT, char* lds, int tid) {
  const int wid = __builtin_amdgcn_readfirstlane(tid >> 6), lane = tid & 63, r32 = lane & 31, hi = lane >> 5;
  char* K_lds = lds + LDS_KR; char* V_lds = lds + LDS_VR;
  float m_reg = 0.f, l_reg = 0; f32x16 o[4] = {}; f32x16 negm = {}; asm volatile("" : "+v"(negm)); bf16x8 qr[4];
  const unsigned voffK = (unsigned)(lane * LDQ + wid * 8) * 2u;
  unsigned voffV[2];
#pragma unroll
  for (int i = 0; i < 2; ++i) { const int p = 2 * wid + i, s = 2 * p + (lane >> 5), kk = (s >> 2) * 8 + ((lane & 31) >> 2), c = (s & 3) * 32 + (lane & 3) * 8;
    const int k = (kk & ~0xC) | ((kk & 4) << 1) | ((kk & 8) >> 1); voffV[i] = (unsigned)(k * LDQ + c) * 2u; }
#define TROW(j) ((j) < nlat ? lat0 + 64 * (j) : ctx0 + 64 * ((j) - nlat))
#define DMA_K(j) do { const char* tb_ = (const char*)QKV + (size_t)TROW(j) * (LDQ * 2) + kcol * 2; \
    __builtin_amdgcn_global_load_lds((const unsigned*)(tb_ + voffK), (AT_LAS unsigned*)(K_lds + ((j) % NSLOT) * SHM_K + wid * 1024), 16, 0, 0); } while (0)
#define DMA_V(j) do { const char* tb_ = (const char*)QKV + (size_t)TROW(j) * (LDQ * 2) + vcol * 2; \
    __builtin_amdgcn_global_load_lds((const unsigned*)(tb_ + voffV[0]), (AT_LAS unsigned*)(V_lds + ((j) % NSLOT) * SHM_V + (2 * wid) * 1024), 16, 0, 0); \
    __builtin_amdgcn_global_load_lds((const unsigned*)(tb_ + voffV[1]), (AT_LAS unsigned*)(V_lds + ((j) % NSLOT) * SHM_V + (2 * wid + 1) * 1024), 16, 0, 0); } while (0)
#define WAITBAR(N) asm volatile("s_waitcnt vmcnt(" #N ") lgkmcnt(0)\n\ts_barrier" ::: "memory")
#define RESC(a) do { if (__any((a) < 1.f)) { _Pragma("unroll") for (int d = 0; d < 4; ++d) _Pragma("unroll") for (int r = 0; r < 16; ++r) o[d][r] *= (a); } } while (0)
  DMA_K(0); DMA_V(0); DMA_K(1);
  const bf16_t* Qw = QKV + (size_t)(qrow0 + wid * QBLK + r32) * LDQ + qcol + hi * 8;
#pragma unroll
  for (int d0 = 0; d0 < 4; ++d0) qr[d0] = *reinterpret_cast<const bf16x8*>(Qw + d0 * 16);
  const int vb0 = (int)(uintptr_t)V_lds + v_rd_base(lane);
  f32x16 pA0, pA1, pB0, pB1; float alA, alB; bf16x8 pa0, pa1, pa2, pa3;
#define BAR_A(j) do { if ((j) + 2 < NT) { WAITBAR(3); DMA_K((j) + 2); } else { WAITBAR(0); } } while (0)
#define BAR_B(j) do { if ((j) + 2 < NT) { WAITBAR(3); } else { WAITBAR(0); } if ((j) + 1 < NT) DMA_V((j) + 1); } while (0)
  asm volatile("s_waitcnt vmcnt(0)" ::: "memory");
  if (wid >= 4) asm volatile("s_barrier" ::: "memory");
  WAITBAR(0); DMA_K(2);
  bf16x8 kf[8]; kload8(kf, K_lds, r32, hi); ASBAR(); qkt(pA0, pA1, kf, qr, negm); ASBAR();
  BAR_B(0);
  partialSM<true>(pA0, pA1, m_reg, alA, negm);
  int sk = 1, sv = 0;
#define ROT() do { sk = (sk == NSLOT - 1) ? 0 : sk + 1; sv = (sv == NSLOT - 1) ? 0 : sv + 1; } while (0)
  for (int j = 1; j + 1 < NT; j += 2) {
    BAR_A(j);
    kload8(kf, K_lds + sk * SHM_K, r32, hi); ASBAR(); qkt(pB0, pB1, kf, qr, negm);
    finishSM(pA0, pA1, alA, l_reg, pa0, pa1, pa2, pa3); ASBAR();
    BAR_B(j);
    pv_d0(o, vb0 + sv * SHM_V, pa0, pa1, pa2, pa3); partialSM(pB0, pB1, m_reg, alB, negm);
    RESC(alB); ROT();
    BAR_A(j + 1);
    kload8(kf, K_lds + sk * SHM_K, r32, hi); ASBAR(); qkt(pA0, pA1, kf, qr, negm);
    finishSM(pB0, pB1, alB, l_reg, pa0, pa1, pa2, pa3); ASBAR();
    BAR_B(j + 1);
    pv_d0(o, vb0 + sv * SHM_V, pa0, pa1, pa2, pa3); partialSM(pA0, pA1, m_reg, alA, negm);
    RESC(alA); ROT();
  }
  BAR_A(NT - 1);
  kload8(kf, K_lds + sk * SHM_K, r32, hi); ASBAR(); qkt(pB0, pB1, kf, qr, negm);
  finishSM(pA0, pA1, alA, l_reg, pa0, pa1, pa2, pa3); ASBAR();
  BAR_B(NT - 1);
  pv_d0(o, vb0 + sv * SHM_V, pa0, pa1, pa2, pa3); partialSM(pB0, pB1, m_reg, alB, negm);
  RESC(alB); ROT();
  finishSM(pB0, pB1, alB, l_reg, pa0, pa1, pa2, pa3); ASBAR();
  pv_d0(o, vb0 + sv * SHM_V, pa0, pa1, pa2, pa3);
  if (wid < 4) asm volatile("s_barrier" ::: "memory");
#undef BAR_A
#undef BAR_B
  const float rl = __builtin_amdgcn_rcpf(l_reg);
  bf16_t* Ow = OC + (size_t)(qrow0 + wid * QBLK + r32) * LDO + ocol + 8 * hi;
#pragma unroll
  for (int d0 = 0; d0 < 4; ++d0)
#pragma unroll
    for (int t = 0; t < 2; ++t) {
      const unsigned x0 = cvtpk(o[d0][8 * t + 0] * rl, o[d0][8 * t + 1] * rl), x1 = cvtpk(o[d0][8 * t + 2] * rl, o[d0][8 * t + 3] * rl);
      const unsigned y0 = cvtpk(o[d0][8 * t + 4] * rl, o[d0][8 * t + 5] * rl), y1 = cvtpk(o[d0][8 * t + 6] * rl, o[d0][8 * t + 7] * rl);
      auto s0 = __builtin_amdgcn_permlane32_swap(x0, y0, false, false); auto s1 = __builtin_amdgcn_permlane32_swap(x1, y1, false, false);
      u32x4 w = {s0[0], s1[0], s0[1], s1[1]};
      *reinterpret_cast<u32x4*>(Ow + d0 * 32 + 16 * t) = w; }
  WAITBAR(0);
#undef TROW
#undef DMA_K
#undef DMA_V
#undef WAITBAR
#undef ROT
#undef RESC
}
#undef ASBAR
}

constexpr int DM = 2048, BATCH = 2, SEQ = 8192, DEPTH = 4, CTXL = 256, FF = 5632;
constexpr int TLAT = BATCH * SEQ, TCTX = BATCH * CTXL, TT = TLAT + TCTX;
constexpr int NMOD = 9, MODW = NMOD * DM;
constexpr int S5W = 1024, S5H = 16, S5G = 64, S5P = 64, MIXIN = 4096, MIXOUT = 2048;
constexpr int NTC = (SEQ + CTXL) / 64;
constexpr float EPS = 1e-6f;
#ifndef NSUB
#define NSUB 12
#endif
#ifndef ONE_LAUNCH
#define ONE_LAUNCH 1
#endif

constexpr size_t MiB = 1u << 20;
constexpr size_t al(size_t x) { return (x + MiB - 1) / MiB * MiB; }
constexpr size_t WS_CTL = 0, CTL_ZERO_BYTES = 1 * MiB;
constexpr size_t WS_MOD   = WS_CTL + CTL_ZERO_BYTES;
constexpr size_t WS_ROPE  = WS_MOD + al((size_t)DEPTH * 3 * MODW * 4);
constexpr size_t WS_MODP  = WS_ROPE + MiB;
constexpr int    ADA_KC = 32;
constexpr size_t WS_SE    = WS_MODP + al((size_t)DEPTH * ADA_KC * 3 * MODW * 4);
constexpr size_t SCAN_BYTES = (size_t)BATCH * 2 * S5G * NTC * S5P * 8;
constexpr size_t WS_SC    = WS_SE + al(SCAN_BYTES);
constexpr size_t WS_WGU   = WS_SC + al(SCAN_BYTES);
constexpr size_t WGU_ONE  = (size_t)2 * FF * DM * 2;
constexpr size_t WS_WD    = WS_WGU + al(8 * WGU_ONE);
constexpr size_t WD_ONE   = (size_t)DM * FF * 2;
constexpr size_t WS_WIN   = WS_WD + al(8 * WD_ONE);
constexpr size_t WS_WOUT  = WS_WIN + al((size_t)2 * MIXIN * DM * 2);
constexpr size_t WS_WGLU  = WS_WOUT + al((size_t)2 * DM * MIXOUT * 2);
constexpr size_t WS_WQKV  = WS_WGLU + al((size_t)2 * S5W * S5W * 2);
constexpr size_t WS_WO    = WS_WQKV + al((size_t)2 * 3 * DM * DM * 2);
constexpr size_t WS_X     = WS_WO + al((size_t)2 * DM * DM * 2);
constexpr size_t WS_H     = WS_X + al((size_t)TT * DM * 4);
constexpr size_t WS_Y     = WS_H + al((size_t)TT * DM * 2);
constexpr size_t WS_BIG   = WS_Y + al((size_t)TT * DM * 2);
constexpr size_t WS_Z     = WS_BIG + al((size_t)TT * 6144 * 2);
constexpr size_t WS_MIXA  = WS_Z + al((size_t)TT * S5W * 2);
constexpr size_t WS_OC    = WS_MIXA + al((size_t)TT * DM * 2);
constexpr size_t WS_PART  = WS_OC + al((size_t)TT * 4096 * 2);
constexpr int    NZ_DOWN = 4, NZ_OUT = 4;
constexpr size_t WS_END   = WS_PART + al((size_t)11 * TCTX * DM * 4);

constexpr int CW_BAR = 4096;
constexpr int CW_HOST = 16384;

constexpr int SCRATCH_BYTES = 143360;
constexpr int LDSCTL_OFF = SCRATCH_BYTES, MISC_OFF = LDSCTL_OFF + 320;
constexpr int LDS_BYTES = 147456;
static_assert(pg8::STAGE_BYTES <= SCRATCH_BYTES && att::SHM_ATTN <= SCRATCH_BYTES && MISC_OFF + 128 <= LDS_BYTES, "LDS map");

#define GAS __attribute__((address_space(1)))
#define LAS __attribute__((address_space(3)))
typedef unsigned short bf16;
typedef unsigned v4u __attribute__((ext_vector_type(4)));
typedef float f32x4 __attribute__((ext_vector_type(4)));
typedef float f32x16 __attribute__((ext_vector_type(16)));
typedef short bf16x8 __attribute__((ext_vector_type(8)));
#define LDS_WAIT() asm volatile("s_waitcnt lgkmcnt(0)" ::: "memory")
#define VM_WAIT() asm volatile("s_waitcnt vmcnt(0)" ::: "memory")
__device__ __forceinline__ unsigned pk2(float lo, float hi) { unsigned r; asm volatile("v_cvt_pk_bf16_f32 %0, %1, %2" : "=v"(r) : "v"(lo), "v"(hi)); return r; }
typedef _Float16 h16x2 __attribute__((ext_vector_type(2)));
__device__ __forceinline__ unsigned pkh2(float lo, float hi) { const float L = 65504.f; h16x2 v = {(_Float16)__builtin_fminf(__builtin_fmaxf(lo, -L), L), (_Float16)__builtin_fminf(__builtin_fmaxf(hi, -L), L)}; return __builtin_bit_cast(unsigned, v); }
__device__ __forceinline__ float hlo(unsigned w) { return (float)__builtin_bit_cast(h16x2, w)[0]; }
__device__ __forceinline__ float hhi(unsigned w) { return (float)__builtin_bit_cast(h16x2, w)[1]; }
__device__ __forceinline__ float bflo(unsigned w) { return __uint_as_float(w << 16); }
__device__ __forceinline__ float bfhi(unsigned w) { return __uint_as_float(w & 0xffff0000u); }
__device__ __forceinline__ float wave_sum(float v) {
#pragma unroll
    for (int o = 1; o < 64; o <<= 1) v += __shfl_xor(v, o);
    return v;
}
#define XB_TMO      128
#define XB_XCNT(j)  (256  + 64 * (j))
#define XB_XSUB(j)  (1280 + 64 * (j))
#define XB_XGEN(j)  (2304 + 64 * (j))
#define XB_TOP      3328
#define XB_TOPGEN   3392
#define XCD_BAR_WORDS 3456
#define XB_SPIN_CAP (1u << 18)

__device__ __forceinline__ unsigned xb_ld(unsigned* p)              { return __hip_atomic_load(p, __ATOMIC_RELAXED, __HIP_MEMORY_SCOPE_AGENT); }
__device__ __forceinline__ unsigned xb_add(unsigned* p, unsigned v) { return __hip_atomic_fetch_add(p, v, __ATOMIC_RELAXED, __HIP_MEMORY_SCOPE_AGENT); }
__device__ __forceinline__ unsigned xb_xcc_id() { return (unsigned)__builtin_amdgcn_s_getreg((3 << 11) | 20) & 0xFu; }
#define XB_SPIN(cond, bar) do { unsigned _sp = 0; while (cond) { __builtin_amdgcn_s_sleep(1); \
    if ((++_sp & 255u) == 0u) { if (xb_ld(&(bar)[XB_TMO])) break; if (_sp > XB_SPIN_CAP) { atomicAdd(&(bar)[XB_TMO], 1u); break; } } } } while (0)

struct XcdBarrier {
    unsigned* bar; unsigned x;
    volatile LAS unsigned* st;
};

__device__ __forceinline__ XcdBarrier xcd_barrier_post(unsigned* bar, volatile LAS unsigned* st) {
    XcdBarrier b; b.bar = bar; b.x = xb_xcc_id(); b.st = st;
    if (threadIdx.x == 0) (void)xb_add(&bar[XB_XCNT(b.x)], 1u);
    return b;
}
__device__ __forceinline__ void xcd_barrier_complete(unsigned* bar, unsigned x, unsigned& nloc, unsigned& nx) {
    const unsigned G = gridDim.x * gridDim.y * gridDim.z;
    unsigned sum, cnt, mine, sp = 0u;
    for (;;) {
        sum = 0u; cnt = 0u; mine = 0u;
#pragma unroll
        for (unsigned j = 0; j < 16; ++j) { const unsigned c = xb_ld(&bar[XB_XCNT(j)]); sum += c; cnt += (c > 0u) ? 1u : 0u; mine = (j == x) ? c : mine; }
        if (sum == G) break;
        __builtin_amdgcn_s_sleep(1);
        if ((++sp & 255u) == 0u) { if (xb_ld(&bar[XB_TMO])) break; if (sp > XB_SPIN_CAP) { atomicAdd(&bar[XB_TMO], 1u); break; } }
    }
    nloc = mine > 0u ? mine : 1u; nx = cnt > 0u ? cnt : 1u;
}

__device__ __forceinline__ void xcd_barrier(const XcdBarrier& b) {
    asm volatile("s_waitcnt vmcnt(0)" ::: "memory");
    __syncthreads();
    if (threadIdx.x == 0) {
        unsigned* bar = b.bar;
        __builtin_amdgcn_s_waitcnt(0);
        unsigned nloc = b.st[0], nx = b.st[1];
        if (nloc == 0u) { xcd_barrier_complete(bar, b.x, nloc, nx); b.st[0] = nloc; b.st[1] = nx; }
        const unsigned old = xb_add(&bar[XB_XSUB(b.x)], 1u);
        const unsigned gen = old / nloc;
        if (old + 1u == (gen + 1u) * nloc) {
            __builtin_amdgcn_fence(__ATOMIC_RELEASE, "agent");
            asm volatile("s_waitcnt vmcnt(0)" ::: "memory");
            const unsigned og = xb_add(&bar[XB_TOP], 1u);
            const unsigned tg = og / nx;
            if (og + 1u == (tg + 1u) * nx) xb_add(&bar[XB_TOPGEN], 1u);
            else XB_SPIN(xb_ld(&bar[XB_TOPGEN]) == tg, bar);
            __builtin_amdgcn_fence(__ATOMIC_ACQUIRE, "agent");
            xb_add(&bar[XB_XGEN(b.x)], 1u);
            asm volatile("s_waitcnt vmcnt(0)" ::: "memory");
        } else {
            XB_SPIN(xb_ld(&bar[XB_XGEN(b.x)]) == gen, bar);
            __builtin_amdgcn_fence(__ATOMIC_ACQUIRE, "agent");
            asm volatile("s_waitcnt vmcnt(0)" ::: "memory");
        }
    }
    __syncthreads();
}
constexpr int NWAVES = 8;
struct Args { const float* in[28]; float* out; unsigned char* ws; int ph_lo, ph_hi; };
struct Frame {
    const Args& A;
    LAS unsigned char* lds;
    int tid, lane, wave, vcu, G;
    float* out; unsigned char* ws;
};
#define WSP(T, off) ((T*)(F.ws + (off)))

template <int MAP> __device__ __forceinline__ int rowmap(int n) {
    if (MAP == 1) return ((n >> 7) << 8) + (n & 127);
    if (MAP == 2) return ((n >> 7) << 8) + 128 + (n & 127);
    if (MAP == 3) { if (n >= 4096) return n; const int i = n & 255, beta = i >> 6, d = i & 63; return (n & ~255) + (d < 32 ? 32 * beta + d : 128 + 32 * beta + (d - 32)); }
    return n;
}
template <int MAP> __device__ __forceinline__ void transpose_item(const float* W, int K, int N, bf16* WT, LAS float* scr, int item, int lane) {
    const int nblk = N / 32, kb = item / nblk, nb = item % nblk, k0 = 64 * kb, n0 = 32 * nb;
#pragma unroll 8
    for (int i = 0; i < 32; ++i) { const int kk = 2 * i + (lane >> 5); scr[kk * 33 + (lane & 31)] = W[(size_t)(k0 + kk) * N + n0 + (lane & 31)]; }
    LDS_WAIT(); asm volatile("" ::: "memory");
    const int c = lane & 7;
#pragma unroll
    for (int j = 0; j < 4; ++j) { const int n = (lane >> 3) + 8 * j; const LAS float* s = scr + (8 * c) * 33 + n;
        v4u o; o.x = pk2(s[0 * 33], s[1 * 33]); o.y = pk2(s[2 * 33], s[3 * 33]); o.z = pk2(s[4 * 33], s[5 * 33]); o.w = pk2(s[6 * 33], s[7 * 33]);
        *(GAS v4u*)(WT + (size_t)rowmap<MAP>(n0 + n) * K + k0 + 8 * c) = o; }
    LDS_WAIT(); asm volatile("" ::: "memory");
}
__device__ __forceinline__ float silu_f(float v) { return v / (1.0f + __expf(-v)); }

__device__ __forceinline__ void p0_prologue(Frame& F) {
    const int gw = F.vcu * NWAVES + F.wave, NGW = F.G * NWAVES;
    LAS float* sv = (LAS float*)(F.lds + 8 * 8704);
    for (int i = F.tid; i < 3 * DM; i += NWAVES * 64) { const int v = i / DM, k = i % DM; sv[i] = silu_f(v < 2 ? F.A.in[1][v * DM + k] : F.A.in[3][k]); }
    { const int gt = (F.vcu * NWAVES * 64) + F.tid; if (gt < 128 * 16) { const int pos = gt >> 4, j = gt & 15; const float fr = powf(10000.0f, -(float)j / 16.0f); const float ang = (float)pos * fr;
            float* cs = WSP(float, WS_ROPE); cs[2 * gt] = cosf(ang); cs[2 * gt + 1] = sinf(ang); } }
    __syncthreads();
    { float* part = WSP(float, WS_MODP);
      constexpr int NCB = MODW / 256, NU = DEPTH * ADA_KC * NCB;
      for (int u = gw; u < NU; u += NGW) { const int cb = u % NCB, kc = (u / NCB) % ADA_KC, l = u / (NCB * ADA_KC);
          const float* W = F.A.in[4] + ((size_t)l * DM + kc * 64) * MODW + cb * 256 + F.lane * 4;
          f32x4 a0 = {0, 0, 0, 0}, a1 = a0, a2 = a0;
#pragma unroll 8
          for (int k = 0; k < 64; ++k) { const f32x4 w = *(const f32x4*)(W + (size_t)k * MODW); const int kk = kc * 64 + k;
              a0 += w * sv[kk]; a1 += w * sv[DM + kk]; a2 += w * sv[2 * DM + kk]; }
          float* o = part + ((size_t)(l * ADA_KC + kc) * 3) * MODW + cb * 256 + F.lane * 4;
          *(f32x4*)o = a0; *(f32x4*)(o + MODW) = a1; *(f32x4*)(o + 2 * MODW) = a2; } }
    LAS float* scr = (LAS float*)(F.lds + F.wave * 8704);
    constexpr int I_FF = (DM / 64) * (FF / 32);
    constexpr int I_IN = (DM / 64) * (MIXIN / 32), I_OUT = (MIXOUT / 64) * (DM / 32), I_GLU = (S5W / 64) * (S5W / 32), I_QKV = (DM / 64) * (3 * DM / 32), I_O = (DM / 64) * (DM / 32);
    constexpr int N_FFN = 24 * I_FF, N_EV = I_IN + I_OUT + I_GLU, N_OD = I_QKV + I_O, NITEMS = N_FFN + 2 * N_EV + 2 * N_OD;
    for (int it = gw; it < NITEMS; it += NGW) {
        int r = it;
        if (r < N_FFN) { const int q = r / I_FF, item = r % I_FF, lh = q / 3, kind = q % 3;
            if (kind == 0) transpose_item<1>(F.A.in[7] + (size_t)lh * DM * FF, DM, FF, WSP(bf16, WS_WGU + lh * WGU_ONE), scr, item, F.lane);
            else if (kind == 1) transpose_item<2>(F.A.in[8] + (size_t)lh * DM * FF, DM, FF, WSP(bf16, WS_WGU + lh * WGU_ONE), scr, item, F.lane);
            else transpose_item<0>(F.A.in[9] + (size_t)lh * FF * DM, FF, DM, WSP(bf16, WS_WD + lh * WD_ONE), scr, item, F.lane);
            continue; }
        r -= N_FFN;
        if (r < 2 * N_EV) { const int i = r / N_EV; r %= N_EV;
            if (r < I_IN) { transpose_item<0>(F.A.in[10] + (size_t)i * DM * MIXIN, DM, MIXIN, WSP(bf16, WS_WIN + (size_t)i * MIXIN * DM * 2), scr, r, F.lane); continue; } r -= I_IN;
            if (r < I_OUT) { transpose_item<0>(F.A.in[11] + (size_t)i * MIXOUT * DM, MIXOUT, DM, WSP(bf16, WS_WOUT + (size_t)i * DM * MIXOUT * 2), scr, r, F.lane); continue; } r -= I_OUT;
            transpose_item<0>(F.A.in[20] + (size_t)i * S5W * S5W, S5W, S5W, WSP(bf16, WS_WGLU + (size_t)i * S5W * S5W * 2), scr, r, F.lane); continue; }
        r -= 2 * N_EV;
        { const int i = r / N_OD; r %= N_OD;
            if (r < I_QKV) { transpose_item<3>(F.A.in[24] + (size_t)i * DM * 3 * DM, DM, 3 * DM, WSP(bf16, WS_WQKV + (size_t)i * 3 * DM * DM * 2), scr, r, F.lane); continue; } r -= I_QKV;
            transpose_item<0>(F.A.in[25] + (size_t)i * DM * DM, DM, DM, WSP(bf16, WS_WO + (size_t)i * DM * DM * 2), scr, r, F.lane); }
    }
}
__device__ __forceinline__ void p1_ada_reduce(Frame& F) {
    const float* part = WSP(float, WS_MODP); float* mod = WSP(float, WS_MOD);
    const int gt = F.vcu * NWAVES * 64 + F.tid, NGT = F.G * NWAVES * 64;
    for (int i = gt; i < DEPTH * 3 * MODW; i += NGT) { const int n = i % MODW, v = (i / MODW) % 3, l = i / (3 * MODW);
        float s = F.A.in[5][l * MODW + n];
#pragma unroll 8
        for (int kc = 0; kc < ADA_KC; ++kc) s += part[((size_t)(l * ADA_KC + kc) * 3 + v) * MODW + n];
        mod[i] = s; }
}

__device__ __forceinline__ void host_arrive(unsigned* cnt) {
    VM_WAIT(); __syncthreads();
    if (threadIdx.x == 0) { __builtin_amdgcn_fence(__ATOMIC_RELEASE, "agent"); VM_WAIT(); (void)__hip_atomic_fetch_add(cnt, 1u, __ATOMIC_RELAXED, __HIP_MEMORY_SCOPE_AGENT); }
}
__device__ __forceinline__ void host_wait(unsigned* cnt, unsigned want) {
    if (threadIdx.x == 0) { unsigned sp = 0; while (__hip_atomic_load(cnt, __ATOMIC_RELAXED, __HIP_MEMORY_SCOPE_AGENT) < want) { __builtin_amdgcn_s_sleep(4); if (++sp > (1u << 22)) break; }
        __builtin_amdgcn_fence(__ATOMIC_ACQUIRE, "agent"); VM_WAIT(); }
    __syncthreads();
}
__device__ __forceinline__ void resid_norm_phase(Frame& F, int sub, int nctx = TCTX, bool dry = false) {
    LAS float* vA = (LAS float*)F.lds; LAS float* vB = vA + 3 * DM; LAS float* vC = vB + 3 * DM;
    const float* mod = WSP(float, WS_MOD);
    const bool has_y = sub >= 0, from_input = sub <= 0, last = (sub == NSUB - 1), write_h = !last;
    const int nsub = sub + 1, nl = nsub / 3, ns = nsub % 3;
    for (int i = F.tid; i < 3 * DM; i += NWAVES * 64) { const int v = i / DM, c = i % DM;
        if (has_y) { const int l = sub / 3, s = sub % 3; const float wgt = (s == 1) ? 1.0f : 0.5f;
            vA[i] = wgt * mod[((size_t)(l * 3 + v) * NMOD + 3 * s + 2) * DM + c] * F.A.in[6][((size_t)l * 6 + 2 * s + 1) * DM + c]; }
        if (write_h) { vB[i] = F.A.in[6][((size_t)nl * 6 + 2 * ns) * DM + c] * (1.0f + mod[((size_t)(nl * 3 + v) * NMOD + 3 * ns + 1) * DM + c]);
            vC[i] = mod[((size_t)(nl * 3 + v) * NMOD + 3 * ns) * DM + c]; } }
    __syncthreads();
    const bf16* Y = WSP(bf16, WS_Y); const bf16* X = WSP(bf16, WS_X); bf16* Xd = dry ? WSP(bf16, WS_OC) : WSP(bf16, WS_X); bf16* H = dry ? WSP(bf16, WS_MIXA) : WSP(bf16, WS_H); float* outd = dry ? WSP(float, WS_OC) : F.out;
    const int lp = (TLAT + F.G - 1) / F.G, cp = (TCTX + F.G - 1) / F.G;
    const int l0 = blockIdx.x * lp, l1 = (l0 + lp < TLAT) ? l0 + lp : TLAT, nl_ = l1 > l0 ? l1 - l0 : 0;
    const int c0 = blockIdx.x * cp, c1 = (c0 + cp < nctx) ? c0 + cp : nctx, nc_ = c1 > c0 ? c1 - c0 : 0;
    for (int j = F.wave; j < nl_ + nc_; j += NWAVES) {
        const int row = j < nl_ ? l0 + j : TLAT + c0 + (j - nl_);
        const int v = row < SEQ ? 0 : (row < TLAT ? 1 : 2);
        f32x4 xv[4][2];
        if (from_input) {
            const float* xs = row < TLAT ? F.A.in[0] + (size_t)row * DM : F.A.in[2] + (size_t)(row - TLAT) * DM;
#pragma unroll
            for (int i = 0; i < 4; ++i) { const f32x4* p = (const f32x4*)(xs + i * 512 + F.lane * 8); xv[i][0] = p[0]; xv[i][1] = p[1]; }
        } else {
            v4u xw[4];
#pragma unroll
            for (int i = 0; i < 4; ++i) xw[i] = *(const v4u*)(X + (size_t)row * DM + i * 512 + F.lane * 8);
#pragma unroll
            for (int i = 0; i < 4; ++i) { xv[i][0] = (f32x4){hlo(xw[i].x), hhi(xw[i].x), hlo(xw[i].y), hhi(xw[i].y)}; xv[i][1] = (f32x4){hlo(xw[i].z), hhi(xw[i].z), hlo(xw[i].w), hhi(xw[i].w)}; }
        }
        if (has_y) {
            float ss = 0.f; f32x4 yv[4][2];
            if (row < TLAT) {
                v4u yw[4];
#pragma unroll
                for (int i = 0; i < 4; ++i) yw[i] = *(const v4u*)(Y + (size_t)row * DM + i * 512 + F.lane * 8);
#pragma unroll
                for (int i = 0; i < 4; ++i) { yv[i][0] = (f32x4){bflo(yw[i].x), bfhi(yw[i].x), bflo(yw[i].y), bfhi(yw[i].y)}; yv[i][1] = (f32x4){bflo(yw[i].z), bfhi(yw[i].z), bflo(yw[i].w), bfhi(yw[i].w)}; }
            } else {
                const int nz = (sub % 3 == 1) ? NZ_OUT : NZ_DOWN; const float* pp = WSP(const float, WS_PART) + (size_t)(row - TLAT) * DM + F.lane * 8;
#pragma unroll
                for (int i = 0; i < 4; ++i) { yv[i][0] = (f32x4){0.f, 0.f, 0.f, 0.f}; yv[i][1] = yv[i][0]; }
#pragma unroll 4
                for (int z = 0; z < nz; ++z) { const float* pz = pp + (size_t)z * TCTX * DM;
#pragma unroll
                    for (int i = 0; i < 4; ++i) { yv[i][0] += *(const f32x4*)(pz + i * 512); yv[i][1] += *(const f32x4*)(pz + i * 512 + 4); } }
            }
#pragma unroll
            for (int i = 0; i < 4; ++i)
#pragma unroll
                for (int h = 0; h < 2; ++h) ss += (yv[i][h][0] * yv[i][h][0] + yv[i][h][1] * yv[i][h][1]) + (yv[i][h][2] * yv[i][h][2] + yv[i][h][3] * yv[i][h][3]);
            const float r = rsqrtf(wave_sum(ss) * (1.0f / DM) + EPS);
#pragma unroll
            for (int i = 0; i < 4; ++i)
#pragma unroll
                for (int h = 0; h < 2; ++h) { const f32x4 a = *(const LAS f32x4*)(vA + v * DM + i * 512 + F.lane * 8 + 4 * h); xv[i][h] += a * (yv[i][h] * r); }
            if (!last) {
#pragma unroll
                for (int i = 0; i < 4; ++i) { v4u w; w.x = pkh2(xv[i][0][0], xv[i][0][1]); w.y = pkh2(xv[i][0][2], xv[i][0][3]); w.z = pkh2(xv[i][1][0], xv[i][1][1]); w.w = pkh2(xv[i][1][2], xv[i][1][3]);
                    *(v4u*)(Xd + (size_t)row * DM + i * 512 + F.lane * 8) = w; }
            } else if (row < TLAT) {
#pragma unroll
                for (int i = 0; i < 4; ++i) { f32x4* p = (f32x4*)(outd + (size_t)row * DM + i * 512 + F.lane * 8); p[0] = xv[i][0]; p[1] = xv[i][1]; }
            }
        }
        if (write_h) {
            float ss = 0.f;
#pragma unroll
            for (int i = 0; i < 4; ++i)
#pragma unroll
                for (int h = 0; h < 2; ++h) ss += (xv[i][h][0] * xv[i][h][0] + xv[i][h][1] * xv[i][h][1]) + (xv[i][h][2] * xv[i][h][2] + xv[i][h][3] * xv[i][h][3]);
            const float r = rsqrtf(wave_sum(ss) * (1.0f / DM) + EPS);
#pragma unroll
            for (int i = 0; i < 4; ++i) { f32x4 o[2];
#pragma unroll
                for (int h = 0; h < 2; ++h) { const f32x4 b = *(const LAS f32x4*)(vB + v * DM + i * 512 + F.lane * 8 + 4 * h), c = *(const LAS f32x4*)(vC + v * DM + i * 512 + F.lane * 8 + 4 * h); o[h] = (xv[i][h] * r) * b + c; }
                v4u w; w.x = pk2(o[0][0], o[0][1]); w.y = pk2(o[0][2], o[0][3]); w.z = pk2(o[1][0], o[1][1]); w.w = pk2(o[1][2], o[1][3]);
                *(v4u*)(H + (size_t)row * DM + i * 512 + F.lane * 8) = w; }
        }
    }
}

namespace s5 {
struct Par { float a_re, a_im; bf16x8 Bre1, Bim1, Bre2, Bim2; };
__device__ __forceinline__ void discretize(float lre, float lim, float dt, float& a_re, float& a_im, float& co_re, float& co_im) {
    const float mag = expf(lre * dt); float sn, cn; sincosf(lim * dt, &sn, &cn);
    a_re = mag * cn; a_im = mag * sn;
    const float inv = 1.0f / (lre * lre + lim * lim);
    co_re = ((a_re - 1.0f) * lre + a_im * lim) * inv; co_im = (a_im * lre - (a_re - 1.0f) * lim) * inv;
}
__device__ __forceinline__ void load_par(const Args& in, int ei, int dir, int g, int lane, Par& P) {
    const int base = (ei * 2 + dir) * S5G + g; const float dt = expf(in.in[14][base]);
    const int r32 = lane & 31, hi = lane >> 5;
    { float cr, ci; discretize(in.in[12][base * S5P + lane], in.in[13][base * S5P + lane], dt, P.a_re, P.a_im, cr, ci); }
#pragma unroll
    for (int q = 0; q < 2; ++q) { const int p = q * 32 + r32; float ar, ai, cr, ci; discretize(in.in[12][base * S5P + p], in.in[13][base * S5P + p], dt, ar, ai, cr, ci);
        const f32x4* br = (const f32x4*)(in.in[15] + ((size_t)base * S5P + p) * S5H + 8 * hi); const f32x4* bi = (const f32x4*)(in.in[16] + ((size_t)base * S5P + p) * S5H + 8 * hi);
        const f32x4 r0 = br[0], r1 = br[1], i0 = bi[0], i1 = bi[1];
        const f32x4 xr0 = r0 * cr - i0 * ci, xr1 = r1 * cr - i1 * ci, xi0 = i0 * cr + r0 * ci, xi1 = i1 * cr + r1 * ci;
        v4u wr, wi; wr.x = pk2(xr0[0], xr0[1]); wr.y = pk2(xr0[2], xr0[3]); wr.z = pk2(xr1[0], xr1[1]); wr.w = pk2(xr1[2], xr1[3]);
        wi.x = pk2(xi0[0], xi0[1]); wi.y = pk2(xi0[2], xi0[3]); wi.z = pk2(xi1[0], xi1[1]); wi.w = pk2(xi1[2], xi1[3]);
        if (q == 0) { P.Bre1 = __builtin_bit_cast(bf16x8, wr); P.Bim1 = __builtin_bit_cast(bf16x8, wi); } else { P.Bre2 = __builtin_bit_cast(bf16x8, wr); P.Bim2 = __builtin_bit_cast(bf16x8, wi); } }
}
constexpr size_t TAB_B = 0, TAB_A = 128 * 4 * 64 * 16, TAB_C = TAB_A + 128 * 64 * 8, TAB_END = TAB_C + 128 * 4 * 64 * 16;
__device__ __forceinline__ void cfrags(const Args& in, int ei, int dir, int g, int lane, bf16x8 (&C)[4]) {
    const int fr = lane & 15, kq = lane >> 4;
#pragma unroll
    for (int ks = 0; ks < 4; ++ks) { const size_t o = ((size_t)((ei * 2 + dir) * S5G + g) * S5H + fr) * S5P + 16 * ks + 4 * kq;
        const f32x4 cr = *(const f32x4*)(in.in[17] + o), ci = *(const f32x4*)(in.in[18] + o);
        v4u w; w.x = pk2(cr[0], -ci[0]); w.y = pk2(cr[1], -ci[1]); w.z = pk2(cr[2], -ci[2]); w.w = pk2(cr[3], -ci[3]);
        C[ks] = __builtin_bit_cast(bf16x8, w); }
}
__device__ __forceinline__ void table_store(unsigned char* tab, int dg, int lane, const Par& P, const bf16x8 (&C)[4]) {
    v4u* tb = (v4u*)(tab + TAB_B) + (size_t)dg * 256 + lane; tb[0] = __builtin_bit_cast(v4u, P.Bre1); tb[64] = __builtin_bit_cast(v4u, P.Bim1); tb[128] = __builtin_bit_cast(v4u, P.Bre2); tb[192] = __builtin_bit_cast(v4u, P.Bim2);
    ((float2*)(tab + TAB_A))[dg * 64 + lane] = make_float2(P.a_re, P.a_im);
    v4u* tc = (v4u*)(tab + TAB_C) + (size_t)dg * 256 + lane;
#pragma unroll
    for (int ks = 0; ks < 4; ++ks) tc[64 * ks] = __builtin_bit_cast(v4u, C[ks]);
}
__device__ __forceinline__ void table_load(const unsigned char* tab, int dg, int lane, Par& P, bf16x8 (&C)[4]) {
    const v4u* tb = (const v4u*)(tab + TAB_B) + (size_t)dg * 256 + lane; P.Bre1 = __builtin_bit_cast(bf16x8, tb[0]); P.Bim1 = __builtin_bit_cast(bf16x8, tb[64]); P.Bre2 = __builtin_bit_cast(bf16x8, tb[128]); P.Bim2 = __builtin_bit_cast(bf16x8, tb[192]);
    const float2 a = ((const float2*)(tab + TAB_A))[dg * 64 + lane]; P.a_re = a.x; P.a_im = a.y;
    const v4u* tc = (const v4u*)(tab + TAB_C) + (size_t)dg * 256 + lane;
#pragma unroll
    for (int ks = 0; ks < 4; ++ks) C[ks] = __builtin_bit_cast(bf16x8, tc[64 * ks]);
}
__device__ __forceinline__ int chunk_row0(int b, int tc) { return tc < 128 ? b * SEQ + 64 * tc : TLAT + b * CTXL + 64 * (tc - 128); }
__device__ __forceinline__ void load_chunk(const bf16* U, int row0, int g, int dir, int lane, bf16x8 (&A2)[2]) {
    const int r32 = lane & 31, hi = lane >> 5;
#pragma unroll
    for (int blk = 0; blk < 2; ++blk) { const int i = 32 * blk + r32, tok = dir ? 63 - i : i; A2[blk] = *(const bf16x8*)(U + (size_t)(row0 + tok) * MIXIN + g * S5H + 8 * hi); }
}
template <bool WRITE_H> __device__ __forceinline__ void run_chunk_pre(const Par& P, const bf16x8 (&A2)[2], int dir, int lane, float& sre, float& sim, LAS unsigned* Hbuf) {
#pragma unroll
    for (int blk = 0; blk < 2; ++blk) {
        const bf16x8 A = A2[blk];
        f32x16 G1r, G1i, G2r, G2i;
        asm volatile("s_nop 1\n\tv_mfma_f32_32x32x16_bf16 %0, %4, %5, 0\n\tv_mfma_f32_32x32x16_bf16 %1, %4, %6, 0\n\tv_mfma_f32_32x32x16_bf16 %2, %4, %7, 0\n\tv_mfma_f32_32x32x16_bf16 %3, %4, %8, 0\n\ts_nop 15"
                     : "=&v"(G1r), "=&v"(G1i), "=&v"(G2r), "=&v"(G2i) : "v"(A), "v"(P.Bre1), "v"(P.Bim1), "v"(P.Bre2), "v"(P.Bim2));
#pragma unroll
        for (int r = 0; r < 16; ++r) {
            auto sr = __builtin_amdgcn_permlane32_swap(__float_as_uint(G1r[r]), __float_as_uint(G2r[r]), false, false); G1r[r] = __uint_as_float(sr[0]); G2r[r] = __uint_as_float(sr[1]);
            auto si = __builtin_amdgcn_permlane32_swap(__float_as_uint(G1i[r]), __float_as_uint(G2i[r]), false, false); G1i[r] = __uint_as_float(si[0]); G2i[r] = __uint_as_float(si[1]); }
#define S5_STEP(XR, XI, STEPI) do { const float nr = fmaf(-P.a_im, sim, fmaf(P.a_re, sre, (XR))); const float ni = fmaf(P.a_im, sre, fmaf(P.a_re, sim, (XI))); sre = nr; sim = ni; \
        if (WRITE_H) { const int st_ = 32 * blk + (STEPI); const int tk_ = dir ? 63 - st_ : st_; Hbuf[tk_ * 68 + lane] = pk2(sre, sim); } } while (0)
#pragma unroll
        for (int j = 0; j < 4; ++j) {
#pragma unroll
            for (int q = 0; q < 4; ++q) S5_STEP(G1r[4 * j + q], G1i[4 * j + q], 8 * j + q);
#pragma unroll
            for (int q = 0; q < 4; ++q) S5_STEP(G2r[4 * j + q], G2i[4 * j + q], 8 * j + 4 + q);
        }
#undef S5_STEP
    }
}
template <bool WRITE_H> __device__ __forceinline__ void run_chunk(const Par& P, const bf16* U, int row0, int g, int dir, int lane, float& sre, float& sim, LAS unsigned* Hbuf) {
    bf16x8 A2[2]; load_chunk(U, row0, g, dir, lane, A2); run_chunk_pre<WRITE_H>(P, A2, dir, lane, sre, sim, Hbuf);
}
}

__device__ __forceinline__ void s1_phase(Frame& F, int ei) {
    const int gw = F.vcu * NWAVES + F.wave, NGW = F.G * NWAVES;
    const bf16* U = WSP(bf16, WS_BIG); float2* SE = WSP(float2, WS_SE);
    int cur = -1; s5::Par P;
    constexpr int NTASK = 2 * S5G * BATCH * NTC;
    for (int task = gw; task < NTASK; task += 2 * NGW) {
        const int dg = task % 128, idx = task / 128, dir = dg >> 6, g = dg & 63, b = idx / NTC, tc = idx % NTC;
        const int task2 = task + NGW; const bool has2 = task2 < NTASK; const int idx2 = has2 ? task2 / 128 : idx, b2 = idx2 / NTC, tc2 = idx2 % NTC;
        bf16x8 Aa[2], Ab[2];
        s5::load_chunk(U, s5::chunk_row0(b, tc), g, dir, F.lane, Aa); s5::load_chunk(U, s5::chunk_row0(b2, tc2), g, dir, F.lane, Ab);
        if (dg != cur) { s5::load_par(F.A, ei, dir, g, F.lane, P); cur = dg;
            if (idx == 0) { bf16x8 C[4]; s5::cfrags(F.A, ei, dir, g, F.lane, C); s5::table_store(F.ws + WS_MODP, dg, F.lane, P, C); } }
        { float sre = 0.f, sim = 0.f;
          s5::run_chunk_pre<false>(P, Aa, dir, F.lane, sre, sim, nullptr);
          SE[(((size_t)(b * 2 + dir) * S5G + g) * NTC + tc) * S5P + F.lane] = make_float2(sre, sim); }
        if (has2) { float sre = 0.f, sim = 0.f;
          s5::run_chunk_pre<false>(P, Ab, dir, F.lane, sre, sim, nullptr);
          SE[(((size_t)(b2 * 2 + dir) * S5G + g) * NTC + tc2) * S5P + F.lane] = make_float2(sre, sim); }
    }
    bf16* MIXA = WSP(bf16, WS_MIXA);
    const float* cw = F.A.in[22] + (size_t)ei * 3 * S5W; const float* cb = F.A.in[23] + (size_t)ei * S5W;
    const int c0 = F.lane * 16;
    f32x4 w0[4], w1[4], w2[4], wb4[4];
#pragma unroll
    for (int q = 0; q < 4; ++q) { w0[q] = *(const f32x4*)(cw + c0 + 4 * q); w1[q] = *(const f32x4*)(cw + S5W + c0 + 4 * q); w2[q] = *(const f32x4*)(cw + 2 * S5W + c0 + 4 * q); wb4[q] = *(const f32x4*)(cb + c0 + 4 * q); }
    for (int row = gw; row < TT; row += NGW) {
        const int t = row < TLAT ? (row & (SEQ - 1)) : ((row - TLAT) & (CTXL - 1)), len = row < TLAT ? SEQ : CTXL;
        const bool hp = t > 0, hn = t < len - 1;
        const bf16* pr = U + (size_t)row * MIXIN;
        v4u bgv[2], cg0v[2], v0v[2], cg1v[2], v1v[2], cg2v[2], v2v[2];
#pragma unroll
        for (int hh = 0; hh < 2; ++hh) { const int c = c0 + 8 * hh;
            bgv[hh] = *(const v4u*)(pr + 1024 + c); cg1v[hh] = *(const v4u*)(pr + 2048 + c); v1v[hh] = *(const v4u*)(pr + 3072 + c);
            cg0v[hh] = (v4u){0, 0, 0, 0}; v0v[hh] = cg0v[hh]; cg2v[hh] = cg0v[hh]; v2v[hh] = cg0v[hh];
            if (hp) { cg0v[hh] = *(const v4u*)(pr - MIXIN + 2048 + c); v0v[hh] = *(const v4u*)(pr - MIXIN + 3072 + c); }
            if (hn) { cg2v[hh] = *(const v4u*)(pr + MIXIN + 2048 + c); v2v[hh] = *(const v4u*)(pr + MIXIN + 3072 + c); } }
#pragma unroll
        for (int hh = 0; hh < 2; ++hh) { const int c = c0 + 8 * hh;
            const v4u bg = bgv[hh], cg0 = cg0v[hh], v0 = v0v[hh], cg1 = cg1v[hh], v1 = v1v[hh], cg2 = cg2v[hh], v2 = v2v[hh];
            float o[8];
#pragma unroll
            for (int e = 0; e < 4; ++e) { const unsigned wb = bg[e], a0 = cg0[e], b0 = v0[e], a1 = cg1[e], b1 = v1[e], a2 = cg2[e], b2 = v2[e]; const int q = 2 * hh + (e >> 1), z = 2 * (e & 1);
                o[2 * e] = bflo(wb) * (w0[q][z] * (bflo(a0) * bflo(b0)) + w1[q][z] * (bflo(a1) * bflo(b1)) + w2[q][z] * (bflo(a2) * bflo(b2)) + wb4[q][z]);
                o[2 * e + 1] = bfhi(wb) * (w0[q][z + 1] * (bfhi(a0) * bfhi(b0)) + w1[q][z + 1] * (bfhi(a1) * bfhi(b1)) + w2[q][z + 1] * (bfhi(a2) * bfhi(b2)) + wb4[q][z + 1]); }
            v4u w; w.x = pk2(o[0], o[1]); w.y = pk2(o[2], o[3]); w.z = pk2(o[4], o[5]); w.w = pk2(o[6], o[7]);
            *(v4u*)(MIXA + (size_t)row * DM + S5W + c) = w; }
    }
}
__device__ __forceinline__ void s2_phase(Frame& F, int ei) {
    if (F.wave != 0) return;
    const float2* SE = WSP(float2, WS_SE); float2* SC = WSP(float2, WS_SC);
    for (int combo = blockIdx.x; combo < BATCH * 2 * S5G; combo += F.G) {
        const int b = combo >> 7, dir = (combo >> 6) & 1, g = combo & 63, base = (ei * 2 + dir) * S5G + g;
        float ar, ai, cr, ci; s5::discretize(F.A.in[12][base * S5P + F.lane], F.A.in[13][base * S5P + F.lane], expf(F.A.in[14][base]), ar, ai, cr, ci);
#pragma unroll
        for (int q = 0; q < 6; ++q) { const float nr = ar * ar - ai * ai, ni = 2.0f * ar * ai; ar = nr; ai = ni; }
        const size_t off = ((size_t)(b * 2 + dir) * S5G + g) * NTC * S5P + F.lane;
        float sre = 0.f, sim = 0.f; asm volatile("" : "+v"(sre), "+v"(sim));
        for (int k0 = 0; k0 < NTC; k0 += 12) {
            float2 e[12];
#pragma unroll
            for (int q = 0; q < 12; ++q) { const int k = k0 + q; const int tc = dir ? (NTC - 1 - k) : (k < 4 ? 128 + k : k - 4); e[q] = SE[off + (size_t)tc * S5P]; }
#pragma unroll
            for (int q = 0; q < 12; ++q) { const int k = k0 + q; const int tc = dir ? (NTC - 1 - k) : (k < 4 ? 128 + k : k - 4);
                SC[off + (size_t)tc * S5P] = make_float2(sre, sim);
                const float nr = ar * sre - ai * sim + e[q].x, ni = ar * sim + ai * sre + e[q].y; sre = nr; sim = ni; }
        }
    }
}
__device__ __forceinline__ float gelu_tanh(float x) { const float u = 0.7978845608028654f * (x + 0.044715f * x * x * x); const float e = __expf(2.0f * u); const float t = 1.0f - 2.0f / (e + 1.0f); return 0.5f * x * (1.0f + t); }
__device__ __forceinline__ void s3_phase(Frame& F, int ei) {
    const int gw = F.vcu * NWAVES + F.wave, NGW = F.G * NWAVES;
    const bf16* U = WSP(bf16, WS_BIG); const float2* SC = WSP(float2, WS_SC); bf16* Z = WSP(bf16, WS_Z);
    const unsigned char* tab = F.ws + WS_MODP;
    LAS unsigned* Hbuf = (LAS unsigned*)(F.lds + F.wave * (64 * 68 * 4));
    LAS float* Ybuf = (LAS float*)Hbuf;
    const int fr = F.lane & 15, kq = F.lane >> 4;
    constexpr int NTASK = S5G * BATCH * NTC;
    s5::Par Pd[2]; bf16x8 Cd[2][4];
#pragma unroll
    for (int dir = 0; dir < 2; ++dir) s5::table_load(tab, dir * S5G + (gw % S5G), F.lane, Pd[dir], Cd[dir]);
    for (int task = gw; task < NTASK; task += NGW) {
        const int g = task % S5G, idx = task / S5G, b = idx / NTC, tc = idx % NTC;
        const int row0 = s5::chunk_row0(b, tc);
        f32x4 yacc[4] = {{0, 0, 0, 0}, {0, 0, 0, 0}, {0, 0, 0, 0}, {0, 0, 0, 0}};
        bf16x8 Ad[2][2]; s5::load_chunk(U, row0, g, 0, F.lane, Ad[0]); s5::load_chunk(U, row0, g, 1, F.lane, Ad[1]);
        float2 cin[2];
#pragma unroll
        for (int dir = 0; dir < 2; ++dir) cin[dir] = SC[(((size_t)(b * 2 + dir) * S5G + g) * NTC + tc) * S5P + F.lane];
        const v4u u0 = *(const v4u*)(U + (size_t)(row0 + F.lane) * MIXIN + g * S5H), u1 = *(const v4u*)(U + (size_t)(row0 + F.lane) * MIXIN + g * S5H + 8);
#pragma unroll
        for (int dir = 0; dir < 2; ++dir) {
            const s5::Par& P = Pd[dir]; const bf16x8 (&C)[4] = Cd[dir];
            float sre = cin[dir].x, sim = cin[dir].y;
            s5::run_chunk_pre<true>(P, Ad[dir], dir, F.lane, sre, sim, Hbuf);
            LDS_WAIT(); asm volatile("" ::: "memory");
#pragma unroll
            for (int tb = 0; tb < 4; ++tb)
#pragma unroll
                for (int ks = 0; ks < 4; ++ks) { const bf16x8 a = *(const LAS bf16x8*)(Hbuf + (16 * tb + fr) * 68 + 16 * ks + 4 * kq);
                    yacc[tb] = __builtin_amdgcn_mfma_f32_16x16x32_bf16(a, C[ks], yacc[tb], 0, 0, 0); }
            LDS_WAIT(); asm volatile("" ::: "memory");
        }
#pragma unroll
        for (int tb = 0; tb < 4; ++tb)
#pragma unroll
            for (int e = 0; e < 4; ++e) Ybuf[(16 * tb + 4 * kq + e) * 20 + fr] = yacc[tb][e];
        LDS_WAIT(); asm volatile("" ::: "memory");
        { const size_t row = (size_t)(row0 + F.lane);
          const float* dp = F.A.in[19] + ei * S5W + g * S5H;
          float z[16];
#pragma unroll
          for (int q = 0; q < 4; ++q) { const f32x4 y = *(const LAS f32x4*)(Ybuf + F.lane * 20 + 4 * q); const f32x4 d = *(const f32x4*)(dp + 4 * q);
              const unsigned w0 = q < 2 ? u0[2 * q] : u1[2 * q - 4], w1 = q < 2 ? u0[2 * q + 1] : u1[2 * q - 3];
              z[4 * q] = gelu_tanh(y[0] + d[0] * bflo(w0)); z[4 * q + 1] = gelu_tanh(y[1] + d[1] * bfhi(w0)); z[4 * q + 2] = gelu_tanh(y[2] + d[2] * bflo(w1)); z[4 * q + 3] = gelu_tanh(y[3] + d[3] * bfhi(w1)); }
          v4u o0, o1; o0.x = pk2(z[0], z[1]); o0.y = pk2(z[2], z[3]); o0.z = pk2(z[4], z[5]); o0.w = pk2(z[6], z[7]); o1.x = pk2(z[8], z[9]); o1.y = pk2(z[10], z[11]); o1.z = pk2(z[12], z[13]); o1.w = pk2(z[14], z[15]);
          *(v4u*)(Z + row * S5W + g * S5H) = o0; *(v4u*)(Z + row * S5W + g * S5H + 8) = o1; }
        LDS_WAIT(); asm volatile("" ::: "memory");
    }
}

__device__ __forceinline__ void attn_combine_block(Frame& F, const bf16* OC, bf16* AO, int row0, int h, int oi, float lam_init) {
    const int e0 = (F.lane & 15) * 8, sub = F.lane >> 4;
    const float* lv = F.A.in[26] + (size_t)oi * 4 * 64;
    const float lam = expf(wave_sum(lv[F.lane] * lv[64 + F.lane])) - expf(wave_sum(lv[128 + F.lane] * lv[192 + F.lane])) + lam_init;
    float g[8];
    { const float* sl = F.A.in[27] + (size_t)oi * 128 + e0;
#pragma unroll
      for (int e = 0; e < 8; ++e) g[e] = sl[e] * (1.0f - lam_init); }
#pragma unroll 2
    for (int it = 0; it < 8; ++it) { const size_t row = (size_t)(row0 + it * 32 + F.wave * 4 + sub);
        const v4u a = *(const v4u*)(OC + row * 4096 + h * 256 + e0), bq = *(const v4u*)(OC + row * 4096 + h * 256 + 128 + e0);
        float d[8]; float ss = 0.f;
#pragma unroll
        for (int e = 0; e < 4; ++e) { d[2 * e] = bflo(a[e]) - lam * bflo(bq[e]); d[2 * e + 1] = bfhi(a[e]) - lam * bfhi(bq[e]); ss += d[2 * e] * d[2 * e] + d[2 * e + 1] * d[2 * e + 1]; }
        ss += __shfl_xor(ss, 1); ss += __shfl_xor(ss, 2); ss += __shfl_xor(ss, 4); ss += __shfl_xor(ss, 8);
        const float r = rsqrtf(ss * (1.0f / 128.0f) + EPS);
        v4u w; w.x = pk2(d[0] * r * g[0], d[1] * r * g[1]); w.y = pk2(d[2] * r * g[2], d[3] * r * g[3]); w.z = pk2(d[4] * r * g[4], d[5] * r * g[5]); w.w = pk2(d[6] * r * g[6], d[7] * r * g[7]);
        *(v4u*)(AO + row * DM + h * 128 + e0) = w; }
}
__device__ __forceinline__ void attn_phase(Frame& F, int oi, float lam_init, bool ctx_queries) {
    const bf16* QKV = WSP(bf16, WS_BIG); bf16* OC = WSP(bf16, WS_OC); bf16* AO = WSP(bf16, WS_MIXA);
    char* lds = (char*)F.lds;
    const int npairs = BATCH * 16 * 32 + (ctx_queries ? BATCH * 16 : 0);
    for (int pair = F.vcu; pair < npairs; pair += F.G) {
        int qrow0, h, lat0, nlat, ctx0, NT;
        if (pair < BATCH * 16 * 32) { const int qb = pair & 31, hb = pair >> 5, b = hb >> 4; h = hb & 15;
            qrow0 = b * SEQ + qb * 256; lat0 = b * SEQ; nlat = 128; ctx0 = TLAT + b * CTXL; NT = 132; }
        else { const int hb = pair - BATCH * 16 * 32, b = hb >> 4; h = hb & 15;
            qrow0 = TLAT + b * CTXL; lat0 = 0; nlat = 0; ctx0 = TLAT + b * CTXL; NT = 4; }
#pragma unroll 1
        for (int c = 0; c < 2; ++c)
            att::attn_unit(QKV, OC, qrow0, h * 128 + c * 64, DM + h * 128 + c * 64, 2 * DM + h * 128, h * 256 + c * 128, lat0, nlat, ctx0, NT, lds, F.tid);
        attn_combine_block(F, OC, AO, qrow0, h, oi, lam_init);
    }
}
__global__ void __launch_bounds__(NWAVES * 64, 2) mk_fwd(Args args) {
    extern __shared__ __attribute__((aligned(16))) unsigned char lds[];
    Frame F{args};
    F.lds = (LAS unsigned char*)lds;
    F.tid = threadIdx.x; F.lane = F.tid & 63; F.wave = __builtin_amdgcn_readfirstlane(F.tid >> 6);
    F.G = gridDim.x; { const int bx = blockIdx.x; F.vcu = (F.G % 8 == 0) ? (bx % 8) * (F.G / 8) + bx / 8 : bx; }
    F.ws = args.ws; F.out = args.out;
    volatile LAS unsigned* MISC = (volatile LAS unsigned*)(F.lds + MISC_OFF);
    for (int u = F.tid; u < (LDS_BYTES - LDSCTL_OFF) / 4; u += NWAVES * 64) ((LAS unsigned*)(F.lds + LDSCTL_OFF))[u] = 0u;
    __syncthreads();
    const int lo = args.ph_lo, hi = args.ph_hi;
    XcdBarrier bar; bar.bar = (unsigned*)(F.ws + WS_CTL) + CW_BAR; bar.x = 0; bar.st = nullptr;
    if (hi - lo > 1) bar = xcd_barrier_post((unsigned*)(F.ws + WS_CTL) + CW_BAR, MISC + 8);
    int ph = 0;
#define PH_BEGIN if (ph >= lo && ph < hi) { { int t_ = threadIdx.x; asm volatile("" : "+v"(t_)); F.tid = t_; F.lane = t_ & 63; F.wave = __builtin_amdgcn_readfirstlane(t_ >> 6); \
        GAS unsigned char* w_ = (GAS unsigned char*)args.ws; asm volatile("" : "+s"(w_)); F.ws = (unsigned char*)w_; }
#define PH_END   if (ph + 1 < hi) xcd_barrier(bar); } ++ph;

    PH_BEGIN p0_prologue(F); PH_END
    PH_BEGIN p1_ada_reduce(F); PH_END
    PH_BEGIN resid_norm_phase(F, -1); PH_END

    for (int sub = 0; sub < NSUB; ++sub) {
        const int layer = sub / 3, s = sub % 3;
        const bool mix_ctx = layer < DEPTH - 1;
        const bool need_ctx = mix_ctx || s == 0;
        if (s != 1) {
            const int lh = layer * 2 + (s >> 1);
            constexpr int NCG = 2 * (2 * FF / 256), NCS = (TCTX / 256) * (DM / 256) * NZ_DOWN;
            unsigned* hcnt = (unsigned*)(F.ws + WS_CTL) + CW_HOST + 64 * sub;
            for (int part = 0; part < 2; ++part) {
                PH_BEGIN
                    const bool cg = need_ctx && (int)blockIdx.x < NCG;
                    if (part == 0 || cg) {
                        pg8::Gemm g{WSP(const pg8::bf16_t, WS_H), WSP(const pg8::bf16_t, WS_WGU + lh * WGU_ONE), TT, 2 * FF, DM, DM}; pg8::StaticOrder S;
                        if (part == 0) S.init(TLAT, 2 * FF, F.G, (int)blockIdx.x, 0, 8); else S.init(TCTX, 2 * FF, NCG, (int)blockIdx.x, TLAT / 256);
                        pg8::EpiSwiGLU E{WSP(pg8::bf16_t, WS_BIG), FF};
                        pg8::gemm_phase<pg8::EpiSwiGLU, pg8::StaticOrder, true, true>(F.lds, g, S, E);
                    }
                    if (part == 1) {
                        if (cg) host_arrive(hcnt);
                        pg8::Gemm g{WSP(const pg8::bf16_t, WS_BIG), WSP(const pg8::bf16_t, WS_WD + lh * WD_ONE), TLAT, DM, FF, FF}; pg8::StaticOrder S; S.init(TLAT, DM, F.G, (int)blockIdx.x);
                        pg8::EpiPlain E{WSP(pg8::bf16_t, WS_Y), DM};
                        pg8::gemm_phase<pg8::EpiPlain, pg8::StaticOrder, true, true>(F.lds, g, S, E);
                        const int cs = (int)blockIdx.x - NCG;
                        if (need_ctx && cs >= 0 && cs < NCS) {
                            host_wait(hcnt, (unsigned)NCG);
                            pg8::Gemm g2{WSP(const pg8::bf16_t, WS_BIG), WSP(const pg8::bf16_t, WS_WD + lh * WD_ONE), TT, DM, FF / NZ_DOWN, FF}; pg8::SplitOrder S2; S2.init(TLAT / 256, TCTX / 256, DM, NZ_DOWN, NCS, cs);
                            pg8::EpiPartial E2{WSP(float, WS_PART), DM, TLAT, (size_t)TCTX * DM};
                            pg8::gemm_phase<pg8::EpiPartial, pg8::SplitOrder, true, true>(F.lds, g2, S2, E2);
                        }
                    }
                PH_END
            }
        } else if ((layer & 1) == 0) {
            const int ei = layer >> 1;
            PH_BEGIN
                pg8::Gemm g{WSP(const pg8::bf16_t, WS_H), WSP(const pg8::bf16_t, WS_WIN + (size_t)ei * MIXIN * DM * 2), TT, MIXIN, DM, DM}; pg8::StaticOrder S; S.init(TT, MIXIN, F.G, (int)blockIdx.x);
                pg8::EpiPlain E{WSP(pg8::bf16_t, WS_BIG), MIXIN};
                pg8::gemm_phase<pg8::EpiPlain, pg8::StaticOrder, true, true>(F.lds, g, S, E);
            PH_END
            PH_BEGIN s1_phase(F, ei); PH_END
            PH_BEGIN s2_phase(F, ei); PH_END
            PH_BEGIN s3_phase(F, ei); PH_END
            PH_BEGIN
                pg8::Gemm g{WSP(const pg8::bf16_t, WS_Z), WSP(const pg8::bf16_t, WS_WGLU + (size_t)ei * S5W * S5W * 2), TT, S5W, S5W, S5W}; pg8::StaticOrder S; S.init(TT, S5W, F.G, (int)blockIdx.x);
                pg8::EpiGLU E{WSP(const pg8::bf16_t, WS_Z), S5W, F.A.in[21] + (size_t)ei * S5W, WSP(pg8::bf16_t, WS_MIXA), DM};
                pg8::gemm_phase<pg8::EpiGLU, pg8::StaticOrder, true, true>(F.lds, g, S, E);
            PH_END
            PH_BEGIN
                const pg8::bf16_t* Wp = WSP(const pg8::bf16_t, WS_WOUT + (size_t)ei * DM * MIXOUT * 2);
                pg8::Gemm g{WSP(const pg8::bf16_t, WS_MIXA), Wp, TLAT, DM, MIXOUT, MIXOUT}; pg8::StaticOrder S; S.init(TLAT, DM, F.G, (int)blockIdx.x);
                pg8::EpiPlain E{WSP(pg8::bf16_t, WS_Y), DM};
                pg8::gemm_phase<pg8::EpiPlain, pg8::StaticOrder, true, true>(F.lds, g, S, E);
                pg8::Gemm g2{WSP(const pg8::bf16_t, WS_MIXA), Wp, TT, DM, MIXOUT / NZ_OUT, MIXOUT}; pg8::SplitOrder S2; S2.init(TLAT / 256, TCTX / 256, DM, NZ_OUT, F.G, (int)blockIdx.x);
                pg8::EpiPartial E2{WSP(float, WS_PART), DM, TLAT, (size_t)TCTX * DM};
                if (mix_ctx) pg8::gemm_phase<pg8::EpiPartial, pg8::SplitOrder, true, true>(F.lds, g2, S2, E2);
            PH_END
        } else {
            const int oi = layer >> 1;
            PH_BEGIN
                pg8::Gemm g{WSP(const pg8::bf16_t, WS_H), WSP(const pg8::bf16_t, WS_WQKV + (size_t)oi * 3 * DM * DM * 2), TT, 3 * DM, DM, DM}; pg8::StaticOrder S; S.init(TT, 3 * DM, F.G, (int)blockIdx.x);
                pg8::EpiQKV E{WSP(pg8::bf16_t, WS_BIG), 3 * DM, WSP(const float, WS_ROPE), 0.125f * 1.4426950408889634f};
                pg8::gemm_phase<pg8::EpiQKV, pg8::StaticOrder, true, true>(F.lds, g, S, E);
            PH_END
            PH_BEGIN attn_phase(F, oi, oi == 0 ? 0.35550906759096934f : 0.5560582041556406f, mix_ctx); PH_END
            PH_BEGIN
                const pg8::bf16_t* Wp = WSP(const pg8::bf16_t, WS_WO + (size_t)oi * DM * DM * 2);
                pg8::Gemm g{WSP(const pg8::bf16_t, WS_MIXA), Wp, TLAT, DM, DM, DM}; pg8::StaticOrder S; S.init(TLAT, DM, F.G, (int)blockIdx.x);
                pg8::EpiPlain E{WSP(pg8::bf16_t, WS_Y), DM};
                pg8::gemm_phase<pg8::EpiPlain, pg8::StaticOrder, true, true>(F.lds, g, S, E);
                pg8::Gemm g2{WSP(const pg8::bf16_t, WS_MIXA), Wp, TT, DM, DM / NZ_OUT, DM}; pg8::SplitOrder S2; S2.init(TLAT / 256, TCTX / 256, DM, NZ_OUT, F.G, (int)blockIdx.x);
                pg8::EpiPartial E2{WSP(float, WS_PART), DM, TLAT, (size_t)TCTX * DM};
                pg8::gemm_phase<pg8::EpiPartial, pg8::SplitOrder, true, true>(F.lds, g2, S2, E2);
            PH_END
        }
        PH_BEGIN resid_norm_phase(F, sub, (mix_ctx || s == 0) ? TCTX : 0); PH_END
    }
#undef PH_BEGIN
#undef PH_END
}

static int count_phases() { int n = 3; for (int sub = 0; sub < NSUB; ++sub) { const int layer = sub / 3, s = sub % 3; n += (s != 1) ? 2 : ((layer & 1) == 0 ? 6 : 3); n += 1; } return n; }
extern "C" void kernel_launch(void* const* d_in, const int* in_sizes, int n_in, void* d_out, int out_size, void* d_ws, size_t ws_size, hipStream_t stream) {
    static int grid = 0;
    if (grid == 0) {
        if (n_in != 28 || in_sizes[0] != TLAT * DM || out_size != TLAT * DM || ws_size < WS_END) { fprintf(stderr, "kernel_launch: shape mismatch: n_in %d in0 %d out %d ws %zu (need %zu)\n", n_in, n_in > 0 ? in_sizes[0] : -1, out_size, ws_size, (size_t)WS_END); grid = -1; return; }
        int dev = 0, cus = 0, per_cu = 0;
        if (hipGetDevice(&dev) != hipSuccess || hipDeviceGetAttribute(&cus, hipDeviceAttributeMultiprocessorCount, dev) != hipSuccess) { grid = -1; return; }
        if (hipFuncSetAttribute((const void*)mk_fwd, hipFuncAttributeMaxDynamicSharedMemorySize, LDS_BYTES) != hipSuccess) { fprintf(stderr, "kernel_launch: hipFuncSetAttribute failed\n"); grid = -1; return; }
        if (hipOccupancyMaxActiveBlocksPerMultiprocessor(&per_cu, (const void*)mk_fwd, NWAVES * 64, LDS_BYTES) != hipSuccess || per_cu < 1) { fprintf(stderr, "kernel_launch: occupancy query says %d\n", per_cu); }
        (void)hipGetLastError();
        grid = cus;
    }
    if (grid < 0) return;
    if (hipMemsetAsync((char*)d_ws + WS_CTL, 0, CTL_ZERO_BYTES, stream) != hipSuccess) return;
    Args a{};
    for (int i = 0; i < 28; ++i) a.in[i] = (const float*)d_in[i];
    a.out = (float*)d_out; a.ws = (unsigned char*)d_ws;
    const int nph = count_phases();
#if ONE_LAUNCH
    a.ph_lo = 0; a.ph_hi = nph;
    hipLaunchKernelGGL(mk_fwd, dim3(grid), dim3(NWAVES * 64), LDS_BYTES, stream, a);
#else
    for (int p = 0; p < nph; ++p) { a.ph_lo = p; a.ph_hi = p + 1; hipLaunchKernelGGL(mk_fwd, dim3(grid), dim3(NWAVES * 64), LDS_BYTES, stream, a); }
#endif
    const hipError_t le = hipPeekAtLastError();
    if (le != hipSuccess) fprintf(stderr, "kernel_launch: launch failed: %s\n", hipGetErrorName(le));
}
```

```cpp
#include <hip/hip_runtime.h>
#include <cstdio>
#include <cstdint>
#include <cmath>
namespace pg8 {
#define PG8_LAS __attribute__((address_space(3)))
typedef unsigned short bf16_t;
typedef short bf16x8 __attribute__((ext_vector_type(8)));
typedef float f32x4 __attribute__((ext_vector_type(4)));
typedef unsigned u32x4 __attribute__((ext_vector_type(4)));
constexpr int BM = 256, BK = 64, HALF = 128, HTB = HALF * BK * 2  , STAGE_BYTES = 8 * HTB, NXCD = 8, WGM = 4;

__host__ __device__ __forceinline__ int lds_byte(int r, int c) { const int st = (r >> 4) * 2 + (c >> 5), rr = r & 15, cc = c & 31, ob = rr * 64 + cc * 2; return st * 1024 + (ob ^ (((ob >> 9) & 1) << 5)); }
__host__ __device__ __forceinline__ void stage_rc(int b, int& R, int& C) { const int st = b / 1024, sb = b % 1024, swz = sb ^ (((sb >> 9) & 1) << 5); R = (st >> 1) * 16 + swz / 64; C = (st & 1) * 32 + (swz % 64) / 2; }
__host__ __device__ __forceinline__ int perm32(int rho) { const int n = rho >> 4, i = rho & 15; return 8 * (i >> 2) + 4 * n + (i & 3); }

struct Unit { int pm, pn, kz, kind; };
struct Gemm { const bf16_t* A; const bf16_t* Bt; int M, N, K, ld; };

struct StaticOrder {
    int nM, nN, nwg, G, c, pm0, wgm;
    __host__ __device__ void init(int M, int N, int G_, int c_, int pm0_ = 0, int wgm_ = WGM) { nM = M / BM; nN = N / BM; nwg = nM * nN; G = G_; c = c_; pm0 = pm0_; wgm = wgm_; }
    __host__ __device__ bool next(int i, Unit& u) const {
        const long L = (long)i * G + c; if (L >= nwg) return false;
        int wgid = (int)L; { const int q = nwg / NXCD, r = nwg % NXCD, xcd = wgid % NXCD, off = wgid / NXCD; wgid = (xcd < r ? xcd * (q + 1) : r * (q + 1) + (xcd - r) * q) + off; }
        const int nig = wgm * nN, gid = wgid / nig, fm = gid * wgm, gsz = (nM - fm) < wgm ? (nM - fm) : wgm;
        u.pm = pm0 + fm + ((wgid % nig) % gsz); u.pn = (wgid % nig) / gsz; u.kz = 0; u.kind = 0; return true;
    }
    __device__ __forceinline__ void a_ready(const Unit&) const {}
    __device__ __forceinline__ void done(const Unit&) const {}
};

__device__ __forceinline__ unsigned cvt_pk_bf16(float lo, float hi) { unsigned r; asm volatile("v_cvt_pk_bf16_f32 %0, %1, %2" : "=v"(r) : "v"(lo), "v"(hi)); return r; }
typedef float f32x2 __attribute__((ext_vector_type(2)));
typedef unsigned u32x2 __attribute__((ext_vector_type(2)));
__device__ __forceinline__ float sigmoid_f(float v) { return __builtin_amdgcn_rcpf(1.0f + __builtin_amdgcn_exp2f(-1.4426950408889634f * v)); }
__device__ __forceinline__ float bf_lo(unsigned w) { return __uint_as_float(w << 16); }
__device__ __forceinline__ float bf_hi(unsigned w) { return __uint_as_float(w & 0xffff0000u); }
__device__ __forceinline__ u32x4 pack8(const f32x4 v0, const f32x4 v1) { u32x4 w; w.x = cvt_pk_bf16(v0[0], v0[1]); w.y = cvt_pk_bf16(v0[2], v0[3]); w.z = cvt_pk_bf16(v1[0], v1[1]); w.w = cvt_pk_bf16(v1[2], v1[3]); return w; }

struct EpiPlain {
    static constexpr bool PERM = true, AFTER_DRAIN = false;
    bf16_t* O; int ldc;
    __device__ __forceinline__ void operator()(const f32x4 (&acc)[2][2][4][2], const Unit& u, int wr, int wc, int fr, int fq) const {
        const int row0 = u.pm * BM + wr * 64 + fr, col0 = u.pn * BM + wc * 32 + 8 * fq;
#pragma unroll
        for (int ai = 0; ai < 2; ++ai)
#pragma unroll
            for (int m = 0; m < 4; ++m) { bf16_t* rowp = O + (size_t)(row0 + ai * HALF + m * 16) * ldc + col0;
#pragma unroll
                for (int bj = 0; bj < 2; ++bj) *(u32x4*)(rowp + bj * HALF) = pack8(acc[ai][bj][m][0], acc[ai][bj][m][1]); }
    }
};
struct EpiSwiGLU {
    static constexpr bool PERM = true, AFTER_DRAIN = false;
    bf16_t* O; int ldc;
    __device__ __forceinline__ void operator()(const f32x4 (&acc)[2][2][4][2], const Unit& u, int wr, int wc, int fr, int fq) const {
        const int row0 = u.pm * BM + wr * 64 + fr, col0 = u.pn * HALF + wc * 32 + 8 * fq;
#pragma unroll
        for (int ai = 0; ai < 2; ++ai)
#pragma unroll
            for (int m = 0; m < 4; ++m) { bf16_t* rowp = O + (size_t)(row0 + ai * HALF + m * 16) * ldc + col0;
                const f32x4 g0 = acc[ai][0][m][0], g1 = acc[ai][0][m][1];
                f32x4 t0 = g0 * -1.4426950408889634f, t1 = g1 * -1.4426950408889634f;
#pragma unroll
                for (int e = 0; e < 4; ++e) { t0[e] = __builtin_amdgcn_exp2f(t0[e]); t1[e] = __builtin_amdgcn_exp2f(t1[e]); }
                t0 = t0 + 1.0f; t1 = t1 + 1.0f;
#pragma unroll
                for (int e = 0; e < 4; ++e) { t0[e] = __builtin_amdgcn_rcpf(t0[e]); t1[e] = __builtin_amdgcn_rcpf(t1[e]); }
                const f32x4 h0 = (g0 * acc[ai][1][m][0]) * t0, h1 = (g1 * acc[ai][1][m][1]) * t1;
                *(u32x4*)rowp = pack8(h0, h1); }
    }
};
struct EpiGLU {
    static constexpr bool PERM = true, AFTER_DRAIN = false;
    const bf16_t* Z; int ldz; const float* bias; bf16_t* O; int ldo;
    __device__ __forceinline__ void operator()(const f32x4 (&acc)[2][2][4][2], const Unit& u, int wr, int wc, int fr, int fq) const {
        const int row0 = u.pm * BM + wr * 64 + fr, col0 = u.pn * BM + wc * 32 + 8 * fq;
        f32x4 bv[2][2];
#pragma unroll
        for (int bj = 0; bj < 2; ++bj)
#pragma unroll
            for (int n = 0; n < 2; ++n) bv[bj][n] = *(const f32x4*)(bias + col0 + bj * HALF + 4 * n);
#pragma unroll
        for (int ai = 0; ai < 2; ++ai)
#pragma unroll
            for (int m = 0; m < 4; ++m) { const size_t r = (size_t)(row0 + ai * HALF + m * 16);
#pragma unroll
                for (int bj = 0; bj < 2; ++bj) { const u32x4 zw = *(const u32x4*)(Z + r * ldz + col0 + bj * HALF);
                    const f32x4 v0 = acc[ai][bj][m][0] + bv[bj][0], v1 = acc[ai][bj][m][1] + bv[bj][1];
                    f32x4 o0, o1;
                    o0[0] = bf_lo(zw.x) * sigmoid_f(v0[0]); o0[1] = bf_hi(zw.x) * sigmoid_f(v0[1]); o0[2] = bf_lo(zw.y) * sigmoid_f(v0[2]); o0[3] = bf_hi(zw.y) * sigmoid_f(v0[3]);
                    o1[0] = bf_lo(zw.z) * sigmoid_f(v1[0]); o1[1] = bf_hi(zw.z) * sigmoid_f(v1[1]); o1[2] = bf_lo(zw.w) * sigmoid_f(v1[2]); o1[3] = bf_hi(zw.w) * sigmoid_f(v1[3]);
                    *(u32x4*)(O + r * ldo + col0 + bj * HALF) = pack8(o0, o1); } }
    }
};
struct EpiQKV {
    static constexpr bool PERM = true, AFTER_DRAIN = false;
    bf16_t* O; int ldc; const float* cs; float qscale;
    __device__ __forceinline__ void operator()(const f32x4 (&acc)[2][2][4][2], const Unit& u, int wr, int wc, int fr, int fq) const {
        const int row0 = u.pm * BM + wr * 64 + fr;
        if (u.pn >= 16) {
            const int col0 = u.pn * BM + wc * 32 + 8 * fq;
#pragma unroll
            for (int ai = 0; ai < 2; ++ai)
#pragma unroll
                for (int m = 0; m < 4; ++m) { bf16_t* rowp = O + (size_t)(row0 + ai * HALF + m * 16) * ldc + col0;
#pragma unroll
                    for (int bj = 0; bj < 2; ++bj) *(u32x4*)(rowp + bj * HALF) = pack8(acc[ai][bj][m][0], acc[ai][bj][m][1]); }
            return;
        }
        const float sc = (u.pn < 8) ? qscale : 1.0f;
        const bool rope = (u.pm < 64);
        const int col1 = u.pn * BM + 64 * wc + 8 * fq;
#pragma unroll
        for (int ai = 0; ai < 2; ++ai)
#pragma unroll
            for (int m = 0; m < 4; ++m) { const int row = row0 + ai * HALF + m * 16;
                f32x4 c0, s0, c1, s1;
                if (rope) { const int t = row & 8191; const int pos = (fq < 2) ? (t >> 6) : (t & 63);
                    const f32x4* tp = (const f32x4*)(cs + (size_t)(pos * 16 + 8 * (fq & 1)) * 2);
                    const f32x4 a = tp[0], b = tp[1], c = tp[2], d = tp[3];
                    c0 = (f32x4){a[0], a[2], b[0], b[2]}; s0 = (f32x4){a[1], a[3], b[1], b[3]}; c1 = (f32x4){c[0], c[2], d[0], d[2]}; s1 = (f32x4){c[1], c[3], d[1], d[3]};
                } else { c0 = c1 = (f32x4){1.f, 1.f, 1.f, 1.f}; s0 = s1 = (f32x4){0.f, 0.f, 0.f, 0.f}; }
                const f32x4 x10 = acc[ai][0][m][0], x11 = acc[ai][0][m][1], x20 = acc[ai][1][m][0], x21 = acc[ai][1][m][1];
                const f32x4 o10 = (x10 * c0 - x20 * s0) * sc, o11 = (x11 * c1 - x21 * s1) * sc, o20 = (x10 * s0 + x20 * c0) * sc, o21 = (x11 * s1 + x21 * c1) * sc;
                bf16_t* rowp = O + (size_t)row * ldc + col1;
                *(u32x4*)rowp = pack8(o10, o11); *(u32x4*)(rowp + 32) = pack8(o20, o21); }
    }
};

struct SplitOrder {
    int pm0, nN, nz, total, G, c;
    __host__ __device__ void init(int pm0_, int npm, int N, int nz_, int G_, int c_) { pm0 = pm0_; nN = N / BM; nz = nz_; total = npm * nN * nz; G = G_; c = c_; }
    __host__ __device__ bool next(int i, Unit& u) const { const long L = (long)i * G + c; if (L >= total) return false; const int l = (int)L; u.kz = l % nz; const int r = l / nz; u.pn = r % nN; u.pm = pm0 + r / nN; u.kind = 1; return true; }
    __device__ __forceinline__ void a_ready(const Unit&) const {}
    __device__ __forceinline__ void done(const Unit&) const {}
};
struct EpiPartial {
    static constexpr bool PERM = true, AFTER_DRAIN = false;
    float* P; int ldc, row0; size_t zstride;
    __device__ __forceinline__ void operator()(const f32x4 (&acc)[2][2][4][2], const Unit& u, int wr, int wc, int fr, int fq) const {
        const int r0 = u.pm * BM + wr * 64 + fr - row0, col0 = u.pn * BM + wc * 32 + 8 * fq;
        float* base = P + (size_t)u.kz * zstride;
#pragma unroll
        for (int ai = 0; ai < 2; ++ai)
#pragma unroll
            for (int m = 0; m < 4; ++m) { float* rowp = base + (size_t)(r0 + ai * HALF + m * 16) * ldc + col0;
#pragma unroll
                for (int bj = 0; bj < 2; ++bj) { *(f32x4*)(rowp + bj * HALF) = acc[ai][bj][m][0]; *(f32x4*)(rowp + bj * HALF + 4) = acc[ai][bj][m][1]; } }
    }
};

struct MixedOrder {
    StaticOrder A; SplitOrder B; int nA;
    __host__ __device__ void init(int M, int N, int pm0, int npm, int nz, int G, int c) { A.init(M, N, G, c); B.init(pm0, npm, N, nz, G, c); nA = (A.nwg > c) ? (A.nwg - c + G - 1) / G : 0; }
    __host__ __device__ bool next(int i, Unit& u) const { return i < nA ? A.next(i, u) : B.next(i - nA, u); }
    __device__ __forceinline__ void a_ready(const Unit&) const {}
    __device__ __forceinline__ void done(const Unit&) const {}
};

template <class Epi, class Sched, bool ALIGN_EPI = false, bool SP2 = false>
__device__ __forceinline__ void gemm_phase(PG8_LAS unsigned char* lds, const Gemm g, const Sched& S, const Epi& E) {
    int tid_ = threadIdx.x; asm volatile("" : "+v"(tid_));
    const int tid = tid_, wid = __builtin_amdgcn_readfirstlane(tid >> 6), lane = tid & 63, wr = wid >> 2, wc = wid & 3, fr = lane & 15, fq = lane >> 4;
    const int K = g.K, nt = K / BK;
    unsigned voffA[2], voffB[2];
#pragma unroll
    for (int i = 0; i < 2; ++i) { int R, C; stage_rc(tid * 16 + i * 8192, R, C); const int Rb = Epi::PERM ? ((R & ~31) + perm32(R & 31)) : R;
        voffA[i] = (unsigned)(R * g.ld + C) * 2u; voffB[i] = (unsigned)(Rb * g.ld + C) * 2u; }
    const size_t kstep = (size_t)(BK * 2);
    const size_t hstep = (size_t)HALF * g.ld * 2; const size_t zstep = (size_t)K * 2;
    const size_t tstep = 2 * hstep;
    const unsigned ldsw = (unsigned)wid * 1024u;
    const int aoff = lds_byte(wr * 64 + fr, fq * 8), boff = lds_byte(wc * 32 + fr, fq * 8);
#define PG8_SA(b, h) (((b) * 2 + (h)) * HTB)
#define PG8_SB(b, h) ((4 + (b) * 2 + (h)) * HTB)
#define PG8_STAGE(bufoff, gbase, voff) do { _Pragma("unroll") for (int _i = 0; _i < 2; ++_i) \
        __builtin_amdgcn_global_load_lds((const unsigned*)((const char*)(gbase) + (voff)[_i]), (PG8_LAS unsigned*)(lds + (bufoff) + ldsw + _i * 8192), 16, 0, 0); } while (0)
#define PG8_LDA(dst, b, h) do { _Pragma("unroll") for (int m = 0; m < 4; ++m) _Pragma("unroll") for (int k = 0; k < 2; ++k) dst[m][k] = *(const PG8_LAS bf16x8*)(lds + PG8_SA(b, h) + aoff + m * 2048 + k * 1024); } while (0)
#define PG8_LDB(dst, b, h) do { _Pragma("unroll") for (int n = 0; n < 2; ++n) _Pragma("unroll") for (int k = 0; k < 2; ++k) dst[n][k] = *(const PG8_LAS bf16x8*)(lds + PG8_SB(b, h) + boff + n * 2048 + k * 1024); } while (0)
#define PG8_MMA(ai, bj, At, Bt) do { __builtin_amdgcn_s_setprio(1); _Pragma("unroll") for (int m = 0; m < 4; ++m) _Pragma("unroll") for (int n = 0; n < 2; ++n) _Pragma("unroll") for (int k = 0; k < 2; ++k) \
        acc[ai][bj][m][n] = __builtin_amdgcn_mfma_f32_16x16x32_bf16(Bt[n][k], At[m][k], acc[ai][bj][m][n], 0, 0, 0); __builtin_amdgcn_s_setprio(0); } while (0)
#define PG8_WAIT_V(n) asm volatile("s_waitcnt vmcnt(" #n ")" ::: "memory")
#define PG8_WAIT_L(n) asm volatile("s_waitcnt lgkmcnt(" #n ")" ::: "memory")
#define PG8_BAR __builtin_amdgcn_s_barrier()
#define PG8_SCHED __builtin_amdgcn_sched_barrier(0)
    Unit cur, nxt; int ui = 0;
    if (!S.next(0, cur)) return;
    f32x4 acc[2][2][4][2];
#pragma unroll
    for (int a = 0; a < 2; ++a)
#pragma unroll
        for (int b = 0; b < 2; ++b)
#pragma unroll
            for (int m = 0; m < 4; ++m)
#pragma unroll
                for (int n = 0; n < 2; ++n) acc[a][b][m][n] = (f32x4){0.f, 0.f, 0.f, 0.f};
    bf16x8 At[4][2], B0[2][2], B1[2][2];
    const char* cA = (const char*)g.A + (size_t)cur.pm * tstep + (size_t)cur.kz * zstep; const char* cB = (const char*)g.Bt + (size_t)cur.pn * tstep + (size_t)cur.kz * zstep;
    S.a_ready(cur);
    if constexpr (SP2) {
        PG8_STAGE(PG8_SB(0, 0), cB, voffB); PG8_STAGE(PG8_SB(0, 1), cB + hstep, voffB); PG8_STAGE(PG8_SA(0, 0), cA, voffA); PG8_STAGE(PG8_SA(0, 1), cA + hstep, voffA);
        if (wr == 1) PG8_BAR;
        PG8_WAIT_V(2); PG8_BAR;
        PG8_STAGE(PG8_SB(1, 0), cB + kstep, voffB); PG8_STAGE(PG8_SA(1, 0), cA + kstep, voffA); PG8_STAGE(PG8_SB(1, 1), cB + hstep + kstep, voffB);
        PG8_WAIT_V(6); PG8_BAR;
    } else {
        PG8_STAGE(PG8_SB(0, 0), cB, voffB); PG8_STAGE(PG8_SA(0, 0), cA, voffA); PG8_STAGE(PG8_SB(0, 1), cB + hstep, voffB); PG8_STAGE(PG8_SA(0, 1), cA + hstep, voffA);
        if (wr == 1) PG8_BAR;
        PG8_WAIT_V(4); PG8_BAR;
        PG8_STAGE(PG8_SB(1, 0), cB + kstep, voffB); PG8_STAGE(PG8_SA(1, 0), cA + kstep, voffA); PG8_STAGE(PG8_SB(1, 1), cB + hstep + kstep, voffB);
        PG8_WAIT_V(6); PG8_BAR;
    }
    for (;;) {
        const bool has_next = S.next(ui + 1, nxt);
        const char* nA = has_next ? (const char*)g.A + (size_t)nxt.pm * tstep + (size_t)nxt.kz * zstep : cA; const char* nB = has_next ? (const char*)g.Bt + (size_t)nxt.pn * tstep + (size_t)nxt.kz * zstep : cB;
        for (int t = 0; t < nt; t += 2) {
            const bool last = (t == nt - 2);
            const char* a1 = cA + (size_t)(t + 1) * kstep;
            const char* a2 = last ? nA : cA + (size_t)(t + 2) * kstep; const char* b2 = last ? nB : cB + (size_t)(t + 2) * kstep;
            const char* a3 = a2 + kstep; const char* b3 = b2 + kstep;
            if (last && has_next) S.a_ready(nxt);
            if constexpr (SP2) {
            PG8_LDB(B0, 0, 0); PG8_LDB(B1, 0, 1); PG8_SCHED; PG8_LDA(At, 0, 0); PG8_STAGE(PG8_SA(1, 1), a1 + hstep, voffA);
            PG8_WAIT_V(8); PG8_WAIT_L(0); PG8_BAR; PG8_MMA(0, 0, At, B0); PG8_MMA(0, 1, At, B1); PG8_BAR; PG8_SCHED;
            PG8_LDA(At, 0, 1); PG8_STAGE(PG8_SB(0, 0), b2, voffB); PG8_STAGE(PG8_SB(0, 1), b2 + hstep, voffB); PG8_STAGE(PG8_SA(0, 0), a2, voffA);
            PG8_WAIT_V(8); PG8_WAIT_L(0); PG8_BAR; PG8_MMA(1, 0, At, B0); PG8_MMA(1, 1, At, B1); PG8_BAR; PG8_SCHED;
            PG8_LDB(B0, 1, 0); PG8_LDB(B1, 1, 1); PG8_SCHED; PG8_LDA(At, 1, 0); PG8_STAGE(PG8_SA(0, 1), a2 + hstep, voffA);
            PG8_WAIT_V(8); PG8_WAIT_L(0); PG8_BAR; PG8_MMA(0, 0, At, B0); PG8_MMA(0, 1, At, B1); PG8_BAR; PG8_SCHED;
            PG8_LDA(At, 1, 1); PG8_STAGE(PG8_SB(1, 0), b3, voffB); PG8_STAGE(PG8_SB(1, 1), b3 + hstep, voffB); PG8_STAGE(PG8_SA(1, 0), a3, voffA);
            PG8_WAIT_V(8); PG8_WAIT_L(0); PG8_BAR; PG8_MMA(1, 0, At, B0); PG8_MMA(1, 1, At, B1); PG8_BAR; PG8_SCHED;
            } else {
            PG8_LDB(B0, 0, 0); PG8_SCHED; PG8_LDA(At, 0, 0); PG8_STAGE(PG8_SA(1, 1), a1 + hstep, voffA);
            PG8_WAIT_L(8); PG8_BAR; PG8_WAIT_L(0); PG8_MMA(0, 0, At, B0); PG8_BAR; PG8_SCHED;
            PG8_LDB(B1, 0, 1); PG8_STAGE(PG8_SB(0, 0), b2, voffB);
            PG8_BAR; PG8_WAIT_L(0); PG8_MMA(0, 1, At, B1); PG8_BAR;
            PG8_LDA(At, 0, 1); PG8_STAGE(PG8_SA(0, 0), a2, voffA);
            PG8_BAR; PG8_WAIT_L(0); PG8_MMA(1, 0, At, B0); PG8_BAR; PG8_SCHED;
            PG8_STAGE(PG8_SB(0, 1), b2 + hstep, voffB);
            PG8_WAIT_V(6); PG8_BAR; PG8_MMA(1, 1, At, B1); PG8_BAR;
            PG8_LDB(B0, 1, 0); PG8_SCHED; PG8_LDA(At, 1, 0); PG8_STAGE(PG8_SA(0, 1), a2 + hstep, voffA);
            PG8_WAIT_L(8); PG8_BAR; PG8_WAIT_L(0); PG8_MMA(0, 0, At, B0); PG8_BAR; PG8_SCHED;
            PG8_LDB(B1, 1, 1); PG8_STAGE(PG8_SB(1, 0), b3, voffB);
            PG8_BAR; PG8_WAIT_L(0); PG8_MMA(0, 1, At, B1); PG8_BAR;
            PG8_LDA(At, 1, 1); PG8_STAGE(PG8_SA(1, 0), a3, voffA);
            PG8_BAR; PG8_WAIT_L(0); PG8_MMA(1, 0, At, B0); PG8_BAR; PG8_SCHED;
            PG8_STAGE(PG8_SB(1, 1), b3 + hstep, voffB);
            PG8_WAIT_V(6); PG8_BAR; PG8_MMA(1, 1, At, B1); PG8_BAR;
            }
        }
        if constexpr (ALIGN_EPI) { if (wr == 0) PG8_BAR; }
        if constexpr (!Epi::AFTER_DRAIN) { E(acc, cur, wr, wc, fr, fq); S.done(cur); }
        if (!has_next) break;
#pragma unroll
        for (int a = 0; a < 2; ++a)
#pragma unroll
            for (int b = 0; b < 2; ++b)
#pragma unroll
                for (int m = 0; m < 4; ++m)
#pragma unroll
                    for (int n = 0; n < 2; ++n) acc[a][b][m][n] = (f32x4){0.f, 0.f, 0.f, 0.f};
        cur = nxt; cA = nA; cB = nB; ++ui;
        if constexpr (ALIGN_EPI) { if (wr == 1) PG8_BAR; }
    }
    PG8_WAIT_V(0);
    if constexpr (!ALIGN_EPI) { if (wr == 0) PG8_BAR; }
    PG8_BAR;
    if constexpr (Epi::AFTER_DRAIN) { E.fused(acc, cur, wr, wc, fr, fq, lds, wid, lane); S.done(cur); }
#undef PG8_SA
#undef PG8_SB
#undef PG8_STAGE
#undef PG8_LDA
#undef PG8_LDB
#undef PG8_MMA
#undef PG8_WAIT_V
#undef PG8_WAIT_L
#undef PG8_BAR
#undef PG8_SCHED
}
}
namespace att {
typedef unsigned short bf16_t;
using bf16x8 = __attribute__((ext_vector_type(8))) short;
using s16x4  = __attribute__((ext_vector_type(4))) short;
using f32x16 = __attribute__((ext_vector_type(16))) float;
using u32x4  = __attribute__((ext_vector_type(4))) unsigned;
constexpr int NW = 8, QBLK = 32, KVBLK = 64;
constexpr int LDQ = 6144, LDO = 4096;
constexpr int SHM_V = KVBLK * 128 * 2, SHM_K = KVBLK * 64 * 2;
constexpr float THR = 8.f;
#define ASBAR() __builtin_amdgcn_sched_barrier(0)
__device__ __forceinline__ int crow(int r, int hi) { return (r & 3) + 8 * (r >> 2) + 4 * hi; }
__device__ __forceinline__ unsigned cvtpk(float lo, float hi) { unsigned r; asm volatile("v_cvt_pk_bf16_f32 %0, %1, %2" : "=v"(r) : "v"(lo), "v"(hi)); return r; }
template <bool FIRST = false> __device__ __forceinline__ void partialSM(f32x16& p0, f32x16& p1, float& m_reg, float& alpha, f32x16& negm) {
  float pmax = p0[0];
#pragma unroll
  for (int r = 1; r < 16; ++r) pmax = fmaxf(pmax, p0[r]);
#pragma unroll
  for (int r = 0; r < 16; ++r) pmax = fmaxf(pmax, p1[r]);
  { auto rr = __builtin_amdgcn_permlane32_swap(__float_as_uint(pmax), __float_as_uint(pmax), false, false);
    pmax = fmaxf(__uint_as_float(rr[0]), __uint_as_float(rr[1])); }
  if (!FIRST && __builtin_expect(__all(pmax <= THR), 1)) { alpha = 1.f; }
  else { const float dl = FIRST ? pmax : fmaxf(pmax, 0.f); m_reg += dl;
#pragma unroll
    for (int r = 0; r < 16; ++r) { p0[r] -= dl; p1[r] -= dl; }
#pragma unroll
    for (int r = 0; r < 16; ++r) negm[r] = -m_reg;
    asm volatile("" : "+v"(negm));
    alpha = __builtin_amdgcn_exp2f(-dl); }
#pragma unroll
  for (int r = 0; r < 16; ++r) p0[r] = __builtin_amdgcn_exp2f(p0[r]);
}
__device__ __forceinline__ void finishSM(f32x16& p0, f32x16& p1, float alpha, float& l_reg, bf16x8& pa0, bf16x8& pa1, bf16x8& pa2, bf16x8& pa3) {
#pragma unroll
  for (int r = 0; r < 16; ++r) p1[r] = __builtin_amdgcn_exp2f(p1[r]);
  float ps = 0;
#pragma unroll
  for (int r = 0; r < 16; ++r) ps += p0[r];
#pragma unroll
  for (int r = 0; r < 16; ++r) ps += p1[r];
  { auto rr = __builtin_amdgcn_permlane32_swap(__float_as_uint(ps), __float_as_uint(ps), false, false);
    ps = __uint_as_float(rr[0]) + __uint_as_float(rr[1]); }
  l_reg = l_reg * alpha + ps;
#define PK4(P, BASE, OUT) do { unsigned a0 = cvtpk(P[BASE + 0], P[BASE + 1]), a1 = cvtpk(P[BASE + 2], P[BASE + 3]);   \
    unsigned b0 = cvtpk(P[BASE + 4], P[BASE + 5]), b1 = cvtpk(P[BASE + 6], P[BASE + 7]);                              \
    auto r0 = __builtin_amdgcn_permlane32_swap(a0, b0, false, false); auto r1 = __builtin_amdgcn_permlane32_swap(a1, b1, false, false); \
    u32x4 w = {r0[0], r1[0], r0[1], r1[1]}; OUT = *reinterpret_cast<bf16x8*>(&w); } while (0)
  PK4(p0, 0, pa0); PK4(p0, 8, pa1); PK4(p1, 0, pa2); PK4(p1, 8, pa3);
#undef PK4
}
__device__ __forceinline__ int k_off(int key, int ch) { return ch * 1024 + (key << 4); }
__device__ __forceinline__ void kload8(bf16x8 (&kf)[8], const char* Ks, int r32, int hi) {
#pragma unroll
  for (int d0 = 0; d0 < 4; ++d0) { const int ch = 2 * d0 + hi;
    kf[2 * d0] = *reinterpret_cast<const bf16x8*>(Ks + k_off(r32, ch)); kf[2 * d0 + 1] = *reinterpret_cast<const bf16x8*>(Ks + k_off(32 + r32, ch)); }
}
__device__ __forceinline__ void qkt(f32x16& p0, f32x16& p1, const bf16x8 (&kf)[8], const bf16x8* qr, const f32x16& negm) {
  p0 = __builtin_amdgcn_mfma_f32_32x32x16_bf16(kf[0], qr[0], negm, 0, 0, 0); p1 = __builtin_amdgcn_mfma_f32_32x32x16_bf16(kf[1], qr[0], negm, 0, 0, 0);
  asm volatile("" :: "v"(kf[0]), "v"(kf[1]));
#pragma unroll
  for (int d0 = 1; d0 < 4; ++d0) { p0 = __builtin_amdgcn_mfma_f32_32x32x16_bf16(kf[2 * d0], qr[d0], p0, 0, 0, 0); p1 = __builtin_amdgcn_mfma_f32_32x32x16_bf16(kf[2 * d0 + 1], qr[d0], p1, 0, 0, 0); }
}
__device__ __forceinline__ int v_st(int k, int c) { const int kk = (k & ~0xC) | ((k & 4) << 1) | ((k & 8) >> 1); return ((kk >> 3) * 4 + (c >> 5)) * 512 + ((kk & 7) * 32 + (c & 31)) * 2; }
__device__ __forceinline__ int v_rd_base(int lane) { return ((lane & 3) << 3) | (((lane >> 2) & 3) << 6) | (((lane >> 4) & 1) << 5) | (((lane >> 5) & 1) << 8); }
constexpr int v_rd_off(int d0, int ks, int half) { return d0 * 512 + ks * 4096 + half * 2048; }
template <int OFF> __device__ __forceinline__ s16x4 tr_read(int vb) {
  s16x4 r; asm volatile("ds_read_b64_tr_b16 %0, %1 offset:%2" : "=&v"(r) : "v"(vb), "i"(OFF) : "memory"); return r;
}
template <int D0> __device__ __forceinline__ void pv_one(f32x16& od, int vb, bf16x8 pa0, bf16x8 pa1, bf16x8 pa2, bf16x8 pa3) {
  const s16x4 l0 = tr_read<v_rd_off(D0, 0, 0)>(vb), h0 = tr_read<v_rd_off(D0, 0, 1)>(vb), l1 = tr_read<v_rd_off(D0, 1, 0)>(vb), h1 = tr_read<v_rd_off(D0, 1, 1)>(vb);
  const s16x4 l2 = tr_read<v_rd_off(D0, 2, 0)>(vb), h2 = tr_read<v_rd_off(D0, 2, 1)>(vb), l3 = tr_read<v_rd_off(D0, 3, 0)>(vb), h3 = tr_read<v_rd_off(D0, 3, 1)>(vb);
  asm volatile("s_waitcnt lgkmcnt(0)" ::: "memory"); ASBAR();
#define PK(L, H) (bf16x8){L[0], L[1], L[2], L[3], H[0], H[1], H[2], H[3]}
  od = __builtin_amdgcn_mfma_f32_32x32x16_bf16(PK(l0, h0), pa0, od, 0, 0, 0);
  od = __builtin_amdgcn_mfma_f32_32x32x16_bf16(PK(l1, h1), pa1, od, 0, 0, 0);
  od = __builtin_amdgcn_mfma_f32_32x32x16_bf16(PK(l2, h2), pa2, od, 0, 0, 0);
  od = __builtin_amdgcn_mfma_f32_32x32x16_bf16(PK(l3, h3), pa3, od, 0, 0, 0);
#undef PK
}
__device__ __forceinline__ void pv_d0(f32x16* o, int vb, bf16x8 pa0, bf16x8 pa1, bf16x8 pa2, bf16x8 pa3) {
  pv_one<0>(o[0], vb, pa0, pa1, pa2, pa3); pv_one<1>(o[1], vb, pa0, pa1, pa2, pa3); pv_one<2>(o[2], vb, pa0, pa1, pa2, pa3); pv_one<3>(o[3], vb, pa0, pa1, pa2, pa3);
}
constexpr int NSLOT = 3, LDS_KR = 0, LDS_VR = NSLOT * SHM_K, LDS_WS = LDS_VR + NSLOT * SHM_V;
constexpr int SHM_ATTN = LDS_WS + NW * 64 * 4;
#define AT_LAS __attribute__((address_space(3)))
__device__ __forceinline__ void attn_unit(const bf16_t* __restrict__ QKV, bf16_t* __restrict__ OC, int qrow0, int qcol, int kcol, int vcol, int ocol,
                                          int lat0, int nlat, int ctx0, int NT, char* lds, int tid) {
  const int wid = __builtin_amdgcn_readfirstlane(tid >> 6), lane = tid & 63, r32 = lane & 31, hi = lane >> 5;
  char* K_lds = lds + LDS_KR; char* V_lds = lds + LDS_VR;
  float m_reg = 0.f, l_reg = 0; f32x16 o[4] = {}; f32x16 negm = {}; asm volatile("" : "+v"(negm)); bf16x8 qr[4];
  const unsigned voffK = (unsigned)(lane * LDQ + wid * 8) * 2u;
  unsigned voffV[2];
#pragma unroll
  for (int i = 0; i < 2; ++i) { const int p = 2 * wid + i, s = 2 * p + (lane >> 5), kk = (s >> 2) * 8 + ((lane & 31) >> 2), c = (s & 3) * 32 + (lane & 3) * 8;
    const int k = (kk & ~0xC) | ((kk & 4) << 1) | ((kk & 8) >> 1); voffV[i] = (unsigned)(k * LDQ + c) * 2u; }
#define TROW(j) ((j) < nlat ? lat0 + 64 * (j) : ctx0 + 64 * ((j) - nlat))
#define DMA_K(j) do { const char* tb_ = (const char*)QKV + (size_t)TROW(j) * (LDQ * 2) + kcol * 2; \
    __builtin_amdgcn_global_load_lds((const unsigned*)(tb_ + voffK), (AT_LAS unsigned*)(K_lds + ((j) % NSLOT) * SHM_K + wid * 1024), 16, 0, 0); } while (0)
#define DMA_V(j) do { const char* tb_ = (const char*)QKV + (size_t)TROW(j) * (LDQ * 2) + vcol * 2; \
    __builtin_amdgcn_global_load_lds((const unsigned*)(tb_ + voffV[0]), (AT_LAS unsigned*)(V_lds + ((j) % NSLOT) * SHM_V + (2 * wid) * 1024), 16, 0, 0); \
    __builtin_amdgcn_global_load_lds((const unsigned*)(tb_ + voffV[1]), (AT_LAS unsigned*)(V_lds + ((j) % NSLOT) * SHM_V + (2 * wid + 1) * 1024), 16, 0, 0); } while (0)
#define WAITBAR(N) asm volatile("s_waitcnt vmcnt(" #N ") lgkmcnt(0)\n\ts_barrier" ::: "memory")
#define RESC(a) do { if (__any((a) < 1.f)) { _Pragma("unroll") for (int d = 0; d < 4; ++d) _Pragma("unroll") for (int r = 0; r < 16; ++r) o[d][r] *= (a); } } while (0)
  DMA_K(0); DMA_V(0); DMA_K(1);
  const bf16_t* Qw = QKV + (size_t)(qrow0 + wid * QBLK + r32) * LDQ + qcol + hi * 8;
#pragma unroll
  for (int d0 = 0; d0 < 4; ++d0) qr[d0] = *reinterpret_cast<const bf16x8*>(Qw + d0 * 16);
  const int vb0 = (int)(uintptr_t)V_lds + v_rd_base(lane);
  f32x16 pA0, pA1, pB0, pB1; float alA, alB; bf16x8 pa0, pa1, pa2, pa3;
#define BAR_A(j) do { if ((j) + 2 < NT) { WAITBAR(3); DMA_K((j) + 2); } else { WAITBAR(0); } } while (0)
#define BAR_B(j) do { if ((j) + 2 < NT) { WAITBAR(3); } else { WAITBAR(0); } if ((j) + 1 < NT) DMA_V((j) + 1); } while (0)
  asm volatile("s_waitcnt vmcnt(0)" ::: "memory");
  if (wid >= 4) asm volatile("s_barrier" ::: "memory");
  WAITBAR(0); DMA_K(2);
  bf16x8 kf[8]; kload8(kf, K_lds, r32, hi); ASBAR(); qkt(pA0, pA1, kf, qr, negm); ASBAR();
  BAR_B(0);
  partialSM<true>(pA0, pA1, m_reg, alA, negm);
  int sk = 1, sv = 0;
#define ROT() do { sk = (sk == NSLOT - 1) ? 0 : sk + 1; sv = (sv == NSLOT - 1) ? 0 : sv + 1; } while (0)
  for (int j = 1; j + 1 < NT; j += 2) {
    BAR_A(j);
    kload8(kf, K_lds + sk * SHM_K, r32, hi); ASBAR(); qkt(pB0, pB1, kf, qr, negm);
    finishSM(pA0, pA1, alA, l_reg, pa0, pa1, pa2, pa3); ASBAR();
    BAR_B(j);
    pv_d0(o, vb0 + sv * SHM_V, pa0, pa1, pa2, pa3); partialSM(pB0, pB1, m_reg, alB, negm);
    RESC(alB); ROT();
    BAR_A(j + 1);
    kload8(kf, K_lds + sk * SHM_K, r32, hi); ASBAR(); qkt(pA0, pA1, kf, qr, negm);
    finishSM(pB0, pB1, alB, l_reg, pa0, pa1, pa2, pa3); ASBAR();
    BAR_B(j + 1);
    pv_d0(o, vb0 + sv * SHM_V, pa0, pa1, pa2, pa3); partialSM(pA0, pA1, m_reg, alA, negm);
    RESC(alA); ROT();
  }
  BAR_A(NT - 1);
  kload8(kf, K_lds + sk * SHM_K, r32, hi); ASBAR(); qkt(pB0, pB1, kf, qr, negm);
  finishSM(pA0, pA1, alA, l_reg, pa0, pa1, pa2, pa3); ASBAR();
  BAR_B(NT - 1);
  pv_d0(o, vb0 + sv * SHM_V, pa0, pa1, pa2, pa3); partialSM(pB0, pB1, m_reg, alB, negm);
  RESC(alB); ROT();
  finishSM(pB0, pB1, alB, l_reg, pa0, pa1, pa2, pa3); ASBAR();
  pv_d0(o, vb0 + sv * SHM_V, pa0, pa1, pa2, pa3);
  if (wid < 4) asm volatile("s_barrier" ::: "memory");
#undef BAR_A
#undef BAR_B
  const float rl = __builtin_amdgcn_rcpf(l_reg);
  bf16_t* Ow = OC + (size_t)(qrow0 + wid * QBLK + r32) * LDO + ocol + 8 * hi;
#pragma unroll
  for (int d0 = 0; d0 < 4; ++d0)
#pragma unroll
    for (int t = 0; t < 2; ++t) {
      const unsigned x0 = cvtpk(o[d0][8 * t + 0] * rl, o[d0][8 * t + 1] * rl), x1 = cvtpk(o[d0][8 * t + 2] * rl, o[d0][8 * t + 3] * rl);
      const unsigned y0 = cvtpk(o[d0][8 * t + 4] * rl, o[d0][8 * t + 5] * rl), y1 = cvtpk(o[d0][8 * t + 6] * rl, o[d0][8 * t + 7] * rl);
      auto s0 = __builtin_amdgcn_permlane32_swap(x0, y0, false, false); auto s1 = __builtin_amdgcn_permlane32_swap(x1, y1, false, false);
      u32x4 w = {s0[0], s1[0], s0[1], s1[1]};
      *reinterpret_cast<u32x4*>(Ow + d0 * 32 + 16 * t) = w; }
  WAITBAR(0);
#undef TROW
#undef DMA_K
#undef DMA_V
#undef WAITBAR
#undef ROT
#undef RESC
}
#undef ASBAR
}

constexpr int DM = 2048, BATCH = 2, SEQ = 8192, DEPTH = 4, CTXL = 256, FF = 5632;
constexpr int TLAT = BATCH * SEQ, TCTX = BATCH * CTXL, TT = TLAT + TCTX;
constexpr int NMOD = 9, MODW = NMOD * DM;
constexpr int S5W = 1024, S5H = 16, S5G = 64, S5P = 64, MIXIN = 4096, MIXOUT = 2048;
constexpr int NTC = (SEQ + CTXL) / 64;
constexpr float EPS = 1e-6f;
#ifndef NSUB
#define NSUB 12
#endif
#ifndef ONE_LAUNCH
#define ONE_LAUNCH 1
#endif

constexpr size_t MiB = 1u << 20;
constexpr size_t al(size_t x) { return (x + MiB - 1) / MiB * MiB; }
constexpr size_t WS_CTL = 0, CTL_ZERO_BYTES = 1 * MiB;
constexpr size_t WS_MOD   = WS_CTL + CTL_ZERO_BYTES;
constexpr size_t WS_ROPE  = WS_MOD + al((size_t)DEPTH * 3 * MODW * 4);
constexpr size_t WS_MODP  = WS_ROPE + MiB;
constexpr int    ADA_KC = 32;
constexpr size_t WS_SE    = WS_MODP + al((size_t)DEPTH * ADA_KC * 3 * MODW * 4);
constexpr size_t SCAN_BYTES = (size_t)BATCH * 2 * S5G * NTC * S5P * 8;
constexpr size_t WS_SC    = WS_SE + al(SCAN_BYTES);
constexpr size_t WS_WGU   = WS_SC + al(SCAN_BYTES);
constexpr size_t WGU_ONE  = (size_t)2 * FF * DM * 2;
constexpr size_t WS_WD    = WS_WGU + al(8 * WGU_ONE);
constexpr size_t WD_ONE   = (size_t)DM * FF * 2;
constexpr size_t WS_WIN   = WS_WD + al(8 * WD_ONE);
constexpr size_t WS_WOUT  = WS_WIN + al((size_t)2 * MIXIN * DM * 2);
constexpr size_t WS_WGLU  = WS_WOUT + al((size_t)2 * DM * MIXOUT * 2);
constexpr size_t WS_WQKV  = WS_WGLU + al((size_t)2 * S5W * S5W * 2);
constexpr size_t WS_WO    = WS_WQKV + al((size_t)2 * 3 * DM * DM * 2);
constexpr size_t WS_X     = WS_WO + al((size_t)2 * DM * DM * 2);
constexpr size_t WS_H     = WS_X + al((size_t)TT * DM * 4);
constexpr size_t WS_Y     = WS_H + al((size_t)TT * DM * 2);
constexpr size_t WS_BIG   = WS_Y + al((size_t)TT * DM * 2);
constexpr size_t WS_Z     = WS_BIG + al((size_t)TT * 6144 * 2);
constexpr size_t WS_MIXA  = WS_Z + al((size_t)TT * S5W * 2);
constexpr size_t WS_OC    = WS_MIXA + al((size_t)TT * DM * 2);
constexpr size_t WS_PART  = WS_OC + al((size_t)TT * 4096 * 2);
constexpr int    NZ_DOWN = 4, NZ_OUT = 4;
constexpr size_t WS_END   = WS_PART + al((size_t)11 * TCTX * DM * 4);

constexpr int CW_BAR = 4096;
constexpr int CW_HOST = 16384;

constexpr int SCRATCH_BYTES = 143360;
constexpr int LDSCTL_OFF = SCRATCH_BYTES, MISC_OFF = LDSCTL_OFF + 320;
constexpr int LDS_BYTES = 147456;
static_assert(pg8::STAGE_BYTES <= SCRATCH_BYTES && att::SHM_ATTN <= SCRATCH_BYTES && MISC_OFF + 128 <= LDS_BYTES, "LDS map");

#define GAS __attribute__((address_space(1)))
#define LAS __attribute__((address_space(3)))
typedef unsigned short bf16;
typedef unsigned v4u __attribute__((ext_vector_type(4)));
typedef float f32x4 __attribute__((ext_vector_type(4)));
typedef float f32x16 __attribute__((ext_vector_type(16)));
typedef short bf16x8 __attribute__((ext_vector_type(8)));
#define LDS_WAIT() asm volatile("s_waitcnt lgkmcnt(0)" ::: "memory")
#define VM_WAIT() asm volatile("s_waitcnt vmcnt(0)" ::: "memory")
__device__ __forceinline__ unsigned pk2(float lo, float hi) { unsigned r; asm volatile("v_cvt_pk_bf16_f32 %0, %1, %2" : "=v"(r) : "v"(lo), "v"(hi)); return r; }
typedef _Float16 h16x2 __attribute__((ext_vector_type(2)));
__device__ __forceinline__ unsigned pkh2(float lo, float hi) { const float L = 65504.f; h16x2 v = {(_Float16)__builtin_fminf(__builtin_fmaxf(lo, -L), L), (_Float16)__builtin_fminf(__builtin_fmaxf(hi, -L), L)}; return __builtin_bit_cast(unsigned, v); }
__device__ __forceinline__ float hlo(unsigned w) { return (float)__builtin_bit_cast(h16x2, w)[0]; }
__device__ __forceinline__ float hhi(unsigned w) { return (float)__builtin_bit_cast(h16x2, w)[1]; }
__device__ __forceinline__ float bflo(unsigned w) { return __uint_as_float(w << 16); }
__device__ __forceinline__ float bfhi(unsigned w) { return __uint_as_float(w & 0xffff0000u); }
__device__ __forceinline__ float wave_sum(float v) {
#pragma unroll
    for (int o = 1; o < 64; o <<= 1) v += __shfl_xor(v, o);
    return v;
}
#define XB_TMO      128
#define XB_XCNT(j)  (256  + 64 * (j))
#define XB_XSUB(j)  (1280 + 64 * (j))
#define XB_XGEN(j)  (2304 + 64 * (j))
#define XB_TOP      3328
#define XB_TOPGEN   3392
#define XCD_BAR_WORDS 3456
#define XB_SPIN_CAP (1u << 18)

__device__ __forceinline__ unsigned xb_ld(unsigned* p)              { return __hip_atomic_load(p, __ATOMIC_RELAXED, __HIP_MEMORY_SCOPE_AGENT); }
__device__ __forceinline__ unsigned xb_add(unsigned* p, unsigned v) { return __hip_atomic_fetch_add(p, v, __ATOMIC_RELAXED, __HIP_MEMORY_SCOPE_AGENT); }
__device__ __forceinline__ unsigned xb_xcc_id() { return (unsigned)__builtin_amdgcn_s_getreg((3 << 11) | 20) & 0xFu; }
#define XB_SPIN(cond, bar) do { unsigned _sp = 0; while (cond) { __builtin_amdgcn_s_sleep(1); \
    if ((++_sp & 255u) == 0u) { if (xb_ld(&(bar)[XB_TMO])) break; if (_sp > XB_SPIN_CAP) { atomicAdd(&(bar)[XB_TMO], 1u); break; } } } } while (0)

struct XcdBarrier {
    unsigned* bar; unsigned x;
    volatile LAS unsigned* st;
};

__device__ __forceinline__ XcdBarrier xcd_barrier_post(unsigned* bar, volatile LAS unsigned* st) {
    XcdBarrier b; b.bar = bar; b.x = xb_xcc_id(); b.st = st;
    if (threadIdx.x == 0) (void)xb_add(&bar[XB_XCNT(b.x)], 1u);
    return b;
}
__device__ __forceinline__ void xcd_barrier_complete(unsigned* bar, unsigned x, unsigned& nloc, unsigned& nx) {
    const unsigned G = gridDim.x * gridDim.y * gridDim.z;
    unsigned sum, cnt, mine, sp = 0u;
    for (;;) {
        sum = 0u; cnt = 0u; mine = 0u;
#pragma unroll
        for (unsigned j = 0; j < 16; ++j) { const unsigned c = xb_ld(&bar[XB_XCNT(j)]); sum += c; cnt += (c > 0u) ? 1u : 0u; mine = (j == x) ? c : mine; }
        if (sum == G) break;
        __builtin_amdgcn_s_sleep(1);
        if ((++sp & 255u) == 0u) { if (xb_ld(&bar[XB_TMO])) break; if (sp > XB_SPIN_CAP) { atomicAdd(&bar[XB_TMO], 1u); break; } }
    }
    nloc = mine > 0u ? mine : 1u; nx = cnt > 0u ? cnt : 1u;
}

__device__ __forceinline__ void xcd_barrier(const XcdBarrier& b) {
    asm volatile("s_waitcnt vmcnt(0)" ::: "memory");
    __syncthreads();
    if (threadIdx.x == 0) {
        unsigned* bar = b.bar;
        __builtin_amdgcn_s_waitcnt(0);
        unsigned nloc = b.st[0], nx = b.st[1];
        if (nloc == 0u) { xcd_barrier_complete(bar, b.x, nloc, nx); b.st[0] = nloc; b.st[1] = nx; }
        const unsigned old = xb_add(&bar[XB_XSUB(b.x)], 1u);
        const unsigned gen = old / nloc;
        if (old + 1u == (gen + 1u) * nloc) {
            __builtin_amdgcn_fence(__ATOMIC_RELEASE, "agent");
            asm volatile("s_waitcnt vmcnt(0)" ::: "memory");
            const unsigned og = xb_add(&bar[XB_TOP], 1u);
            const unsigned tg = og / nx;
            if (og + 1u == (tg + 1u) * nx) xb_add(&bar[XB_TOPGEN], 1u);
            else XB_SPIN(xb_ld(&bar[XB_TOPGEN]) == tg, bar);
            __builtin_amdgcn_fence(__ATOMIC_ACQUIRE, "agent");
            xb_add(&bar[XB_XGEN(b.x)], 1u);
            asm volatile("s_waitcnt vmcnt(0)" ::: "memory");
        } else {
            XB_SPIN(xb_ld(&bar[XB_XGEN(b.x)]) == gen, bar);
            __builtin_amdgcn_fence(__ATOMIC_ACQUIRE, "agent");
            asm volatile("s_waitcnt vmcnt(0)" ::: "memory");
        }
    }
    __syncthreads();
}
constexpr int NWAVES = 8;
struct Args { const float* in[28]; float* out; unsigned char* ws; int ph_lo, ph_hi; };
struct Frame {
    const Args& A;
    LAS unsigned char* lds;
    int tid, lane, wave, vcu, G;
    float* out; unsigned char* ws;
};
#define WSP(T, off) ((T*)(F.ws + (off)))

template <int MAP> __device__ __forceinline__ int rowmap(int n) {
    if (MAP == 1) return ((n >> 7) << 8) + (n & 127);
    if (MAP == 2) return ((n >> 7) << 8) + 128 + (n & 127);
    if (MAP == 3) { if (n >= 4096) return n; const int i = n & 255, beta = i >> 6, d = i & 63; return (n & ~255) + (d < 32 ? 32 * beta + d : 128 + 32 * beta + (d - 32)); }
    return n;
}
template <int MAP> __device__ __forceinline__ void transpose_item(const float* W, int K, int N, bf16* WT, LAS float* scr, int item, int lane) {
    const int nblk = N / 32, kb = item / nblk, nb = item % nblk, k0 = 64 * kb, n0 = 32 * nb;
#pragma unroll 8
    for (int i = 0; i < 32; ++i) { const int kk = 2 * i + (lane >> 5); scr[kk * 33 + (lane & 31)] = W[(size_t)(k0 + kk) * N + n0 + (lane & 31)]; }
    LDS_WAIT(); asm volatile("" ::: "memory");
    const int c = lane & 7;
#pragma unroll
    for (int j = 0; j < 4; ++j) { const int n = (lane >> 3) + 8 * j; const LAS float* s = scr + (8 * c) * 33 + n;
        v4u o; o.x = pk2(s[0 * 33], s[1 * 33]); o.y = pk2(s[2 * 33], s[3 * 33]); o.z = pk2(s[4 * 33], s[5 * 33]); o.w = pk2(s[6 * 33], s[7 * 33]);
        *(GAS v4u*)(WT + (size_t)rowmap<MAP>(n0 + n) * K + k0 + 8 * c) = o; }
    LDS_WAIT(); asm volatile("" ::: "memory");
}
__device__ __forceinline__ float silu_f(float v) { return v / (1.0f + __expf(-v)); }

__device__ __forceinline__ void p0_prologue(Frame& F) {
    const int gw = F.vcu * NWAVES + F.wave, NGW = F.G * NWAVES;
    LAS float* sv = (LAS float*)(F.lds + 8 * 8704);
    for (int i = F.tid; i < 3 * DM; i += NWAVES * 64) { const int v = i / DM, k = i % DM; sv[i] = silu_f(v < 2 ? F.A.in[1][v * DM + k] : F.A.in[3][k]); }
    { const int gt = (F.vcu * NWAVES * 64) + F.tid; if (gt < 128 * 16) { const int pos = gt >> 4, j = gt & 15; const float fr = powf(10000.0f, -(float)j / 16.0f); const float ang = (float)pos * fr;
            float* cs = WSP(float, WS_ROPE); cs[2 * gt] = cosf(ang); cs[2 * gt + 1] = sinf(ang); } }
    __syncthreads();
    { float* part = WSP(float, WS_MODP);
      constexpr int NCB = MODW / 256, NU = DEPTH * ADA_KC * NCB;
      for (int u = gw; u < NU; u += NGW) { const int cb = u % NCB, kc = (u / NCB) % ADA_KC, l = u / (NCB * ADA_KC);
          const float* W = F.A.in[4] + ((size_t)l * DM + kc * 64) * MODW + cb * 256 + F.lane * 4;
          f32x4 a0 = {0, 0, 0, 0}, a1 = a0, a2 = a0;
#pragma unroll 8
          for (int k = 0; k < 64; ++k) { const f32x4 w = *(const f32x4*)(W + (size_t)k * MODW); const int kk = kc * 64 + k;
              a0 += w * sv[kk]; a1 += w * sv[DM + kk]; a2 += w * sv[2 * DM + kk]; }
          float* o = part + ((size_t)(l * ADA_KC + kc) * 3) * MODW + cb * 256 + F.lane * 4;
          *(f32x4*)o = a0; *(f32x4*)(o + MODW) = a1; *(f32x4*)(o + 2 * MODW) = a2; } }
    LAS float* scr = (LAS float*)(F.lds + F.wave * 8704);
    constexpr int I_FF = (DM / 64) * (FF / 32);
    constexpr int I_IN = (DM / 64) * (MIXIN / 32), I_OUT = (MIXOUT / 64) * (DM / 32), I_GLU = (S5W / 64) * (S5W / 32), I_QKV = (DM / 64) * (3 * DM / 32), I_O = (DM / 64) * (DM / 32);
    constexpr int N_FFN = 24 * I_FF, N_EV = I_IN + I_OUT + I_GLU, N_OD = I_QKV + I_O, NITEMS = N_FFN + 2 * N_EV + 2 * N_OD;
    for (int it = gw; it < NITEMS; it += NGW) {
        int r = it;
        if (r < N_FFN) { const int q = r / I_FF, item = r % I_FF, lh = q / 3, kind = q % 3;
            if (kind == 0) transpose_item<1>(F.A.in[7] + (size_t)lh * DM * FF, DM, FF, WSP(bf16, WS_WGU + lh * WGU_ONE), scr, item, F.lane);
            else if (kind == 1) transpose_item<2>(F.A.in[8] + (size_t)lh * DM * FF, DM, FF, WSP(bf16, WS_WGU + lh * WGU_ONE), scr, item, F.lane);
            else transpose_item<0>(F.A.in[9] + (size_t)lh * FF * DM, FF, DM, WSP(bf16, WS_WD + lh * WD_ONE), scr, item, F.lane);
            continue; }
        r -= N_FFN;
        if (r < 2 * N_EV) { const int i = r / N_EV; r %= N_EV;
            if (r < I_IN) { transpose_item<0>(F.A.in[10] + (size_t)i * DM * MIXIN, DM, MIXIN, WSP(bf16, WS_WIN + (size_t)i * MIXIN * DM * 2), scr, r, F.lane); continue; } r -= I_IN;
            if (r < I_OUT) { transpose_item<0>(F.A.in[11] + (size_t)i * MIXOUT * DM, MIXOUT, DM, WSP(bf16, WS_WOUT + (size_t)i * DM * MIXOUT * 2), scr, r, F.lane); continue; } r -= I_OUT;
            transpose_item<0>(F.A.in[20] + (size_t)i * S5W * S5W, S5W, S5W, WSP(bf16, WS_WGLU + (size_t)i * S5W * S5W * 2), scr, r, F.lane); continue; }
        r -= 2 * N_EV;
        { const int i = r / N_OD; r %= N_OD;
            if (r < I_QKV) { transpose_item<3>(F.A.in[24] + (size_t)i * DM * 3 * DM, DM, 3 * DM, WSP(bf16, WS_WQKV + (size_t)i * 3 * DM * DM * 2), scr, r, F.lane); continue; } r -= I_QKV;
            transpose_item<0>(F.A.in[25] + (size_t)i * DM * DM, DM, DM, WSP(bf16, WS_WO + (size_t)i * DM * DM * 2), scr, r, F.lane); }
    }
}
__device__ __forceinline__ void p1_ada_reduce(Frame& F) {
    const float* part = WSP(float, WS_MODP); float* mod = WSP(float, WS_MOD);
    const int gt = F.vcu * NWAVES * 64 + F.tid, NGT = F.G * NWAVES * 64;
    for (int i = gt; i < DEPTH * 3 * MODW; i += NGT) { const int n = i % MODW, v = (i / MODW) % 3, l = i / (3 * MODW);
        float s = F.A.in[5][l * MODW + n];
#pragma unroll 8
        for (int kc = 0; kc < ADA_KC; ++kc) s += part[((size_t)(l * ADA_KC + kc) * 3 + v) * MODW + n];
        mod[i] = s; }
}

__device__ __forceinline__ void host_arrive(unsigned* cnt) {
    VM_WAIT(); __syncthreads();
    if (threadIdx.x == 0) { __builtin_amdgcn_fence(__ATOMIC_RELEASE, "agent"); VM_WAIT(); (void)__hip_atomic_fetch_add(cnt, 1u, __ATOMIC_RELAXED, __HIP_MEMORY_SCOPE_AGENT); }
}
__device__ __forceinline__ void host_wait(unsigned* cnt, unsigned want) {
    if (threadIdx.x == 0) { unsigned sp = 0; while (__hip_atomic_load(cnt, __ATOMIC_RELAXED, __HIP_MEMORY_SCOPE_AGENT) < want) { __builtin_amdgcn_s_sleep(4); if (++sp > (1u << 22)) break; }
        __builtin_amdgcn_fence(__ATOMIC_ACQUIRE, "agent"); VM_WAIT(); }
    __syncthreads();
}
__device__ __forceinline__ void resid_norm_phase(Frame& F, int sub, int nctx = TCTX, bool dry = false) {
    LAS float* vA = (LAS float*)F.lds; LAS float* vB = vA + 3 * DM; LAS float* vC = vB + 3 * DM;
    const float* mod = WSP(float, WS_MOD);
    const bool has_y = sub >= 0, from_input = sub <= 0, last = (sub == NSUB - 1), write_h = !last;
    const int nsub = sub + 1, nl = nsub / 3, ns = nsub % 3;
    for (int i = F.tid; i < 3 * DM; i += NWAVES * 64) { const int v = i / DM, c = i % DM;
        if (has_y) { const int l = sub / 3, s = sub % 3; const float wgt = (s == 1) ? 1.0f : 0.5f;
            vA[i] = wgt * mod[((size_t)(l * 3 + v) * NMOD + 3 * s + 2) * DM + c] * F.A.in[6][((size_t)l * 6 + 2 * s + 1) * DM + c]; }
        if (write_h) { vB[i] = F.A.in[6][((size_t)nl * 6 + 2 * ns) * DM + c] * (1.0f + mod[((size_t)(nl * 3 + v) * NMOD + 3 * ns + 1) * DM + c]);
            vC[i] = mod[((size_t)(nl * 3 + v) * NMOD + 3 * ns) * DM + c]; } }
    __syncthreads();
    const bf16* Y = WSP(bf16, WS_Y); const bf16* X = WSP(bf16, WS_X); bf16* Xd = dry ? WSP(bf16, WS_OC) : WSP(bf16, WS_X); bf16* H = dry ? WSP(bf16, WS_MIXA) : WSP(bf16, WS_H); float* outd = dry ? WSP(float, WS_OC) : F.out;
    const int lp = (TLAT + F.G - 1) / F.G, cp = (TCTX + F.G - 1) / F.G;
    const int l0 = blockIdx.x * lp, l1 = (l0 + lp < TLAT) ? l0 + lp : TLAT, nl_ = l1 > l0 ? l1 - l0 : 0;
    const int c0 = blockIdx.x * cp, c1 = (c0 + cp < nctx) ? c0 + cp : nctx, nc_ = c1 > c0 ? c1 - c0 : 0;
    for (int j = F.wave; j < nl_ + nc_; j += NWAVES) {
        const int row = j < nl_ ? l0 + j : TLAT + c0 + (j - nl_);
        const int v = row < SEQ ? 0 : (row < TLAT ? 1 : 2);
        f32x4 xv[4][2];
        if (from_input) {
            const float* xs = row < TLAT ? F.A.in[0] + (size_t)row * DM : F.A.in[2] + (size_t)(row - TLAT) * DM;
#pragma unroll
            for (int i = 0; i < 4; ++i) { const f32x4* p = (const f32x4*)(xs + i * 512 + F.lane * 8); xv[i][0] = p[0]; xv[i][1] = p[1]; }
        } else {
            v4u xw[4];
#pragma unroll
            for (int i = 0; i < 4; ++i) xw[i] = *(const v4u*)(X + (size_t)row * DM + i * 512 + F.lane * 8);
#pragma unroll
            for (int i = 0; i < 4; ++i) { xv[i][0] = (f32x4){hlo(xw[i].x), hhi(xw[i].x), hlo(xw[i].y), hhi(xw[i].y)}; xv[i][1] = (f32x4){hlo(xw[i].z), hhi(xw[i].z), hlo(xw[i].w), hhi(xw[i].w)}; }
        }
        if (has_y) {
            float ss = 0.f; f32x4 yv[4][2];
            if (row < TLAT) {
                v4u yw[4];
#pragma unroll
                for (int i = 0; i < 4; ++i) yw[i] = *(const v4u*)(Y + (size_t)row * DM + i * 512 + F.lane * 8);
#pragma unroll
                for (int i = 0; i < 4; ++i) { yv[i][0] = (f32x4){bflo(yw[i].x), bfhi(yw[i].x), bflo(yw[i].y), bfhi(yw[i].y)}; yv[i][1] = (f32x4){bflo(yw[i].z), bfhi(yw[i].z), bflo(yw[i].w), bfhi(yw[i].w)}; }
            } else {
                const int nz = (sub % 3 == 1) ? NZ_OUT : NZ_DOWN; const float* pp = WSP(const float, WS_PART) + (size_t)(row - TLAT) * DM + F.lane * 8;
#pragma unroll
                for (int i = 0; i < 4; ++i) { yv[i][0] = (f32x4){0.f, 0.f, 0.f, 0.f}; yv[i][1] = yv[i][0]; }
#pragma unroll 4
                for (int z = 0; z < nz; ++z) { const float* pz = pp + (size_t)z * TCTX * DM;
#pragma unroll
                    for (int i = 0; i < 4; ++i) { yv[i][0] += *(const f32x4*)(pz + i * 512); yv[i][1] += *(const f32x4*)(pz + i * 512 + 4); } }
            }
#pragma unroll
            for (int i = 0; i < 4; ++i)
#pragma unroll
                for (int h = 0; h < 2; ++h) ss += (yv[i][h][0] * yv[i][h][0] + yv[i][h][1] * yv[i][h][1]) + (yv[i][h][2] * yv[i][h][2] + yv[i][h][3] * yv[i][h][3]);
            const float r = rsqrtf(wave_sum(ss) * (1.0f / DM) + EPS);
#pragma unroll
            for (int i = 0; i < 4; ++i)
#pragma unroll
                for (int h = 0; h < 2; ++h) { const f32x4 a = *(const LAS f32x4*)(vA + v * DM + i * 512 + F.lane * 8 + 4 * h); xv[i][h] += a * (yv[i][h] * r); }
            if (!last) {
#pragma unroll
                for (int i = 0; i < 4; ++i) { v4u w; w.x = pkh2(xv[i][0][0], xv[i][0][1]); w.y = pkh2(xv[i][0][2], xv[i][0][3]); w.z = pkh2(xv[i][1][0], xv[i][1][1]); w.w = pkh2(xv[i][1][2], xv[i][1][3]);
                    *(v4u*)(Xd + (size_t)row * DM + i * 512 + F.lane * 8) = w; }
            } else if (row < TLAT) {
#pragma unroll
                for (int i = 0; i < 4; ++i) { f32x4* p = (f32x4*)(outd + (size_t)row * DM + i * 512 + F.lane * 8); p[0] = xv[i][0]; p[1] = xv[i][1]; }
            }
        }
        if (write_h) {
            float ss = 0.f;
#pragma unroll
            for (int i = 0; i < 4; ++i)
#pragma unroll
                for (int h = 0; h < 2; ++h) ss += (xv[i][h][0] * xv[i][h][0] + xv[i][h][1] * xv[i][h][1]) + (xv[i][h][2] * xv[i][h][2] + xv[i][h][3] * xv[i][h][3]);
            const float r = rsqrtf(wave_sum(ss) * (1.0f / DM) + EPS);
#pragma unroll
            for (int i = 0; i < 4; ++i) { f32x4 o[2];
#pragma unroll
                for (int h = 0; h < 2; ++h) { const f32x4 b = *(const LAS f32x4*)(vB + v * DM + i * 512 + F.lane * 8 + 4 * h), c = *(const LAS f32x4*)(vC + v * DM + i * 512 + F.lane * 8 + 4 * h); o[h] = (xv[i][h] * r) * b + c; }
                v4u w; w.x = pk2(o[0][0], o[0][1]); w.y = pk2(o[0][2], o[0][3]); w.z = pk2(o[1][0], o[1][1]); w.w = pk2(o[1][2], o[1][3]);
                *(v4u*)(H + (size_t)row * DM + i * 512 + F.lane * 8) = w; }
        }
    }
}

namespace s5 {
struct Par { float a_re, a_im; bf16x8 Bre1, Bim1, Bre2, Bim2; };
__device__ __forceinline__ void discretize(float lre, float lim, float dt, float& a_re, float& a_im, float& co_re, float& co_im) {
    const float mag = expf(lre * dt); float sn, cn; sincosf(lim * dt, &sn, &cn);
    a_re = mag * cn; a_im = mag * sn;
    const float inv = 1.0f / (lre * lre + lim * lim);
    co_re = ((a_re - 1.0f) * lre + a_im * lim) * inv; co_im = (a_im * lre - (a_re - 1.0f) * lim) * inv;
}
__device__ __forceinline__ void load_par(const Args& in, int ei, int dir, int g, int lane, Par& P) {
    const int base = (ei * 2 + dir) * S5G + g; const float dt = expf(in.in[14][base]);
    const int r32 = lane & 31, hi = lane >> 5;
    { float cr, ci; discretize(in.in[12][base * S5P + lane], in.in[13][base * S5P + lane], dt, P.a_re, P.a_im, cr, ci); }
#pragma unroll
    for (int q = 0; q < 2; ++q) { const int p = q * 32 + r32; float ar, ai, cr, ci; discretize(in.in[12][base * S5P + p], in.in[13][base * S5P + p], dt, ar, ai, cr, ci);
        const f32x4* br = (const f32x4*)(in.in[15] + ((size_t)base * S5P + p) * S5H + 8 * hi); const f32x4* bi = (const f32x4*)(in.in[16] + ((size_t)base * S5P + p) * S5H + 8 * hi);
        const f32x4 r0 = br[0], r1 = br[1], i0 = bi[0], i1 = bi[1];
        const f32x4 xr0 = r0 * cr - i0 * ci, xr1 = r1 * cr - i1 * ci, xi0 = i0 * cr + r0 * ci, xi1 = i1 * cr + r1 * ci;
        v4u wr, wi; wr.x = pk2(xr0[0], xr0[1]); wr.y = pk2(xr0[2], xr0[3]); wr.z = pk2(xr1[0], xr1[1]); wr.w = pk2(xr1[2], xr1[3]);
        wi.x = pk2(xi0[0], xi0[1]); wi.y = pk2(xi0[2], xi0[3]); wi.z = pk2(xi1[0], xi1[1]); wi.w = pk2(xi1[2], xi1[3]);
        if (q == 0) { P.Bre1 = __builtin_bit_cast(bf16x8, wr); P.Bim1 = __builtin_bit_cast(bf16x8, wi); } else { P.Bre2 = __builtin_bit_cast(bf16x8, wr); P.Bim2 = __builtin_bit_cast(bf16x8, wi); } }
}
constexpr size_t TAB_B = 0, TAB_A = 128 * 4 * 64 * 16, TAB_C = TAB_A + 128 * 64 * 8, TAB_END = TAB_C + 128 * 4 * 64 * 16;
__device__ __forceinline__ void cfrags(const Args& in, int ei, int dir, int g, int lane, bf16x8 (&C)[4]) {
    const int fr = lane & 15, kq = lane >> 4;
#pragma unroll
    for (int ks = 0; ks < 4; ++ks) { const size_t o = ((size_t)((ei * 2 + dir) * S5G + g) * S5H + fr) * S5P + 16 * ks + 4 * kq;
        const f32x4 cr = *(const f32x4*)(in.in[17] + o), ci = *(const f32x4*)(in.in[18] + o);
        v4u w; w.x = pk2(cr[0], -ci[0]); w.y = pk2(cr[1], -ci[1]); w.z = pk2(cr[2], -ci[2]); w.w = pk2(cr[3], -ci[3]);
        C[ks] = __builtin_bit_cast(bf16x8, w); }
}
__device__ __forceinline__ void table_store(unsigned char* tab, int dg, int lane, const Par& P, const bf16x8 (&C)[4]) {
    v4u* tb = (v4u*)(tab + TAB_B) + (size_t)dg * 256 + lane; tb[0] = __builtin_bit_cast(v4u, P.Bre1); tb[64] = __builtin_bit_cast(v4u, P.Bim1); tb[128] = __builtin_bit_cast(v4u, P.Bre2); tb[192] = __builtin_bit_cast(v4u, P.Bim2);
    ((float2*)(tab + TAB_A))[dg * 64 + lane] = make_float2(P.a_re, P.a_im);
    v4u* tc = (v4u*)(tab + TAB_C) + (size_t)dg * 256 + lane;
#pragma unroll
    for (int ks = 0; ks < 4; ++ks) tc[64 * ks] = __builtin_bit_cast(v4u, C[ks]);
}
__device__ __forceinline__ void table_load(const unsigned char* tab, int dg, int lane, Par& P, bf16x8 (&C)[4]) {
    const v4u* tb = (const v4u*)(tab + TAB_B) + (size_t)dg * 256 + lane; P.Bre1 = __builtin_bit_cast(bf16x8, tb[0]); P.Bim1 = __builtin_bit_cast(bf16x8, tb[64]); P.Bre2 = __builtin_bit_cast(bf16x8, tb[128]); P.Bim2 = __builtin_bit_cast(bf16x8, tb[192]);
    const float2 a = ((const float2*)(tab + TAB_A))[dg * 64 + lane]; P.a_re = a.x; P.a_im = a.y;
    const v4u* tc = (const v4u*)(tab + TAB_C) + (size_t)dg * 256 + lane;
#pragma unroll
    for (int ks = 0; ks < 4; ++ks) C[ks] = __builtin_bit_cast(bf16x8, tc[64 * ks]);
}
__device__ __forceinline__ int chunk_row0(int b, int tc) { return tc < 128 ? b * SEQ + 64 * tc : TLAT + b * CTXL + 64 * (tc - 128); }
__device__ __forceinline__ void load_chunk(const bf16* U, int row0, int g, int dir, int lane, bf16x8 (&A2)[2]) {
    const int r32 = lane & 31, hi = lane >> 5;
#pragma unroll
    for (int blk = 0; blk < 2; ++blk) { const int i = 32 * blk + r32, tok = dir ? 63 - i : i; A2[blk] = *(const bf16x8*)(U + (size_t)(row0 + tok) * MIXIN + g * S5H + 8 * hi); }
}
template <bool WRITE_H> __device__ __forceinline__ void run_chunk_pre(const Par& P, const bf16x8 (&A2)[2], int dir, int lane, float& sre, float& sim, LAS unsigned* Hbuf) {
#pragma unroll
    for (int blk = 0; blk < 2; ++blk) {
        const bf16x8 A = A2[blk];
        f32x16 G1r, G1i, G2r, G2i;
        asm volatile("s_nop 1\n\tv_mfma_f32_32x32x16_bf16 %0, %4, %5, 0\n\tv_mfma_f32_32x32x16_bf16 %1, %4, %6, 0\n\tv_mfma_f32_32x32x16_bf16 %2, %4, %7, 0\n\tv_mfma_f32_32x32x16_bf16 %3, %4, %8, 0\n\ts_nop 15"
                     : "=&v"(G1r), "=&v"(G1i), "=&v"(G2r), "=&v"(G2i) : "v"(A), "v"(P.Bre1), "v"(P.Bim1), "v"(P.Bre2), "v"(P.Bim2));
#pragma unroll
        for (int r = 0; r < 16; ++r) {
            auto sr = __builtin_amdgcn_permlane32_swap(__float_as_uint(G1r[r]), __float_as_uint(G2r[r]), false, false); G1r[r] = __uint_as_float(sr[0]); G2r[r] = __uint_as_float(sr[1]);
            auto si = __builtin_amdgcn_permlane32_swap(__float_as_uint(G1i[r]), __float_as_uint(G2i[r]), false, false); G1i[r] = __uint_as_float(si[0]); G2i[r] = __uint_as_float(si[1]); }
#define S5_STEP(XR, XI, STEPI) do { const float nr = fmaf(-P.a_im, sim, fmaf(P.a_re, sre, (XR))); const float ni = fmaf(P.a_im, sre, fmaf(P.a_re, sim, (XI))); sre = nr; sim = ni; \
        if (WRITE_H) { const int st_ = 32 * blk + (STEPI); const int tk_ = dir ? 63 - st_ : st_; Hbuf[tk_ * 68 + lane] = pk2(sre, sim); } } while (0)
#pragma unroll
        for (int j = 0; j < 4; ++j) {
#pragma unroll
            for (int q = 0; q < 4; ++q) S5_STEP(G1r[4 * j + q], G1i[4 * j + q], 8 * j + q);
#pragma unroll
            for (int q = 0; q < 4; ++q) S5_STEP(G2r[4 * j + q], G2i[4 * j + q], 8 * j + 4 + q);
        }
#undef S5_STEP
    }
}
template <bool WRITE_H> __device__ __forceinline__ void run_chunk(const Par& P, const bf16* U, int row0, int g, int dir, int lane, float& sre, float& sim, LAS unsigned* Hbuf) {
    bf16x8 A2[2]; load_chunk(U, row0, g, dir, lane, A2); run_chunk_pre<WRITE_H>(P, A2, dir, lane, sre, sim, Hbuf);
}
}

__device__ __forceinline__ void s1_phase(Frame& F, int ei) {
    const int gw = F.vcu * NWAVES + F.wave, NGW = F.G * NWAVES;
    const bf16* U = WSP(bf16, WS_BIG); float2* SE = WSP(float2, WS_SE);
    int cur = -1; s5::Par P;
    constexpr int NTASK = 2 * S5G * BATCH * NTC;
    for (int task = gw; task < NTASK; task += 2 * NGW) {
        const int dg = task % 128, idx = task / 128, dir = dg >> 6, g = dg & 63, b = idx / NTC, tc = idx % NTC;
        const int task2 = task + NGW; const bool has2 = task2 < NTASK; const int idx2 = has2 ? task2 / 128 : idx, b2 = idx2 / NTC, tc2 = idx2 % NTC;
        bf16x8 Aa[2], Ab[2];
        s5::load_chunk(U, s5::chunk_row0(b, tc), g, dir, F.lane, Aa); s5::load_chunk(U, s5::chunk_row0(b2, tc2), g, dir, F.lane, Ab);
        if (dg != cur) { s5::load_par(F.A, ei, dir, g, F.lane, P); cur = dg;
            if (idx == 0) { bf16x8 C[4]; s5::cfrags(F.A, ei, dir, g, F.lane, C); s5::table_store(F.ws + WS_MODP, dg, F.lane, P, C); } }
        { float sre = 0.f, sim = 0.f;
          s5::run_chunk_pre<false>(P, Aa, dir, F.lane, sre, sim, nullptr);
          SE[(((size_t)(b * 2 + dir) * S5G + g) * NTC + tc) * S5P + F.lane] = make_float2(sre, sim); }
        if (has2) { float sre = 0.f, sim = 0.f;
          s5::run_chunk_pre<false>(P, Ab, dir, F.lane, sre, sim, nullptr);
          SE[(((size_t)(b2 * 2 + dir) * S5G + g) * NTC + tc2) * S5P + F.lane] = make_float2(sre, sim); }
    }
    bf16* MIXA = WSP(bf16, WS_MIXA);
    const float* cw = F.A.in[22] + (size_t)ei * 3 * S5W; const float* cb = F.A.in[23] + (size_t)ei * S5W;
    const int c0 = F.lane * 16;
    f32x4 w0[4], w1[4], w2[4], wb4[4];
#pragma unroll
    for (int q = 0; q < 4; ++q) { w0[q] = *(const f32x4*)(cw + c0 + 4 * q); w1[q] = *(const f32x4*)(cw + S5W + c0 + 4 * q); w2[q] = *(const f32x4*)(cw + 2 * S5W + c0 + 4 * q); wb4[q] = *(const f32x4*)(cb + c0 + 4 * q); }
    for (int row = gw; row < TT; row += NGW) {
        const int t = row < TLAT ? (row & (SEQ - 1)) : ((row - TLAT) & (CTXL - 1)), len = row < TLAT ? SEQ : CTXL;
        const bool hp = t > 0, hn = t < len - 1;
        const bf16* pr = U + (size_t)row * MIXIN;
        v4u bgv[2], cg0v[2], v0v[2], cg1v[2], v1v[2], cg2v[2], v2v[2];
#pragma unroll
        for (int hh = 0; hh < 2; ++hh) { const int c = c0 + 8 * hh;
            bgv[hh] = *(const v4u*)(pr + 1024 + c); cg1v[hh] = *(const v4u*)(pr + 2048 + c); v1v[hh] = *(const v4u*)(pr + 3072 + c);
            cg0v[hh] = (v4u){0, 0, 0, 0}; v0v[hh] = cg0v[hh]; cg2v[hh] = cg0v[hh]; v2v[hh] = cg0v[hh];
            if (hp) { cg0v[hh] = *(const v4u*)(pr - MIXIN + 2048 + c); v0v[hh] = *(const v4u*)(pr - MIXIN + 3072 + c); }
            if (hn) { cg2v[hh] = *(const v4u*)(pr + MIXIN + 2048 + c); v2v[hh] = *(const v4u*)(pr + MIXIN + 3072 + c); } }
#pragma unroll
        for (int hh = 0; hh < 2; ++hh) { const int c = c0 + 8 * hh;
            const v4u bg = bgv[hh], cg0 = cg0v[hh], v0 = v0v[hh], cg1 = cg1v[hh], v1 = v1v[hh], cg2 = cg2v[hh], v2 = v2v[hh];
            float o[8];
#pragma unroll
            for (int e = 0; e < 4; ++e) { const unsigned wb = bg[e], a0 = cg0[e], b0 = v0[e], a1 = cg1[e], b1 = v1[e], a2 = cg2[e], b2 = v2[e]; const int q = 2 * hh + (e >> 1), z = 2 * (e & 1);
                o[2 * e] = bflo(wb) * (w0[q][z] * (bflo(a0) * bflo(b0)) + w1[q][z] * (bflo(a1) * bflo(b1)) + w2[q][z] * (bflo(a2) * bflo(b2)) + wb4[q][z]);
                o[2 * e + 1] = bfhi(wb) * (w0[q][z + 1] * (bfhi(a0) * bfhi(b0)) + w1[q][z + 1] * (bfhi(a1) * bfhi(b1)) + w2[q][z + 1] * (bfhi(a2) * bfhi(b2)) + wb4[q][z + 1]); }
            v4u w; w.x = pk2(o[0], o[1]); w.y = pk2(o[2], o[3]); w.z = pk2(o[4], o[5]); w.w = pk2(o[6], o[7]);
            *(v4u*)(MIXA + (size_t)row * DM + S5W + c) = w; }
    }
}
__device__ __forceinline__ void s2_phase(Frame& F, int ei) {
    if (F.wave != 0) return;
    const float2* SE = WSP(float2, WS_SE); float2* SC = WSP(float2, WS_SC);
    for (int combo = blockIdx.x; combo < BATCH * 2 * S5G; combo += F.G) {
        const int b = combo >> 7, dir = (combo >> 6) & 1, g = combo & 63, base = (ei * 2 + dir) * S5G + g;
        float ar, ai, cr, ci; s5::discretize(F.A.in[12][base * S5P + F.lane], F.A.in[13][base * S5P + F.lane], expf(F.A.in[14][base]), ar, ai, cr, ci);
#pragma unroll
        for (int q = 0; q < 6; ++q) { const float nr = ar * ar - ai * ai, ni = 2.0f * ar * ai; ar = nr; ai = ni; }
        const size_t off = ((size_t)(b * 2 + dir) * S5G + g) * NTC * S5P + F.lane;
        float sre = 0.f, sim = 0.f; asm volatile("" : "+v"(sre), "+v"(sim));
        for (int k0 = 0; k0 < NTC; k0 += 12) {
            float2 e[12];
#pragma unroll
            for (int q = 0; q < 12; ++q) { const int k = k0 + q; const int tc = dir ? (NTC - 1 - k) : (k < 4 ? 128 + k : k - 4); e[q] = SE[off + (size_t)tc * S5P]; }
#pragma unroll
            for (int q = 0; q < 12; ++q) { const int k = k0 + q; const int tc = dir ? (NTC - 1 - k) : (k < 4 ? 128 + k : k - 4);
                SC[off + (size_t)tc * S5P] = make_float2(sre, sim);
                const float nr = ar * sre - ai * sim + e[q].x, ni = ar * sim + ai * sre + e[q].y; sre = nr; sim = ni; }
        }
    }
}
__device__ __forceinline__ float gelu_tanh(float x) { const float u = 0.7978845608028654f * (x + 0.044715f * x * x * x); const float e = __expf(2.0f * u); const float t = 1.0f - 2.0f / (e + 1.0f); return 0.5f * x * (1.0f + t); }
__device__ __forceinline__ void s3_phase(Frame& F, int ei) {
    const int gw = F.vcu * NWAVES + F.wave, NGW = F.G * NWAVES;
    const bf16* U = WSP(bf16, WS_BIG); const float2* SC = WSP(float2, WS_SC); bf16* Z = WSP(bf16, WS_Z);
    const unsigned char* tab = F.ws + WS_MODP;
    LAS unsigned* Hbuf = (LAS unsigned*)(F.lds + F.wave * (64 * 68 * 4));
    LAS float* Ybuf = (LAS float*)Hbuf;
    const int fr = F.lane & 15, kq = F.lane >> 4;
    constexpr int NTASK = S5G * BATCH * NTC;
    s5::Par Pd[2]; bf16x8 Cd[2][4];
#pragma unroll
    for (int dir = 0; dir < 2; ++dir) s5::table_load(tab, dir * S5G + (gw % S5G), F.lane, Pd[dir], Cd[dir]);
    for (int task = gw; task < NTASK; task += NGW) {
        const int g = task % S5G, idx = task / S5G, b = idx / NTC, tc = idx % NTC;
        const int row0 = s5::chunk_row0(b, tc);
        f32x4 yacc[4] = {{0, 0, 0, 0}, {0, 0, 0, 0}, {0, 0, 0, 0}, {0, 0, 0, 0}};
        bf16x8 Ad[2][2]; s5::load_chunk(U, row0, g, 0, F.lane, Ad[0]); s5::load_chunk(U, row0, g, 1, F.lane, Ad[1]);
        float2 cin[2];
#pragma unroll
        for (int dir = 0; dir < 2; ++dir) cin[dir] = SC[(((size_t)(b * 2 + dir) * S5G + g) * NTC + tc) * S5P + F.lane];
        const v4u u0 = *(const v4u*)(U + (size_t)(row0 + F.lane) * MIXIN + g * S5H), u1 = *(const v4u*)(U + (size_t)(row0 + F.lane) * MIXIN + g * S5H + 8);
#pragma unroll
        for (int dir = 0; dir < 2; ++dir) {
            const s5::Par& P = Pd[dir]; const bf16x8 (&C)[4] = Cd[dir];
            float sre = cin[dir].x, sim = cin[dir].y;
            s5::run_chunk_pre<true>(P, Ad[dir], dir, F.lane, sre, sim, Hbuf);
            LDS_WAIT(); asm volatile("" ::: "memory");
#pragma unroll
            for (int tb = 0; tb < 4; ++tb)
#pragma unroll
                for (int ks = 0; ks < 4; ++ks) { const bf16x8 a = *(const LAS bf16x8*)(Hbuf + (16 * tb + fr) * 68 + 16 * ks + 4 * kq);
                    yacc[tb] = __builtin_amdgcn_mfma_f32_16x16x32_bf16(a, C[ks], yacc[tb], 0, 0, 0); }
            LDS_WAIT(); asm volatile("" ::: "memory");
        }
#pragma unroll
        for (int tb = 0; tb < 4; ++tb)
#pragma unroll
            for (int e = 0; e < 4; ++e) Ybuf[(16 * tb + 4 * kq + e) * 20 + fr] = yacc[tb][e];
        LDS_WAIT(); asm volatile("" ::: "memory");
        { const size_t row = (size_t)(row0 + F.lane);
          const float* dp = F.A.in[19] + ei * S5W + g * S5H;
          float z[16];
#pragma unroll
          for (int q = 0; q < 4; ++q) { const f32x4 y = *(const LAS f32x4*)(Ybuf + F.lane * 20 + 4 * q); const f32x4 d = *(const f32x4*)(dp + 4 * q);
              const unsigned w0 = q < 2 ? u0[2 * q] : u1[2 * q - 4], w1 = q < 2 ? u0[2 * q + 1] : u1[2 * q - 3];
              z[4 * q] = gelu_tanh(y[0] + d[0] * bflo(w0)); z[4 * q + 1] = gelu_tanh(y[1] + d[1] * bfhi(w0)); z[4 * q + 2] = gelu_tanh(y[2] + d[2] * bflo(w1)); z[4 * q + 3] = gelu_tanh(y[3] + d[3] * bfhi(w1)); }
          v4u o0, o1; o0.x = pk2(z[0], z[1]); o0.y = pk2(z[2], z[3]); o0.z = pk2(z[4], z[5]); o0.w = pk2(z[6], z[7]); o1.x = pk2(z[8], z[9]); o1.y = pk2(z[10], z[11]); o1.z = pk2(z[12], z[13]); o1.w = pk2(z[14], z[15]);
          *(v4u*)(Z + row * S5W + g * S5H) = o0; *(v4u*)(Z + row * S5W + g * S5H + 8) = o1; }
        LDS_WAIT(); asm volatile("" ::: "memory");
    }
}

__device__ __forceinline__ void attn_combine_block(Frame& F, const bf16* OC, bf16* AO, int row0, int h, int oi, float lam_init) {
    const int e0 = (F.lane & 15) * 8, sub = F.lane >> 4;
    const float* lv = F.A.in[26] + (size_t)oi * 4 * 64;
    const float lam = expf(wave_sum(lv[F.lane] * lv[64 + F.lane])) - expf(wave_sum(lv[128 + F.lane] * lv[192 + F.lane])) + lam_init;
    float g[8];
    { const float* sl = F.A.in[27] + (size_t)oi * 128 + e0;
#pragma unroll
      for (int e = 0; e < 8; ++e) g[e] = sl[e] * (1.0f - lam_init); }
#pragma unroll 2
    for (int it = 0; it < 8; ++it) { const size_t row = (size_t)(row0 + it * 32 + F.wave * 4 + sub);
        const v4u a = *(const v4u*)(OC + row * 4096 + h * 256 + e0), bq = *(const v4u*)(OC + row * 4096 + h * 256 + 128 + e0);
        float d[8]; float ss = 0.f;
#pragma unroll
        for (int e = 0; e < 4; ++e) { d[2 * e] = bflo(a[e]) - lam * bflo(bq[e]); d[2 * e + 1] = bfhi(a[e]) - lam * bfhi(bq[e]); ss += d[2 * e] * d[2 * e] + d[2 * e + 1] * d[2 * e + 1]; }
        ss += __shfl_xor(ss, 1); ss += __shfl_xor(ss, 2); ss += __shfl_xor(ss, 4); ss += __shfl_xor(ss, 8);
        const float r = rsqrtf(ss * (1.0f / 128.0f) + EPS);
        v4u w; w.x = pk2(d[0] * r * g[0], d[1] * r * g[1]); w.y = pk2(d[2] * r * g[2], d[3] * r * g[3]); w.z = pk2(d[4] * r * g[4], d[5] * r * g[5]); w.w = pk2(d[6] * r * g[6], d[7] * r * g[7]);
        *(v4u*)(AO + row * DM + h * 128 + e0) = w; }
}
__device__ __forceinline__ void attn_phase(Frame& F, int oi, float lam_init, bool ctx_queries) {
    const bf16* QKV = WSP(bf16, WS_BIG); bf16* OC = WSP(bf16, WS_OC); bf16* AO = WSP(bf16, WS_MIXA);
    char* lds = (char*)F.lds;
    const int npairs = BATCH * 16 * 32 + (ctx_queries ? BATCH * 16 : 0);
    for (int pair = F.vcu; pair < npairs; pair += F.G) {
        int qrow0, h, lat0, nlat, ctx0, NT;
        if (pair < BATCH * 16 * 32) { const int qb = pair & 31, hb = pair >> 5, b = hb >> 4; h = hb & 15;
            qrow0 = b * SEQ + qb * 256; lat0 = b * SEQ; nlat = 128; ctx0 = TLAT + b * CTXL; NT = 132; }
        else { const int hb = pair - BATCH * 16 * 32, b = hb >> 4; h = hb & 15;
            qrow0 = TLAT + b * CTXL; lat0 = 0; nlat = 0; ctx0 = TLAT + b * CTXL; NT = 4; }
#pragma unroll 1
        for (int c = 0; c < 2; ++c)
            att::attn_unit(QKV, OC, qrow0, h * 128 + c * 64, DM + h * 128 + c * 64, 2 * DM + h * 128, h * 256 + c * 128, lat0, nlat, ctx0, NT, lds, F.tid);
        attn_combine_block(F, OC, AO, qrow0, h, oi, lam_init);
    }
}
__global__ void __launch_bounds__(NWAVES * 64, 2) mk_fwd(Args args) {
    extern __shared__ __attribute__((aligned(16))) unsigned char lds[];
    Frame F{args};
    F.lds = (LAS unsigned char*)lds;
    F.tid = threadIdx.x; F.lane = F.tid & 63; F.wave = __builtin_amdgcn_readfirstlane(F.tid >> 6);
    F.G = gridDim.x; { const int bx = blockIdx.x; F.vcu = (F.G % 8 == 0) ? (bx % 8) * (F.G / 8) + bx / 8 : bx; }
    F.ws = args.ws; F.out = args.out;
    volatile LAS unsigned* MISC = (volatile LAS unsigned*)(F.lds + MISC_OFF);
    for (int u = F.tid; u < (LDS_BYTES - LDSCTL_OFF) / 4; u += NWAVES * 64) ((LAS unsigned*)(F.lds + LDSCTL_OFF))[u] = 0u;
    __syncthreads();
    const int lo = args.ph_lo, hi = args.ph_hi;
    XcdBarrier bar; bar.bar = (unsigned*)(F.ws + WS_CTL) + CW_BAR; bar.x = 0; bar.st = nullptr;
    if (hi - lo > 1) bar = xcd_barrier_post((unsigned*)(F.ws + WS_CTL) + CW_BAR, MISC + 8);
    int ph = 0;
#define PH_BEGIN if (ph >= lo && ph < hi) { { int t_ = threadIdx.x; asm volatile("" : "+v"(t_)); F.tid = t_; F.lane = t_ & 63; F.wave = __builtin_amdgcn_readfirstlane(t_ >> 6); \
        GAS unsigned char* w_ = (GAS unsigned char*)args.ws; asm volatile("" : "+s"(w_)); F.ws = (unsigned char*)w_; }
#define PH_END   if (ph + 1 < hi) xcd_barrier(bar); } ++ph;

    PH_BEGIN p0_prologue(F); PH_END
    PH_BEGIN p1_ada_reduce(F); PH_END
    PH_BEGIN resid_norm_phase(F, -1); PH_END

    for (int sub = 0; sub < NSUB; ++sub) {
        const int layer = sub / 3, s = sub % 3;
        const bool mix_ctx = layer < DEPTH - 1;
        const bool need_ctx = mix_ctx || s == 0;
        if (s != 1) {
            const int lh = layer * 2 + (s >> 1);
            constexpr int NCG = 2 * (2 * FF / 256), NCS = (TCTX / 256) * (DM / 256) * NZ_DOWN;
            unsigned* hcnt = (unsigned*)(F.ws + WS_CTL) + CW_HOST + 64 * sub;
            for (int part = 0; part < 2; ++part) {
                PH_BEGIN
                    const bool cg = need_ctx && (int)blockIdx.x < NCG;
                    if (part == 0 || cg) {
                        pg8::Gemm g{WSP(const pg8::bf16_t, WS_H), WSP(const pg8::bf16_t, WS_WGU + lh * WGU_ONE), TT, 2 * FF, DM, DM}; pg8::StaticOrder S;
                        if (part == 0) S.init(TLAT, 2 * FF, F.G, (int)blockIdx.x, 0, 8); else S.init(TCTX, 2 * FF, NCG, (int)blockIdx.x, TLAT / 256);
                        pg8::EpiSwiGLU E{WSP(pg8::bf16_t, WS_BIG), FF};
                        pg8::gemm_phase<pg8::EpiSwiGLU, pg8::StaticOrder, true, true>(F.lds, g, S, E);
                    }
                    if (part == 1) {
                        if (cg) host_arrive(hcnt);
                        pg8::Gemm g{WSP(const pg8::bf16_t, WS_BIG), WSP(const pg8::bf16_t, WS_WD + lh * WD_ONE), TLAT, DM, FF, FF}; pg8::StaticOrder S; S.init(TLAT, DM, F.G, (int)blockIdx.x);
                        pg8::EpiPlain E{WSP(pg8::bf16_t, WS_Y), DM};
                        pg8::gemm_phase<pg8::EpiPlain, pg8::StaticOrder, true, true>(F.lds, g, S, E);
                        const int cs = (int)blockIdx.x - NCG;
                        if (need_ctx && cs >= 0 && cs < NCS) {
                            host_wait(hcnt, (unsigned)NCG);
                            pg8::Gemm g2{WSP(const pg8::bf16_t, WS_BIG), WSP(const pg8::bf16_t, WS_WD + lh * WD_ONE), TT, DM, FF / NZ_DOWN, FF}; pg8::SplitOrder S2; S2.init(TLAT / 256, TCTX / 256, DM, NZ_DOWN, NCS, cs);
                            pg8::EpiPartial E2{WSP(float, WS_PART), DM, TLAT, (size_t)TCTX * DM};
                            pg8::gemm_phase<pg8::EpiPartial, pg8::SplitOrder, true, true>(F.lds, g2, S2, E2);
                        }
                    }
                PH_END
            }
        } else if ((layer & 1) == 0) {
            const int ei = layer >> 1;
            PH_BEGIN
                pg8::Gemm g{WSP(const pg8::bf16_t, WS_H), WSP(const pg8::bf16_t, WS_WIN + (size_t)ei * MIXIN * DM * 2), TT, MIXIN, DM, DM}; pg8::StaticOrder S; S.init(TT, MIXIN, F.G, (int)blockIdx.x);
                pg8::EpiPlain E{WSP(pg8::bf16_t, WS_BIG), MIXIN};
                pg8::gemm_phase<pg8::EpiPlain, pg8::StaticOrder, true, true>(F.lds, g, S, E);
            PH_END
            PH_BEGIN s1_phase(F, ei); PH_END
            PH_BEGIN s2_phase(F, ei); PH_END
            PH_BEGIN s3_phase(F, ei); PH_END
            PH_BEGIN
                pg8::Gemm g{WSP(const pg8::bf16_t, WS_Z), WSP(const pg8::bf16_t, WS_WGLU + (size_t)ei * S5W * S5W * 2), TT, S5W, S5W, S5W}; pg8::StaticOrder S; S.init(TT, S5W, F.G, (int)blockIdx.x);
                pg8::EpiGLU E{WSP(const pg8::bf16_t, WS_Z), S5W, F.A.in[21] + (size_t)ei * S5W, WSP(pg8::bf16_t, WS_MIXA), DM};
                pg8::gemm_phase<pg8::EpiGLU, pg8::StaticOrder, true, true>(F.lds, g, S, E);
            PH_END
            PH_BEGIN
                const pg8::bf16_t* Wp = WSP(const pg8::bf16_t, WS_WOUT + (size_t)ei * DM * MIXOUT * 2);
                pg8::Gemm g{WSP(const pg8::bf16_t, WS_MIXA), Wp, TLAT, DM, MIXOUT, MIXOUT}; pg8::StaticOrder S; S.init(TLAT, DM, F.G, (int)blockIdx.x);
                pg8::EpiPlain E{WSP(pg8::bf16_t, WS_Y), DM};
                pg8::gemm_phase<pg8::EpiPlain, pg8::StaticOrder, true, true>(F.lds, g, S, E);
                pg8::Gemm g2{WSP(const pg8::bf16_t, WS_MIXA), Wp, TT, DM, MIXOUT / NZ_OUT, MIXOUT}; pg8::SplitOrder S2; S2.init(TLAT / 256, TCTX / 256, DM, NZ_OUT, F.G, (int)blockIdx.x);
                pg8::EpiPartial E2{WSP(float, WS_PART), DM, TLAT, (size_t)TCTX * DM};
                if (mix_ctx) pg8::gemm_phase<pg8::EpiPartial, pg8::SplitOrder, true, true>(F.lds, g2, S2, E2);
            PH_END
        } else {
            const int oi = layer >> 1;
            PH_BEGIN
                pg8::Gemm g{WSP(const pg8::bf16_t, WS_H), WSP(const pg8::bf16_t, WS_WQKV + (size_t)oi * 3 * DM * DM * 2), TT, 3 * DM, DM, DM}; pg8::StaticOrder S; S.init(TT, 3 * DM, F.G, (int)blockIdx.x);
                pg8::EpiQKV E{WSP(pg8::bf16_t, WS_BIG), 3 * DM, WSP(const float, WS_ROPE), 0.125f * 1.4426950408889634f};
                pg8::gemm_phase<pg8::EpiQKV, pg8::StaticOrder, true, true>(F.lds, g, S, E);
            PH_END
            PH_BEGIN attn_phase(F, oi, oi == 0 ? 0.35550906759096934f : 0.5560582041556406f, mix_ctx); PH_END
            PH_BEGIN
                const pg8::bf16_t* Wp = WSP(const pg8::bf16_t, WS_WO + (size_t)oi * DM * DM * 2);
                pg8::Gemm g{WSP(const pg8::bf16_t, WS_MIXA), Wp, TLAT, DM, DM, DM}; pg8::StaticOrder S; S.init(TLAT, DM, F.G, (int)blockIdx.x);
                pg8::EpiPlain E{WSP(pg8::bf16_t, WS_Y), DM};
                pg8::gemm_phase<pg8::EpiPlain, pg8::StaticOrder, true, true>(F.lds, g, S, E);
                pg8::Gemm g2{WSP(const pg8::bf16_t, WS_MIXA), Wp, TT, DM, DM / NZ_OUT, DM}; pg8::SplitOrder S2; S2.init(TLAT / 256, TCTX / 256, DM, NZ_OUT, F.G, (int)blockIdx.x);
                pg8::EpiPartial E2{WSP(float, WS_PART), DM, TLAT, (size_t)TCTX * DM};
                pg8::gemm_phase<pg8::EpiPartial, pg8::SplitOrder, true, true>(F.lds, g2, S2, E2);
            PH_END
        }
        PH_BEGIN resid_norm_phase(F, sub, (mix_ctx || s == 0) ? TCTX : 0); PH_END
    }
#undef PH_BEGIN
#undef PH_END
}

static int count_phases() { int n = 3; for (int sub = 0; sub < NSUB; ++sub) { const int layer = sub / 3, s = sub % 3; n += (s != 1) ? 2 : ((layer & 1) == 0 ? 6 : 3); n += 1; } return n; }
extern "C" void kernel_launch(void* const* d_in, const int* in_sizes, int n_in, void* d_out, int out_size, void* d_ws, size_t ws_size, hipStream_t stream) {
    static int grid = 0;
    if (grid == 0) {
        if (n_in != 28 || in_sizes[0] != TLAT * DM || out_size != TLAT * DM || ws_size < WS_END) { fprintf(stderr, "kernel_launch: shape mismatch: n_in %d in0 %d out %d ws %zu (need %zu)\n", n_in, n_in > 0 ? in_sizes[0] : -1, out_size, ws_size, (size_t)WS_END); grid = -1; return; }
        int dev = 0, cus = 0, per_cu = 0;
        if (hipGetDevice(&dev) != hipSuccess || hipDeviceGetAttribute(&cus, hipDeviceAttributeMultiprocessorCount, dev) != hipSuccess) { grid = -1; return; }
        if (hipFuncSetAttribute((const void*)mk_fwd, hipFuncAttributeMaxDynamicSharedMemorySize, LDS_BYTES) != hipSuccess) { fprintf(stderr, "kernel_launch: hipFuncSetAttribute failed\n"); grid = -1; return; }
        if (hipOccupancyMaxActiveBlocksPerMultiprocessor(&per_cu, (const void*)mk_fwd, NWAVES * 64, LDS_BYTES) != hipSuccess || per_cu < 1) { fprintf(stderr, "kernel_launch: occupancy query says %d\n", per_cu); }
        (void)hipGetLastError();
        grid = cus;
    }
    if (grid < 0) return;
    if (hipMemsetAsync((char*)d_ws + WS_CTL, 0, CTL_ZERO_BYTES, stream) != hipSuccess) return;
    Args a{};
    for (int i = 0; i < 28; ++i) a.in[i] = (const float*)d_in[i];
    a.out = (float*)d_out; a.ws = (unsigned char*)d_ws;
    const int nph = count_phases();
#if ONE_LAUNCH
    a.ph_lo = 0; a.ph_hi = nph;
    hipLaunchKernelGGL(mk_fwd, dim3(grid), dim3(NWAVES * 64), LDS_BYTES, stream, a);
#else
    for (int p = 0; p < nph; ++p) { a.ph_lo = p; a.ph_hi = p + 1; hipLaunchKernelGGL(mk_fwd, dim3(grid), dim3(NWAVES * 64), LDS_BYTES, stream, a); }
#endif
    const hipError_t le = hipPeekAtLastError();
    if (le != hipSuccess) fprintf(stderr, "kernel_launch: launch failed: %s\n", hipGetErrorName(le));
}
```

```cpp
#include <hip/hip_runtime.h>
#include <cstdio>
#include <cstdint>
#include <cmath>
namespace pg8 {
#define PG8_LAS __attribute__((address_space(3)))
typedef unsigned short bf16_t;
typedef short bf16x8 __attribute__((ext_vector_type(8)));
typedef float f32x4 __attribute__((ext_vector_type(4)));
typedef unsigned u32x4 __attribute__((ext_vector_type(4)));
constexpr int BM = 256, BK = 64, HALF = 128, HTB = HALF * BK * 2  , STAGE_BYTES = 8 * HTB, NXCD = 8, WGM = 4;

__host__ __device__ __forceinline__ int lds_byte(int r, int c) { const int st = (r >> 4) * 2 + (c >> 5), rr = r & 15, cc = c & 31, ob = rr * 64 + cc * 2; return st * 1024 + (ob ^ (((ob >> 9) & 1) << 5)); }
__host__ __device__ __forceinline__ void stage_rc(int b, int& R, int& C) { const int st = b / 1024, sb = b % 1024, swz = sb ^ (((sb >> 9) & 1) << 5); R = (st >> 1) * 16 + swz / 64; C = (st & 1) * 32 + (swz % 64) / 2; }
__host__ __device__ __forceinline__ int perm32(int rho) { const int n = rho >> 4, i = rho & 15; return 8 * (i >> 2) + 4 * n + (i & 3); }

struct Unit { int pm, pn, kz, kind; };
struct Gemm { const bf16_t* A; const bf16_t* Bt; int M, N, K, ld; };

struct StaticOrder {
    int nM, nN, nwg, G, c, pm0, wgm;
    __host__ __device__ void init(int M, int N, int G_, int c_, int pm0_ = 0, int wgm_ = WGM) { nM = M / BM; nN = N / BM; nwg = nM * nN; G = G_; c = c_; pm0 = pm0_; wgm = wgm_; }
    __host__ __device__ bool next(int i, Unit& u) const {
        const long L = (long)i * G + c; if (L >= nwg) return false;
        int wgid = (int)L; { const int q = nwg / NXCD, r = nwg % NXCD, xcd = wgid % NXCD, off = wgid / NXCD; wgid = (xcd < r ? xcd * (q + 1) : r * (q + 1) + (xcd - r) * q) + off; }
        const int nig = wgm * nN, gid = wgid / nig, fm = gid * wgm, gsz = (nM - fm) < wgm ? (nM - fm) : wgm;
        u.pm = pm0 + fm + ((wgid % nig) % gsz); u.pn = (wgid % nig) / gsz; u.kz = 0; u.kind = 0; return true;
    }
    __device__ __forceinline__ void a_ready(const Unit&) const {}
    __device__ __forceinline__ void done(const Unit&) const {}
};

__device__ __forceinline__ unsigned cvt_pk_bf16(float lo, float hi) { unsigned r; asm volatile("v_cvt_pk_bf16_f32 %0, %1, %2" : "=v"(r) : "v"(lo), "v"(hi)); return r; }
typedef float f32x2 __attribute__((ext_vector_type(2)));
typedef unsigned u32x2 __attribute__((ext_vector_type(2)));
__device__ __forceinline__ float sigmoid_f(float v) { return __builtin_amdgcn_rcpf(1.0f + __builtin_amdgcn_exp2f(-1.4426950408889634f * v)); }
__device__ __forceinline__ float bf_lo(unsigned w) { return __uint_as_float(w << 16); }
__device__ __forceinline__ float bf_hi(unsigned w) { return __uint_as_float(w & 0xffff0000u); }
__device__ __forceinline__ u32x4 pack8(const f32x4 v0, const f32x4 v1) { u32x4 w; w.x = cvt_pk_bf16(v0[0], v0[1]); w.y = cvt_pk_bf16(v0[2], v0[3]); w.z = cvt_pk_bf16(v1[0], v1[1]); w.w = cvt_pk_bf16(v1[2], v1[3]); return w; }

struct EpiPlain {
    static constexpr bool PERM = true, AFTER_DRAIN = false;
    bf16_t* O; int ldc;
    __device__ __forceinline__ void operator()(const f32x4 (&acc)[2][2][4][2], const Unit& u, int wr, int wc, int fr, int fq) const {
        const int row0 = u.pm * BM + wr * 64 + fr, col0 = u.pn * BM + wc * 32 + 8 * fq;
#pragma unroll
        for (int ai = 0; ai < 2; ++ai)
#pragma unroll
            for (int m = 0; m < 4; ++m) { bf16_t* rowp = O + (size_t)(row0 + ai * HALF + m * 16) * ldc + col0;
#pragma unroll
                for (int bj = 0; bj < 2; ++bj) *(u32x4*)(rowp + bj * HALF) = pack8(acc[ai][bj][m][0], acc[ai][bj][m][1]); }
    }
};
struct EpiSwiGLU {
    static constexpr bool PERM = true, AFTER_DRAIN = false;
    bf16_t* O; int ldc;
    __device__ __forceinline__ void operator()(const f32x4 (&acc)[2][2][4][2], const Unit& u, int wr, int wc, int fr, int fq) const {
        const int row0 = u.pm * BM + wr * 64 + fr, col0 = u.pn * HALF + wc * 32 + 8 * fq;
#pragma unroll
        for (int ai = 0; ai < 2; ++ai)
#pragma unroll
            for (int m = 0; m < 4; ++m) { bf16_t* rowp = O + (size_t)(row0 + ai * HALF + m * 16) * ldc + col0;
                const f32x4 g0 = acc[ai][0][m][0], g1 = acc[ai][0][m][1];
                f32x4 t0 = g0 * -1.4426950408889634f, t1 = g1 * -1.4426950408889634f;
#pragma unroll
                for (int e = 0; e < 4; ++e) { t0[e] = __builtin_amdgcn_exp2f(t0[e]); t1[e] = __builtin_amdgcn_exp2f(t1[e]); }
                t0 = t0 + 1.0f; t1 = t1 + 1.0f;
#pragma unroll
                for (int e = 0; e < 4; ++e) { t0[e] = __builtin_amdgcn_rcpf(t0[e]); t1[e] = __builtin_amdgcn_rcpf(t1[e]); }
                const f32x4 h0 = (g0 * acc[ai][1][m][0]) * t0, h1 = (g1 * acc[ai][1][m][1]) * t1;
                *(u32x4*)rowp = pack8(h0, h1); }
    }
};
struct EpiGLU {
    static constexpr bool PERM = true, AFTER_DRAIN = false;
    const bf16_t* Z; int ldz; const float* bias; bf16_t* O; int ldo;
    __device__ __forceinline__ void operator()(const f32x4 (&acc)[2][2][4][2], const Unit& u, int wr, int wc, int fr, int fq) const {
        const int row0 = u.pm * BM + wr * 64 + fr, col0 = u.pn * BM + wc * 32 + 8 * fq;
        f32x4 bv[2][2];
#pragma unroll
        for (int bj = 0; bj < 2; ++bj)
#pragma unroll
            for (int n = 0; n < 2; ++n) bv[bj][n] = *(const f32x4*)(bias + col0 + bj * HALF + 4 * n);
#pragma unroll
        for (int ai = 0; ai < 2; ++ai)
#pragma unroll
            for (int m = 0; m < 4; ++m) { const size_t r = (size_t)(row0 + ai * HALF + m * 16);
#pragma unroll
                for (int bj = 0; bj < 2; ++bj) { const u32x4 zw = *(const u32x4*)(Z + r * ldz + col0 + bj * HALF);
                    const f32x4 v0 = acc[ai][bj][m][0] + bv[bj][0], v1 = acc[ai][bj][m][1] + bv[bj][1];
                    f32x4 o0, o1;
                    o0[0] = bf_lo(zw.x) * sigmoid_f(v0[0]); o0[1] = bf_hi(zw.x) * sigmoid_f(v0[1]); o0[2] = bf_lo(zw.y) * sigmoid_f(v0[2]); o0[3] = bf_hi(zw.y) * sigmoid_f(v0[3]);
                    o1[0] = bf_lo(zw.z) * sigmoid_f(v1[0]); o1[1] = bf_hi(zw.z) * sigmoid_f(v1[1]); o1[2] = bf_lo(zw.w) * sigmoid_f(v1[2]); o1[3] = bf_hi(zw.w) * sigmoid_f(v1[3]);
                    *(u32x4*)(O + r * ldo + col0 + bj * HALF) = pack8(o0, o1); } }
    }
};
struct EpiQKV {
    static constexpr bool PERM = true, AFTER_DRAIN = false;
    bf16_t* O; int ldc; const float* cs; float qscale;
    __device__ __forceinline__ void operator()(const f32x4 (&acc)[2][2][4][2], const Unit& u, int wr, int wc, int fr, int fq) const {
        const int row0 = u.pm * BM + wr * 64 + fr;
        if (u.pn >= 16) {
            const int col0 = u.pn * BM + wc * 32 + 8 * fq;
#pragma unroll
            for (int ai = 0; ai < 2; ++ai)
#pragma unroll
                for (int m = 0; m < 4; ++m) { bf16_t* rowp = O + (size_t)(row0 + ai * HALF + m * 16) * ldc + col0;
#pragma unroll
                    for (int bj = 0; bj < 2; ++bj) *(u32x4*)(rowp + bj * HALF) = pack8(acc[ai][bj][m][0], acc[ai][bj][m][1]); }
            return;
        }
        const float sc = (u.pn < 8) ? qscale : 1.0f;
        const bool rope = (u.pm < 64);
        const int col1 = u.pn * BM + 64 * wc + 8 * fq;
#pragma unroll
        for (int ai = 0; ai < 2; ++ai)
#pragma unroll
            for (int m = 0; m < 4; ++m) { const int row = row0 + ai * HALF + m * 16;
                f32x4 c0, s0, c1, s1;
                if (rope) { const int t = row & 8191; const int pos = (fq < 2) ? (t >> 6) : (t & 63);
                    const f32x4* tp = (const f32x4*)(cs + (size_t)(pos * 16 + 8 * (fq & 1)) * 2);
                    const f32x4 a = tp[0], b = tp[1], c = tp[2], d = tp[3];
                    c0 = (f32x4){a[0], a[2], b[0], b[2]}; s0 = (f32x4){a[1], a[3], b[1], b[3]}; c1 = (f32x4){c[0], c[2], d[0], d[2]}; s1 = (f32x4){c[1], c[3], d[1], d[3]};
                } else { c0 = c1 = (f32x4){1.f, 1.f, 1.f, 1.f}; s0 = s1 = (f32x4){0.f, 0.f, 0.f, 0.f}; }
                const f32x4 x10 = acc[ai][0][m][0], x11 = acc[ai][0][m][1], x20 = acc[ai][1][m][0], x21 = acc[ai][1][m][1];
                const f32x4 o10 = (x10 * c0 - x20 * s0) * sc, o11 = (x11 * c1 - x21 * s1) * sc, o20 = (x10 * s0 + x20 * c0) * sc, o21 = (x11 * s1 + x21 * c1) * sc;
                bf16_t* rowp = O + (size_t)row * ldc + col1;
                *(u32x4*)rowp = pack8(o10, o11); *(u32x4*)(rowp + 32) = pack8(o20, o21); }
    }
};

struct SplitOrder {
    int pm0, nN, nz, total, G, c;
    __host__ __device__ void init(int pm0_, int npm, int N, int nz_, int G_, int c_) { pm0 = pm0_; nN = N / BM; nz = nz_; total = npm * nN * nz; G = G_; c = c_; }
    __host__ __device__ bool next(int i, Unit& u) const { const long L = (long)i * G + c; if (L >= total) return false; const int l = (int)L; u.kz = l % nz; const int r = l / nz; u.pn = r % nN; u.pm = pm0 + r / nN; u.kind = 1; return true; }
    __device__ __forceinline__ void a_ready(const Unit&) const {}
    __device__ __forceinline__ void done(const Unit&) const {}
};
struct EpiPartial {
    static constexpr bool PERM = true, AFTER_DRAIN = false;
    float* P; int ldc, row0; size_t zstride;
    __device__ __forceinline__ void operator()(const f32x4 (&acc)[2][2][4][2], const Unit& u, int wr, int wc, int fr, int fq) const {
        const int r0 = u.pm * BM + wr * 64 + fr - row0, col0 = u.pn * BM + wc * 32 + 8 * fq;
        float* base = P + (size_t)u.kz * zstride;
#pragma unroll
        for (int ai = 0; ai < 2; ++ai)
#pragma unroll
            for (int m = 0; m < 4; ++m) { float* rowp = base + (size_t)(r0 + ai * HALF + m * 16) * ldc + col0;
#pragma unroll
                for (int bj = 0; bj < 2; ++bj) { *(f32x4*)(rowp + bj * HALF) = acc[ai][bj][m][0]; *(f32x4*)(rowp + bj * HALF + 4) = acc[ai][bj][m][1]; } }
    }
};

struct MixedOrder {
    StaticOrder A; SplitOrder B; int nA;
    __host__ __device__ void init(int M, int N, int pm0, int npm, int nz, int G, int c) { A.init(M, N, G, c); B.init(pm0, npm, N, nz, G, c); nA = (A.nwg > c) ? (A.nwg - c + G - 1) / G : 0; }
    __host__ __device__ bool next(int i, Unit& u) const { return i < nA ? A.next(i, u) : B.next(i - nA, u); }
    __device__ __forceinline__ void a_ready(const Unit&) const {}
    __device__ __forceinline__ void done(const Unit&) const {}
};

template <class Epi, class Sched, bool ALIGN_EPI = false, bool SP2 = false>
__device__ __forceinline__ void gemm_phase(PG8_LAS unsigned char* lds, const Gemm g, const Sched& S, const Epi& E) {
    int tid_ = threadIdx.x; asm volatile("" : "+v"(tid_));
    const int tid = tid_, wid = __builtin_amdgcn_readfirstlane(tid >> 6), lane = tid & 63, wr = wid >> 2, wc = wid & 3, fr = lane & 15, fq = lane >> 4;
    const int K = g.K, nt = K / BK;
    unsigned voffA[2], voffB[2];
#pragma unroll
    for (int i = 0; i < 2; ++i) { int R, C; stage_rc(tid * 16 + i * 8192, R, C); const int Rb = Epi::PERM ? ((R & ~31) + perm32(R & 31)) : R;
        voffA[i] = (unsigned)(R * g.ld + C) * 2u; voffB[i] = (unsigned)(Rb * g.ld + C) * 2u; }
    const size_t kstep = (size_t)(BK * 2);
    const size_t hstep = (size_t)HALF * g.ld * 2; const size_t zstep = (size_t)K * 2;
    const size_t tstep = 2 * hstep;
    const unsigned ldsw = (unsigned)wid * 1024u;
    const int aoff = lds_byte(wr * 64 + fr, fq * 8), boff = lds_byte(wc * 32 + fr, fq * 8);
#define PG8_SA(b, h) (((b) * 2 + (h)) * HTB)
#define PG8_SB(b, h) ((4 + (b) * 2 + (h)) * HTB)
#define PG8_STAGE(bufoff, gbase, voff) do { _Pragma("unroll") for (int _i = 0; _i < 2; ++_i) \
        __builtin_amdgcn_global_load_lds((const unsigned*)((const char*)(gbase) + (voff)[_i]), (PG8_LAS unsigned*)(lds + (bufoff) + ldsw + _i * 8192), 16, 0, 0); } while (0)
#define PG8_LDA(dst, b, h) do { _Pragma("unroll") for (int m = 0; m < 4; ++m) _Pragma("unroll") for (int k = 0; k < 2; ++k) dst[m][k] = *(const PG8_LAS bf16x8*)(lds + PG8_SA(b, h) + aoff + m * 2048 + k * 1024); } while (0)
#define PG8_LDB(dst, b, h) do { _Pragma("unroll") for (int n = 0; n < 2; ++n) _Pragma("unroll") for (int k = 0; k < 2; ++k) dst[n][k] = *(const PG8_LAS bf16x8*)(lds + PG8_SB(b, h) + boff + n * 2048 + k * 1024); } while (0)
#define PG8_MMA(ai, bj, At, Bt) do { __builtin_amdgcn_s_setprio(1); _Pragma("unroll") for (int m = 0; m < 4; ++m) _Pragma("unroll") for (int n = 0; n < 2; ++n) _Pragma("unroll") for (int k = 0; k < 2; ++k) \
        acc[ai][bj][m][n] = __builtin_amdgcn_mfma_f32_16x16x32_bf16(Bt[n][k], At[m][k], acc[ai][bj][m][n], 0, 0, 0); __builtin_amdgcn_s_setprio(0); } while (0)
#define PG8_WAIT_V(n) asm volatile("s_waitcnt vmcnt(" #n ")" ::: "memory")
#define PG8_WAIT_L(n) asm volatile("s_waitcnt lgkmcnt(" #n ")" ::: "memory")
#define PG8_BAR __builtin_amdgcn_s_barrier()
#define PG8_SCHED __builtin_amdgcn_sched_barrier(0)
    Unit cur, nxt; int ui = 0;
    if (!S.next(0, cur)) return;
    f32x4 acc[2][2][4][2];
#pragma unroll
    for (int a = 0; a < 2; ++a)
#pragma unroll
        for (int b = 0; b < 2; ++b)
#pragma unroll
            for (int m = 0; m < 4; ++m)
#pragma unroll
                for (int n = 0; n < 2; ++n) acc[a][b][m][n] = (f32x4){0.f, 0.f, 0.f, 0.f};
    bf16x8 At[4][2], B0[2][2], B1[2][2];
    const char* cA = (const char*)g.A + (size_t)cur.pm * tstep + (size_t)cur.kz * zstep; const char* cB = (const char*)g.Bt + (size_t)cur.pn * tstep + (size_t)cur.kz * zstep;
    S.a_ready(cur);
    if constexpr (SP2) {
        PG8_STAGE(PG8_SB(0, 0), cB, voffB); PG8_STAGE(PG8_SB(0, 1), cB + hstep, voffB); PG8_STAGE(PG8_SA(0, 0), cA, voffA); PG8_STAGE(PG8_SA(0, 1), cA + hstep, voffA);
        if (wr == 1) PG8_BAR;
        PG8_WAIT_V(2); PG8_BAR;
        PG8_STAGE(PG8_SB(1, 0), cB + kstep, voffB); PG8_STAGE(PG8_SA(1, 0), cA + kstep, voffA); PG8_STAGE(PG8_SB(1, 1), cB + hstep + kstep, voffB);
        PG8_WAIT_V(6); PG8_BAR;
    } else {
        PG8_STAGE(PG8_SB(0, 0), cB, voffB); PG8_STAGE(PG8_SA(0, 0), cA, voffA); PG8_STAGE(PG8_SB(0, 1), cB + hstep, voffB); PG8_STAGE(PG8_SA(0, 1), cA + hstep, voffA);
        if (wr == 1) PG8_BAR;
        PG8_WAIT_V(4); PG8_BAR;
        PG8_STAGE(PG8_SB(1, 0), cB + kstep, voffB); PG8_STAGE(PG8_SA(1, 0), cA + kstep, voffA); PG8_STAGE(PG8_SB(1, 1), cB + hstep + kstep, voffB);
        PG8_WAIT_V(6); PG8_BAR;
    }
    for (;;) {
        const bool has_next = S.next(ui + 1, nxt);
        const char* nA = has_next ? (const char*)g.A + (size_t)nxt.pm * tstep + (size_t)nxt.kz * zstep : cA; const char* nB = has_next ? (const char*)g.Bt + (size_t)nxt.pn * tstep + (size_t)nxt.kz * zstep : cB;
        for (int t = 0; t < nt; t += 2) {
            const bool last = (t == nt - 2);
            const char* a1 = cA + (size_t)(t + 1) * kstep;
            const char* a2 = last ? nA : cA + (size_t)(t + 2) * kstep; const char* b2 = last ? nB : cB + (size_t)(t + 2) * kstep;
            const char* a3 = a2 + kstep; const char* b3 = b2 + kstep;
            if (last && has_next) S.a_ready(nxt);
            if constexpr (SP2) {
            PG8_LDB(B0, 0, 0); PG8_LDB(B1, 0, 1); PG8_SCHED; PG8_LDA(At, 0, 0); PG8_STAGE(PG8_SA(1, 1), a1 + hstep, voffA);
            PG8_WAIT_V(8); PG8_WAIT_L(0); PG8_BAR; PG8_MMA(0, 0, At, B0); PG8_MMA(0, 1, At, B1); PG8_BAR; PG8_SCHED;
            PG8_LDA(At, 0, 1); PG8_STAGE(PG8_SB(0, 0), b2, voffB); PG8_STAGE(PG8_SB(0, 1), b2 + hstep, voffB); PG8_STAGE(PG8_SA(0, 0), a2, voffA);
            PG8_WAIT_V(8); PG8_WAIT_L(0); PG8_BAR; PG8_MMA(1, 0, At, B0); PG8_MMA(1, 1, At, B1); PG8_BAR; PG8_SCHED;
            PG8_LDB(B0, 1, 0); PG8_LDB(B1, 1, 1); PG8_SCHED; PG8_LDA(At, 1, 0); PG8_STAGE(PG8_SA(0, 1), a2 + hstep, voffA);
            PG8_WAIT_V(8); PG8_WAIT_L(0); PG8_BAR; PG8_MMA(0, 0, At, B0); PG8_MMA(0, 1, At, B1); PG8_BAR; PG8_SCHED;
            PG8_LDA(At, 1, 1); PG8_STAGE(PG8_SB(1, 0), b3, voffB); PG8_STAGE(PG8_SB(1, 1), b3 + hstep, voffB); PG8_STAGE(PG8_SA(1, 0), a3, voffA);
            PG8_WAIT_V(8); PG8_WAIT_L(0); PG8_BAR; PG8_MMA(1, 0, At, B0); PG8_MMA(1, 1, At, B1); PG8_BAR; PG8_SCHED;
            } else {
            PG8_LDB(B0, 0, 0); PG8_SCHED; PG8_LDA(At, 0, 0); PG8_STAGE(PG8_SA(1, 1), a1 + hstep, voffA);
            PG8_WAIT_L(8); PG8_BAR; PG8_WAIT_L(0); PG8_MMA(0, 0, At, B0); PG8_BAR; PG8_SCHED;
            PG8_LDB(B1, 0, 1); PG8_STAGE(PG8_SB(0, 0), b2, voffB);
            PG8_BAR; PG8_WAIT_L(0); PG8_MMA(0, 1, At, B1); PG8_BAR;
            PG8_LDA(At, 0, 1); PG8_STAGE(PG8_SA(0, 0), a2, voffA);
            PG8_BAR; PG8_WAIT_L(0); PG8_MMA(1, 0, At, B0); PG8_BAR; PG8_SCHED;
            PG8_STAGE(PG8_SB(0, 1), b2 + hstep, voffB);
            PG8_WAIT_V(6); PG8_BAR; PG8_MMA(1, 1, At, B1); PG8_BAR;
            PG8_LDB(B0, 1, 0); PG8_SCHED; PG8_LDA(At, 1, 0); PG8_STAGE(PG8_SA(0, 1), a2 + hstep, voffA);
            PG8_WAIT_L(8); PG8_BAR; PG8_WAIT_L(0); PG8_MMA(0, 0, At, B0); PG8_BAR; PG8_SCHED;
            PG8_LDB(B1, 1, 1); PG8_STAGE(PG8_SB(1, 0), b3, voffB);
            PG8_BAR; PG8_WAIT_L(0); PG8_MMA(0, 1, At, B1); PG8_BAR;
            PG8_LDA(At, 1, 1); PG8_STAGE(PG8_SA(1, 0), a3, voffA);
            PG8_BAR; PG8_WAIT_L(0); PG8_MMA(1, 0, At, B0); PG8_BAR; PG8_SCHED;
            PG8_STAGE(PG8_SB(1, 1), b3 + hstep, voffB);
            PG8_WAIT_V(6); PG8_BAR; PG8_MMA(1, 1, At, B1); PG8_BAR;
            }
        }
        if constexpr (ALIGN_EPI) { if (wr == 0) PG8_BAR; }
        if constexpr (!Epi::AFTER_DRAIN) { E(acc, cur, wr, wc, fr, fq); S.done(cur); }
        if (!has_next) break;
#pragma unroll
        for (int a = 0; a < 2; ++a)
#pragma unroll
            for (int b = 0; b < 2; ++b)
#pragma unroll
                for (int m = 0; m < 4; ++m)
#pragma unroll
                    for (int n = 0; n < 2; ++n) acc[a][b][m][n] = (f32x4){0.f, 0.f, 0.f, 0.f};
        cur = nxt; cA = nA; cB = nB; ++ui;
        if constexpr (ALIGN_EPI) { if (wr == 1) PG8_BAR; }
    }
    PG8_WAIT_V(0);
    if constexpr (!ALIGN_EPI) { if (wr == 0) PG8_BAR; }
    PG8_BAR;
    if constexpr (Epi::AFTER_DRAIN) { E.fused(acc, cur, wr, wc, fr, fq, lds, wid, lane); S.done(cur); }
#undef PG8_SA
#undef PG8_SB
#undef PG8_STAGE
#undef PG8_LDA
#undef PG8_LDB
#undef PG8_MMA
#undef PG8_WAIT_V
#undef PG8_WAIT_L
#undef PG8_BAR
#undef PG8_SCHED
}
}
namespace att {
typedef unsigned short bf16_t;
using bf16x8 = __attribute__((ext_vector_type(8))) short;
using s16x4  = __attribute__((ext_vector_type(4))) short;
using f32x16 = __attribute__((ext_vector_type(16))) float;
using u32x4  = __attribute__((ext_vector_type(4))) unsigned;
constexpr int NW = 8, QBLK = 32, KVBLK = 64;
constexpr int LDQ = 6144, LDO = 4096;
constexpr int SHM_V = KVBLK * 128 * 2, SHM_K = KVBLK * 64 * 2;
constexpr float THR = 8.f;
#define ASBAR() __builtin_amdgcn_sched_barrier(0)
__device__ __forceinline__ int crow(int r, int hi) { return (r & 3) + 8 * (r >> 2) + 4 * hi; }
__device__ __forceinline__ unsigned cvtpk(float lo, float hi) { unsigned r; asm volatile("v_cvt_pk_bf16_f32 %0, %1, %2" : "=v"(r) : "v"(lo), "v"(hi)); return r; }
template <bool FIRST = false> __device__ __forceinline__ void partialSM(f32x16& p0, f32x16& p1, float& m_reg, float& alpha, f32x16& negm) {
  float pmax = p0[0];
#pragma unroll
  for (int r = 1; r < 16; ++r) pmax = fmaxf(pmax, p0[r]);
#pragma unroll
  for (int r = 0; r < 16; ++r) pmax = fmaxf(pmax, p1[r]);
  { auto rr = __builtin_amdgcn_permlane32_swap(__float_as_uint(pmax), __float_as_uint(pmax), false, false);
    pmax = fmaxf(__uint_as_float(rr[0]), __uint_as_float(rr[1])); }
  if (!FIRST && __builtin_expect(__all(pmax <= THR), 1)) { alpha = 1.f; }
  else { const float dl = FIRST ? pmax : fmaxf(pmax, 0.f); m_reg += dl;
#pragma unroll
    for (int r = 0; r < 16; ++r) { p0[r] -= dl; p1[r] -= dl; }
#pragma unroll
    for (int r = 0; r < 16; ++r) negm[r] = -m_reg;
    asm volatile("" : "+v"(negm));
    alpha = __builtin_amdgcn_exp2f(-dl); }
#pragma unroll
  for (int r = 0; r < 16; ++r) p0[r] = __builtin_amdgcn_exp2f(p0[r]);
}
__device__ __forceinline__ void finishSM(f32x16& p0, f32x16& p1, float alpha, float& l_reg, bf16x8& pa0, bf16x8& pa1, bf16x8& pa2, bf16x8& pa3) {
#pragma unroll
  for (int r = 0; r < 16; ++r) p1[r] = __builtin_amdgcn_exp2f(p1[r]);
  float ps = 0;
#pragma unroll
  for (int r = 0; r < 16; ++r) ps += p0[r];
#pragma unroll
  for (int r = 0; r < 16; ++r) ps += p1[r];
  { auto rr = __builtin_amdgcn_permlane32_swap(__float_as_uint(ps), __float_as_uint(ps), false, false);
    ps = __uint_as_float(rr[0]) + __uint_as_float(rr[1]); }
  l_reg = l_reg * alpha + ps;
#define PK4(P, BASE, OUT) do { unsigned a0 = cvtpk(P[BASE + 0], P[BASE + 1]), a1 = cvtpk(P[BASE + 2], P[BASE + 3]);   \
    unsigned b0 = cvtpk(P[BASE + 4], P[BASE + 5]), b1 = cvtpk(P[BASE + 6], P[BASE + 7]);                              \
    auto r0 = __builtin_amdgcn_permlane32_swap(a0, b0, false, false); auto r1 = __builtin_amdgcn_permlane32_swap(a1, b1, false, false); \
    u32x4 w = {r0[0], r1[0], r0[1], r1[1]}; OUT = *reinterpret_cast<bf16x8*>(&w); } while (0)
  PK4(p0, 0, pa0); PK4(p0, 8, pa1); PK4(p1, 0, pa2); PK4(p1, 8, pa3);
#undef PK4
}
__device__ __forceinline__ int k_off(int key, int ch) { return ch * 1024 + (key << 4); }
__device__ __forceinline__ void kload8(bf16x8 (&kf)[8], const char* Ks, int r32, int hi) {
#pragma unroll
  for (int d0 = 0; d0 < 4; ++d0) { const int ch = 2 * d0 + hi;
    kf[2 * d0] = *reinterpret_cast<const bf16x8*>(Ks + k_off(r32, ch)); kf[2 * d0 + 1] = *reinterpret_cast<const bf16x8*>(Ks + k_off(32 + r32, ch)); }
}
__device__ __forceinline__ void qkt(f32x16& p0, f32x16& p1, const bf16x8 (&kf)[8], const bf16x8* qr, const f32x16& negm) {
  p0 = __builtin_amdgcn_mfma_f32_32x32x16_bf16(kf[0], qr[0], negm, 0, 0, 0); p1 = __builtin_amdgcn_mfma_f32_32x32x16_bf16(kf[1], qr[0], negm, 0, 0, 0);
  asm volatile("" :: "v"(kf[0]), "v"(kf[1]));
#pragma unroll
  for (int d0 = 1; d0 < 4; ++d0) { p0 = __builtin_amdgcn_mfma_f32_32x32x16_bf16(kf[2 * d0], qr[d0], p0, 0, 0, 0); p1 = __builtin_amdgcn_mfma_f32_32x32x16_bf16(kf[2 * d0 + 1], qr[d0], p1, 0, 0, 0); }
}
__device__ __forceinline__ int v_st(int k, int c) { const int kk = (k & ~0xC) | ((k & 4) << 1) | ((k & 8) >> 1); return ((kk >> 3) * 4 + (c >> 5)) * 512 + ((kk & 7) * 32 + (c & 31)) * 2; }
__device__ __forceinline__ int v_rd_base(int lane) { return ((lane & 3) << 3) | (((lane >> 2) & 3) << 6) | (((lane >> 4) & 1) << 5) | (((lane >> 5) & 1) << 8); }
constexpr int v_rd_off(int d0, int ks, int half) { return d0 * 512 + ks * 4096 + half * 2048; }
template <int OFF> __device__ __forceinline__ s16x4 tr_read(int vb) {
  s16x4 r; asm volatile("ds_read_b64_tr_b16 %0, %1 offset:%2" : "=&v"(r) : "v"(vb), "i"(OFF) : "memory"); return r;
}
template <int D0> __device__ __forceinline__ void pv_one(f32x16& od, int vb, bf16x8 pa0, bf16x8 pa1, bf16x8 pa2, bf16x8 pa3) {
  const s16x4 l0 = tr_read<v_rd_off(D0, 0, 0)>(vb), h0 = tr_read<v_rd_off(D0, 0, 1)>(vb), l1 = tr_read<v_rd_off(D0, 1, 0)>(vb), h1 = tr_read<v_rd_off(D0, 1, 1)>(vb);
  const s16x4 l2 = tr_read<v_rd_off(D0, 2, 0)>(vb), h2 = tr_read<v_rd_off(D0, 2, 1)>(vb), l3 = tr_read<v_rd_off(D0, 3, 0)>(vb), h3 = tr_read<v_rd_off(D0, 3, 1)>(vb);
  asm volatile("s_waitcnt lgkmcnt(0)" ::: "memory"); ASBAR();
#define PK(L, H) (bf16x8){L[0], L[1], L[2], L[3], H[0], H[1], H[2], H[3]}
  od = __builtin_amdgcn_mfma_f32_32x32x16_bf16(PK(l0, h0), pa0, od, 0, 0, 0);
  od = __builtin_amdgcn_mfma_f32_32x32x16_bf16(PK(l1, h1), pa1, od, 0, 0, 0);
  od = __builtin_amdgcn_mfma_f32_32x32x16_bf16(PK(l2, h2), pa2, od, 0, 0, 0);
  od = __builtin_amdgcn_mfma_f32_32x32x16_bf16(PK(l3, h3), pa3, od, 0, 0, 0);
#undef PK
}
__device__ __forceinline__ void pv_d0(f32x16* o, int vb, bf16x8 pa0, bf16x8 pa1, bf16x8 pa2, bf16x8 pa3) {
  pv_one<0>(o[0], vb, pa0, pa1, pa2, pa3); pv_one<1>(o[1], vb, pa0, pa1, pa2, pa3); pv_one<2>(o[2], vb, pa0, pa1, pa2, pa3); pv_one<3>(o[3], vb, pa0, pa1, pa2, pa3);
}
constexpr int NSLOT = 3, LDS_KR = 0, LDS_VR = NSLOT * SHM_K, LDS_WS = LDS_VR + NSLOT * SHM_V;
constexpr int SHM_ATTN = LDS_WS + NW * 64 * 4;
#define AT_LAS __attribute__((address_space(3)))
__device__ __forceinline__ void attn_unit(const bf16_t* __restrict__ QKV, bf16_t* __restrict__ OC, int qrow0, int qcol, int kcol, int vcol, int ocol,
                                          int lat0, int nlat, int ctx0, int NT, char* lds, int tid) {
  const int wid = __builtin_amdgcn_readfirstlane(tid >> 6), lane = tid & 63, r32 = lane & 31, hi = lane >> 5;
  char* K_lds = lds + LDS_KR; char* V_lds = lds + LDS_VR;
  float m_reg = 0.f, l_reg = 0; f32x16 o[4] = {}; f32x16 negm = {}; asm volatile("" : "+v"(negm)); bf16x8 qr[4];
  const unsigned voffK = (unsigned)(lane * LDQ + wid * 8) * 2u;
  unsigned voffV[2];
#pragma unroll
  for (int i = 0; i < 2; ++i) { const int p = 2 * wid + i, s = 2 * p + (lane >> 5), kk = (s >> 2) * 8 + ((lane & 31) >> 2), c = (s & 3) * 32 + (lane & 3) * 8;
    const int k = (kk & ~0xC) | ((kk & 4) << 1) | ((kk & 8) >> 1); voffV[i] = (unsigned)(k * LDQ + c) * 2u; }
#define TROW(j) ((j) < nlat ? lat0 + 64 * (j) : ctx0 + 64 * ((j) - nlat))
#define DMA_K(j) do { const char* tb_ = (const char*)QKV + (size_t)TROW(j) * (LDQ * 2) + kcol * 2; \
    __builtin_amdgcn_global_load_lds((const unsigned*)(tb_ + voffK), (AT_LAS unsigned*)(K_lds + ((j) % NSLOT) * SHM_K + wid * 1024), 16, 0, 0); } while (0)
#define DMA_V(j) do { const char* tb_ = (const char*)QKV + (size_t)TROW(j) * (LDQ * 2) + vcol * 2; \
    __builtin_amdgcn_global_load_lds((const unsigned*)(tb_ + voffV[0]), (AT_LAS unsigned*)(V_lds + ((j) % NSLOT) * SHM_V + (2 * wid) * 1024), 16, 0, 0); \
    __builtin_amdgcn_global_load_lds((const unsigned*)(tb_ + voffV[1]), (AT_LAS unsigned*)(V_lds + ((j) % NSLOT) * SHM_V + (2 * wid + 1) * 1024), 16, 0, 0); } while (0)
#define WAITBAR(N) asm volatile("s_waitcnt vmcnt(" #N ") lgkmcnt(0)\n\ts_barrier" ::: "memory")
#define RESC(a) do { if (__any((a) < 1.f)) { _Pragma("unroll") for (int d = 0; d < 4; ++d) _Pragma("unroll") for (int r = 0; r < 16; ++r) o[d][r] *= (a); } } while (0)
  DMA_K(0); DMA_V(0); DMA_K(1);
  const bf16_t* Qw = QKV + (size_t)(qrow0 + wid * QBLK + r32) * LDQ + qcol + hi * 8;
#pragma unroll
  for (int d0 = 0; d0 < 4; ++d0) qr[d0] = *reinterpret_cast<const bf16x8*>(Qw + d0 * 16);
  const int vb0 = (int)(uintptr_t)V_lds + v_rd_base(lane);
  f32x16 pA0, pA1, pB0, pB1; float alA, alB; bf16x8 pa0, pa1, pa2, pa3;
#define BAR_A(j) do { if ((j) + 2 < NT) { WAITBAR(3); DMA_K((j) + 2); } else { WAITBAR(0); } } while (0)
#define BAR_B(j) do { if ((j) + 2 < NT) { WAITBAR(3); } else { WAITBAR(0); } if ((j) + 1 < NT) DMA_V((j) + 1); } while (0)
  asm volatile("s_waitcnt vmcnt(0)" ::: "memory");
  if (wid >= 4) asm volatile("s_barrier" ::: "memory");
  WAITBAR(0); DMA_K(2);
  bf16x8 kf[8]; kload8(kf, K_lds, r32, hi); ASBAR(); qkt(pA0, pA1, kf, qr, negm); ASBAR();
  BAR_B(0);
  partialSM<true>(pA0, pA1, m_reg, alA, negm);
  int sk = 1, sv = 0;
#define ROT() do { sk = (sk == NSLOT - 1) ? 0 : sk + 1; sv = (sv == NSLOT - 1) ? 0 : sv + 1; } while (0)
  for (int j = 1; j + 1 < NT; j += 2) {
    BAR_A(j);
    kload8(kf, K_lds + sk * SHM_K, r32, hi); ASBAR(); qkt(pB0, pB1, kf, qr, negm);
    finishSM(pA0, pA1, alA, l_reg, pa0, pa1, pa2, pa3); ASBAR();
    BAR_B(j);
    pv_d0(o, vb0 + sv * SHM_V, pa0, pa1, pa2, pa3); partialSM(pB0, pB1, m_reg, alB, negm);
    RESC(alB); ROT();
    BAR_A(j + 1);
    kload8(kf, K_lds + sk * SHM_K, r32, hi); ASBAR(); qkt(pA0, pA1, kf, qr, negm);
    finishSM(pB0, pB1, alB, l_reg, pa0, pa1, pa2, pa3); ASBAR();
    BAR_B(j + 1);
    pv_d0(o, vb0 + sv * SHM_V, pa0, pa1, pa2, pa3); partialSM(pA0, pA1, m_reg, alA, negm);
    RESC(alA); ROT();
  }
  BAR_A(NT - 1);
  kload8(kf, K_lds + sk * SHM_K, r32, hi); ASBAR(); qkt(pB0, pB1, kf, qr, negm);
  finishSM(pA0, pA1, alA, l_reg, pa0, pa1, pa2, pa3); ASBAR();
  BAR_B(NT - 1);
  pv_d0(o, vb0 + sv * SHM_V, pa0, pa1, pa2, pa3); partialSM(pB0, pB1, m_reg, alB, negm);
  RESC(alB); ROT();
  finishSM(pB0, pB1, alB, l_reg, pa0, pa1, pa2, pa3); ASBAR();
  pv_d0(o, vb0 + sv * SHM_V, pa0, pa1, pa2, pa3);
  if (wid < 4) asm volatile("s_barrier" ::: "memory");
#undef BAR_A
#undef BAR_B
  const float rl = __builtin_amdgcn_rcpf(l_reg);
  bf16_t* Ow = OC + (size_t)(qrow0 + wid * QBLK + r32) * LDO + ocol + 8 * hi;
#pragma unroll
  for (int d0 = 0; d0 < 4; ++d0)
#pragma unroll
    for (int t = 0; t < 2; ++t) {
      const unsigned x0 = cvtpk(o[d0][8 * t + 0] * rl, o[d0][8 * t + 1] * rl), x1 = cvtpk(o[d0][8 * t + 2] * rl, o[d0][8 * t + 3] * rl);
      const unsigned y0 = cvtpk(o[d0][8 * t + 4] * rl, o[d0][8 * t + 5] * rl), y1 = cvtpk(o[d0][8 * t + 6] * rl, o[d0][8 * t + 7] * rl);
      auto s0 = __builtin_amdgcn_permlane32_swap(x0, y0, false, false); auto s1 = __builtin_amdgcn_permlane32_swap(x1, y1, false, false);
      u32x4 w = {s0[0], s1[0], s0[1], s1[1]};
      *reinterpret_cast<u32x4*>(Ow + d0 * 32 + 16 * t) = w; }
  WAITBAR(0);
#undef TROW
#undef DMA_K
#undef DMA_V
#undef WAITBAR
#undef ROT
#undef RESC
}
#undef ASBAR
}

constexpr int DM = 2048, BATCH = 2, SEQ = 8192, DEPTH = 4, CTXL = 256, FF = 5632;
constexpr int TLAT = BATCH * SEQ, TCTX = BATCH * CTXL, TT = TLAT + TCTX;
constexpr int NMOD = 9, MODW = NMOD * DM;
constexpr int S5W = 1024, S5H = 16, S5G = 64, S5P = 64, MIXIN = 4096, MIXOUT = 2048;
constexpr int NTC = (SEQ + CTXL) / 64;
constexpr float EPS = 1e-6f;
#ifndef NSUB
#define NSUB 12
#endif
#ifndef ONE_LAUNCH
#define ONE_LAUNCH 1
#endif

constexpr size_t MiB = 1u << 20;
constexpr size_t al(size_t x) { return (x + MiB - 1) / MiB * MiB; }
constexpr size_t WS_CTL = 0, CTL_ZERO_BYTES = 1 * MiB;
constexpr size_t WS_MOD   = WS_CTL + CTL_ZERO_BYTES;
constexpr size_t WS_ROPE  = WS_MOD + al((size_t)DEPTH * 3 * MODW * 4);
constexpr size_t WS_MODP  = WS_ROPE + MiB;
constexpr int    ADA_KC = 32;
constexpr size_t WS_SE    = WS_MODP + al((size_t)DEPTH * ADA_KC * 3 * MODW * 4);
constexpr size_t SCAN_BYTES = (size_t)BATCH * 2 * S5G * NTC * S5P * 8;
constexpr size_t WS_SC    = WS_SE + al(SCAN_BYTES);
constexpr size_t WS_WGU   = WS_SC + al(SCAN_BYTES);
constexpr size_t WGU_ONE  = (size_t)2 * FF * DM * 2;
constexpr size_t WS_WD    = WS_WGU + al(8 * WGU_ONE);
constexpr size_t WD_ONE   = (size_t)DM * FF * 2;
constexpr size_t WS_WIN   = WS_WD + al(8 * WD_ONE);
constexpr size_t WS_WOUT  = WS_WIN + al((size_t)2 * MIXIN * DM * 2);
constexpr size_t WS_WGLU  = WS_WOUT + al((size_t)2 * DM * MIXOUT * 2);
constexpr size_t WS_WQKV  = WS_WGLU + al((size_t)2 * S5W * S5W * 2);
constexpr size_t WS_WO    = WS_WQKV + al((size_t)2 * 3 * DM * DM * 2);
constexpr size_t WS_X     = WS_WO + al((size_t)2 * DM * DM * 2);
constexpr size_t WS_H     = WS_X + al((size_t)TT * DM * 4);
constexpr size_t WS_Y     = WS_H + al((size_t)TT * DM * 2);
constexpr size_t WS_BIG   = WS_Y + al((size_t)TT * DM * 2);
constexpr size_t WS_Z     = WS_BIG + al((size_t)TT * 6144 * 2);
constexpr size_t WS_MIXA  = WS_Z + al((size_t)TT * S5W * 2);
constexpr size_t WS_OC    = WS_MIXA + al((size_t)TT * DM * 2);
constexpr size_t WS_PART  = WS_OC + al((size_t)TT * 4096 * 2);
constexpr int    NZ_DOWN = 4, NZ_OUT = 4;
constexpr size_t WS_END   = WS_PART + al((size_t)11 * TCTX * DM * 4);

constexpr int CW_BAR = 4096;
constexpr int CW_HOST = 16384;

constexpr int SCRATCH_BYTES = 143360;
constexpr int LDSCTL_OFF = SCRATCH_BYTES, MISC_OFF = LDSCTL_OFF + 320;
constexpr int LDS_BYTES = 147456;
static_assert(pg8::STAGE_BYTES <= SCRATCH_BYTES && att::SHM_ATTN <= SCRATCH_BYTES && MISC_OFF + 128 <= LDS_BYTES, "LDS map");

#define GAS __attribute__((address_space(1)))
#define LAS __attribute__((address_space(3)))
typedef unsigned short bf16;
typedef unsigned v4u __attribute__((ext_vector_type(4)));
typedef float f32x4 __attribute__((ext_vector_type(4)));
typedef float f32x16 __attribute__((ext_vector_type(16)));
typedef short bf16x8 __attribute__((ext_vector_type(8)));
#define LDS_WAIT() asm volatile("s_waitcnt lgkmcnt(0)" ::: "memory")
#define VM_WAIT() asm volatile("s_waitcnt vmcnt(0)" ::: "memory")
__device__ __forceinline__ unsigned pk2(float lo, float hi) { unsigned r; asm volatile("v_cvt_pk_bf16_f32 %0, %1, %2" : "=v"(r) : "v"(lo), "v"(hi)); return r; }
typedef _Float16 h16x2 __attribute__((ext_vector_type(2)));
__device__ __forceinline__ unsigned pkh2(float lo, float hi) { const float L = 65504.f; h16x2 v = {(_Float16)__builtin_fminf(__builtin_fmaxf(lo, -L), L), (_Float16)__builtin_fminf(__builtin_fmaxf(hi, -L), L)}; return __builtin_bit_cast(unsigned, v); }
__device__ __forceinline__ float hlo(unsigned w) { return (float)__builtin_bit_cast(h16x2, w)[0]; }
__device__ __forceinline__ float hhi(unsigned w) { return (float)__builtin_bit_cast(h16x2, w)[1]; }
__device__ __forceinline__ float bflo(unsigned w) { return __uint_as_float(w << 16); }
__device__ __forceinline__ float bfhi(unsigned w) { return __uint_as_float(w & 0xffff0000u); }
__device__ __forceinline__ float wave_sum(float v) {
#pragma unroll
    for (int o = 1; o < 64; o <<= 1) v += __shfl_xor(v, o);
    return v;
}
#define XB_TMO      128
#define XB_XCNT(j)  (256  + 64 * (j))
#define XB_XSUB(j)  (1280 + 64 * (j))
#define XB_XGEN(j)  (2304 + 64 * (j))
#define XB_TOP      3328
#define XB_TOPGEN   3392
#define XCD_BAR_WORDS 3456
#define XB_SPIN_CAP (1u << 18)

__device__ __forceinline__ unsigned xb_ld(unsigned* p)              { return __hip_atomic_load(p, __ATOMIC_RELAXED, __HIP_MEMORY_SCOPE_AGENT); }
__device__ __forceinline__ unsigned xb_add(unsigned* p, unsigned v) { return __hip_atomic_fetch_add(p, v, __ATOMIC_RELAXED, __HIP_MEMORY_SCOPE_AGENT); }
__device__ __forceinline__ unsigned xb_xcc_id() { return (unsigned)__builtin_amdgcn_s_getreg((3 << 11) | 20) & 0xFu; }
#define XB_SPIN(cond, bar) do { unsigned _sp = 0; while (cond) { __builtin_amdgcn_s_sleep(1); \
    if ((++_sp & 255u) == 0u) { if (xb_ld(&(bar)[XB_TMO])) break; if (_sp > XB_SPIN_CAP) { atomicAdd(&(bar)[XB_TMO], 1u); break; } } } } while (0)

struct XcdBarrier {
    unsigned* bar; unsigned x;
    volatile LAS unsigned* st;
};

__device__ __forceinline__ XcdBarrier xcd_barrier_post(unsigned* bar, volatile LAS unsigned* st) {
    XcdBarrier b; b.bar = bar; b.x = xb_xcc_id(); b.st = st;
    if (threadIdx.x == 0) (void)xb_add(&bar[XB_XCNT(b.x)], 1u);
    return b;
}
__device__ __forceinline__ void xcd_barrier_complete(unsigned* bar, unsigned x, unsigned& nloc, unsigned& nx) {
    const unsigned G = gridDim.x * gridDim.y * gridDim.z;
    unsigned sum, cnt, mine, sp = 0u;
    for (;;) {
        sum = 0u; cnt = 0u; mine = 0u;
#pragma unroll
        for (unsigned j = 0; j < 16; ++j) { const unsigned c = xb_ld(&bar[XB_XCNT(j)]); sum += c; cnt += (c > 0u) ? 1u : 0u; mine = (j == x) ? c : mine; }
        if (sum == G) break;
        __builtin_amdgcn_s_sleep(1);
        if ((++sp & 255u) == 0u) { if (xb_ld(&bar[XB_TMO])) break; if (sp > XB_SPIN_CAP) { atomicAdd(&bar[XB_TMO], 1u); break; } }
    }
    nloc = mine > 0u ? mine : 1u; nx = cnt > 0u ? cnt : 1u;
}

__device__ __forceinline__ void xcd_barrier(const XcdBarrier& b) {
    asm volatile("s_waitcnt vmcnt(0)" ::: "memory");
    __syncthreads();
    if (threadIdx.x == 0) {
        unsigned* bar = b.bar;
        __builtin_amdgcn_s_waitcnt(0);
        unsigned nloc = b.st[0], nx = b.st[1];
        if (nloc == 0u) { xcd_barrier_complete(bar, b.x, nloc, nx); b.st[0] = nloc; b.st[1] = nx; }
        const unsigned old = xb_add(&bar[XB_XSUB(b.x)], 1u);
        const unsigned gen = old / nloc;
        if (old + 1u == (gen + 1u) * nloc) {
            __builtin_amdgcn_fence(__ATOMIC_RELEASE, "agent");
            asm volatile("s_waitcnt vmcnt(0)" ::: "memory");
            const unsigned og = xb_add(&bar[XB_TOP], 1u);
            const unsigned tg = og / nx;
            if (og + 1u == (tg + 1u) * nx) xb_add(&bar[XB_TOPGEN], 1u);
            else XB_SPIN(xb_ld(&bar[XB_TOPGEN]) == tg, bar);
            __builtin_amdgcn_fence(__ATOMIC_ACQUIRE, "agent");
            xb_add(&bar[XB_XGEN(b.x)], 1u);
            asm volatile("s_waitcnt vmcnt(0)" ::: "memory");
        } else {
            XB_SPIN(xb_ld(&bar[XB_XGEN(b.x)]) == gen, bar);
            __builtin_amdgcn_fence(__ATOMIC_ACQUIRE, "agent");
            asm volatile("s_waitcnt vmcnt(0)" ::: "memory");
        }
    }
    __syncthreads();
}
constexpr int NWAVES = 8;
struct Args { const float* in[28]; float* out; unsigned char* ws; int ph_lo, ph_hi; };
struct Frame {
    const Args& A;
    LAS unsigned char* lds;
    int tid, lane, wave, vcu, G;
    float* out; unsigned char* ws;
};
#define WSP(T, off) ((T*)(F.ws + (off)))

template <int MAP> __device__ __forceinline__ int rowmap(int n) {
    if (MAP == 1) return ((n >> 7) << 8) + (n & 127);
    if (MAP == 2) return ((n >> 7) << 8) + 128 + (n & 127);
    if (MAP == 3) { if (n >= 4096) return n; const int i = n & 255, beta = i >> 6, d = i & 63; return (n & ~255) + (d < 32 ? 32 * beta + d : 128 + 32 * beta + (d - 32)); }
    return n;
}
template <int MAP> __device__ __forceinline__ void transpose_item(const float* W, int K, int N, bf16* WT, LAS float* scr, int item, int lane) {
    const int nblk = N / 32, kb = item / nblk, nb = item % nblk, k0 = 64 * kb, n0 = 32 * nb;
#pragma unroll 8
    for (int i = 0; i < 32; ++i) { const int kk = 2 * i + (lane >> 5); scr[kk * 33 + (lane & 31)] = W[(size_t)(k0 + kk) * N + n0 + (lane & 31)]; }
    LDS_WAIT(); asm volatile("" ::: "memory");
    const int c = lane & 7;
#pragma unroll
    for (int j = 0; j < 4; ++j) { const int n = (lane >> 3) + 8 * j; const LAS float* s = scr + (8 * c) * 33 + n;
        v4u o; o.x = pk2(s[0 * 33], s[1 * 33]); o.y = pk2(s[2 * 33], s[3 * 33]); o.z = pk2(s[4 * 33], s[5 * 33]); o.w = pk2(s[6 * 33], s[7 * 33]);
        *(GAS v4u*)(WT + (size_t)rowmap<MAP>(n0 + n) * K + k0 + 8 * c) = o; }
    LDS_WAIT(); asm volatile("" ::: "memory");
}
__device__ __forceinline__ float silu_f(float v) { return v / (1.0f + __expf(-v)); }

__device__ __forceinline__ void p0_prologue(Frame& F) {
    const int gw = F.vcu * NWAVES + F.wave, NGW = F.G * NWAVES;
    LAS float* sv = (LAS float*)(F.lds + 8 * 8704);
    for (int i = F.tid; i < 3 * DM; i += NWAVES * 64) { const int v = i / DM, k = i % DM; sv[i] = silu_f(v < 2 ? F.A.in[1][v * DM + k] : F.A.in[3][k]); }
    { const int gt = (F.vcu * NWAVES * 64) + F.tid; if (gt < 128 * 16) { const int pos = gt >> 4, j = gt & 15; const float fr = powf(10000.0f, -(float)j / 16.0f); const float ang = (float)pos * fr;
            float* cs = WSP(float, WS_ROPE); cs[2 * gt] = cosf(ang); cs[2 * gt + 1] = sinf(ang); } }
    __syncthreads();
    { float* part = WSP(float, WS_MODP);
      constexpr int NCB = MODW / 256, NU = DEPTH * ADA_KC * NCB;
      for (int u = gw; u < NU; u += NGW) { const int cb = u % NCB, kc = (u / NCB) % ADA_KC, l = u / (NCB * ADA_KC);
          const float* W = F.A.in[4] + ((size_t)l * DM + kc * 64) * MODW + cb * 256 + F.lane * 4;
          f32x4 a0 = {0, 0, 0, 0}, a1 = a0, a2 = a0;
#pragma unroll 8
          for (int k = 0; k < 64; ++k) { const f32x4 w = *(const f32x4*)(W + (size_t)k * MODW); const int kk = kc * 64 + k;
              a0 += w * sv[kk]; a1 += w * sv[DM + kk]; a2 += w * sv[2 * DM + kk]; }
          float* o = part + ((size_t)(l * ADA_KC + kc) * 3) * MODW + cb * 256 + F.lane * 4;
          *(f32x4*)o = a0; *(f32x4*)(o + MODW) = a1; *(f32x4*)(o + 2 * MODW) = a2; } }
    LAS float* scr = (LAS float*)(F.lds + F.wave * 8704);
    constexpr int I_FF = (DM / 64) * (FF / 32);
    constexpr int I_IN = (DM / 64) * (MIXIN / 32), I_OUT = (MIXOUT / 64) * (DM / 32), I_GLU = (S5W / 64) * (S5W / 32), I_QKV = (DM / 64) * (3 * DM / 32), I_O = (DM / 64) * (DM / 32);
    constexpr int N_FFN = 24 * I_FF, N_EV = I_IN + I_OUT + I_GLU, N_OD = I_QKV + I_O, NITEMS = N_FFN + 2 * N_EV + 2 * N_OD;
    for (int it = gw; it < NITEMS; it += NGW) {
        int r = it;
        if (r < N_FFN) { const int q = r / I_FF, item = r % I_FF, lh = q / 3, kind = q % 3;
            if (kind == 0) transpose_item<1>(F.A.in[7] + (size_t)lh * DM * FF, DM, FF, WSP(bf16, WS_WGU + lh * WGU_ONE), scr, item, F.lane);
            else if (kind == 1) transpose_item<2>(F.A.in[8] + (size_t)lh * DM * FF, DM, FF, WSP(bf16, WS_WGU + lh * WGU_ONE), scr, item, F.lane);
            else transpose_item<0>(F.A.in[9] + (size_t)lh * FF * DM, FF, DM, WSP(bf16, WS_WD + lh * WD_ONE), scr, item, F.lane);
            continue; }
        r -= N_FFN;
        if (r < 2 * N_EV) { const int i = r / N_EV; r %= N_EV;
            if (r < I_IN) { transpose_item<0>(F.A.in[10] + (size_t)i * DM * MIXIN, DM, MIXIN, WSP(bf16, WS_WIN + (size_t)i * MIXIN * DM * 2), scr, r, F.lane); continue; } r -= I_IN;
            if (r < I_OUT) { transpose_item<0>(F.A.in[11] + (size_t)i * MIXOUT * DM, MIXOUT, DM, WSP(bf16, WS_WOUT + (size_t)i * DM * MIXOUT * 2), scr, r, F.lane); continue; } r -= I_OUT;
            transpose_item<0>(F.A.in[20] + (size_t)i * S5W * S5W, S5W, S5W, WSP(bf16, WS_WGLU + (size_t)i * S5W * S5W * 2), scr, r, F.lane); continue; }
        r -= 2 * N_EV;
        { const int i = r / N_OD; r %= N_OD;
            if (r < I_QKV) { transpose_item<3>(F.A.in[24] + (size_t)i * DM * 3 * DM, DM, 3 * DM, WSP(bf16, WS_WQKV + (size_t)i * 3 * DM * DM * 2), scr, r, F.lane); continue; } r -= I_QKV;
            transpose_item<0>(F.A.in[25] + (size_t)i * DM * DM, DM, DM, WSP(bf16, WS_WO + (size_t)i * DM * DM * 2), scr, r, F.lane); }
    }
}
__device__ __forceinline__ void p1_ada_reduce(Frame& F) {
    const float* part = WSP(float, WS_MODP); float* mod = WSP(float, WS_MOD);
    const int gt = F.vcu * NWAVES * 64 + F.tid, NGT = F.G * NWAVES * 64;
    for (int i = gt; i < DEPTH * 3 * MODW; i += NGT) { const int n = i % MODW, v = (i / MODW) % 3, l = i / (3 * MODW);
        float s = F.A.in[5][l * MODW + n];
#pragma unroll 8
        for (int kc = 0; kc < ADA_KC; ++kc) s += part[((size_t)(l * ADA_KC + kc) * 3 + v) * MODW + n];
        mod[i] = s; }
}

__device__ __forceinline__ void host_arrive(unsigned* cnt) {
    VM_WAIT(); __syncthreads();
    if (threadIdx.x == 0) { __builtin_amdgcn_fence(__ATOMIC_RELEASE, "agent"); VM_WAIT(); (void)__hip_atomic_fetch_add(cnt, 1u, __ATOMIC_RELAXED, __HIP_MEMORY_SCOPE_AGENT); }
}
__device__ __forceinline__ void host_wait(unsigned* cnt, unsigned want) {
    if (threadIdx.x == 0) { unsigned sp = 0; while (__hip_atomic_load(cnt, __ATOMIC_RELAXED, __HIP_MEMORY_SCOPE_AGENT) < want) { __builtin_amdgcn_s_sleep(4); if (++sp > (1u << 22)) break; }
        __builtin_amdgcn_fence(__ATOMIC_ACQUIRE, "agent"); VM_WAIT(); }
    __syncthreads();
}
__device__ __forceinline__ void resid_norm_phase(Frame& F, int sub, int nctx = TCTX, bool dry = false) {
    LAS float* vA = (LAS float*)F.lds; LAS float* vB = vA + 3 * DM; LAS float* vC = vB + 3 * DM;
    const float* mod = WSP(float, WS_MOD);
    const bool has_y = sub >= 0, from_input = sub <= 0, last = (sub == NSUB - 1), write_h = !last;
    const int nsub = sub + 1, nl = nsub / 3, ns = nsub % 3;
    for (int i = F.tid; i < 3 * DM; i += NWAVES * 64) { const int v = i / DM, c = i % DM;
        if (has_y) { const int l = sub / 3, s = sub % 3; const float wgt = (s == 1) ? 1.0f : 0.5f;
            vA[i] = wgt * mod[((size_t)(l * 3 + v) * NMOD + 3 * s + 2) * DM + c] * F.A.in[6][((size_t)l * 6 + 2 * s + 1) * DM + c]; }
        if (write_h) { vB[i] = F.A.in[6][((size_t)nl * 6 + 2 * ns) * DM + c] * (1.0f + mod[((size_t)(nl * 3 + v) * NMOD + 3 * ns + 1) * DM + c]);
            vC[i] = mod[((size_t)(nl * 3 + v) * NMOD + 3 * ns) * DM + c]; } }
    __syncthreads();
    const bf16* Y = WSP(bf16, WS_Y); const bf16* X = WSP(bf16, WS_X); bf16* Xd = dry ? WSP(bf16, WS_OC) : WSP(bf16, WS_X); bf16* H = dry ? WSP(bf16, WS_MIXA) : WSP(bf16, WS_H); float* outd = dry ? WSP(float, WS_OC) : F.out;
    const int lp = (TLAT + F.G - 1) / F.G, cp = (TCTX + F.G - 1) / F.G;
    const int l0 = blockIdx.x * lp, l1 = (l0 + lp < TLAT) ? l0 + lp : TLAT, nl_ = l1 > l0 ? l1 - l0 : 0;
    const int c0 = blockIdx.x * cp, c1 = (c0 + cp < nctx) ? c0 + cp : nctx, nc_ = c1 > c0 ? c1 - c0 : 0;
    for (int j = F.wave; j < nl_ + nc_; j += NWAVES) {
        const int row = j < nl_ ? l0 + j : TLAT + c0 + (j - nl_);
        const int v = row < SEQ ? 0 : (row < TLAT ? 1 : 2);
        f32x4 xv[4][2];
        if (from_input) {
            const float* xs = row < TLAT ? F.A.in[0] + (size_t)row * DM : F.A.in[2] + (size_t)(row - TLAT) * DM;
#pragma unroll
            for (int i = 0; i < 4; ++i) { const f32x4* p = (const f32x4*)(xs + i * 512 + F.lane * 8); xv[i][0] = p[0]; xv[i][1] = p[1]; }
        } else {
            v4u xw[4];
#pragma unroll
            for (int i = 0; i < 4; ++i) xw[i] = *(const v4u*)(X + (size_t)row * DM + i * 512 + F.lane * 8);
#pragma unroll
            for (int i = 0; i < 4; ++i) { xv[i][0] = (f32x4){hlo(xw[i].x), hhi(xw[i].x), hlo(xw[i].y), hhi(xw[i].y)}; xv[i][1] = (f32x4){hlo(xw[i].z), hhi(xw[i].z), hlo(xw[i].w), hhi(xw[i].w)}; }
        }
        if (has_y) {
            float ss = 0.f; f32x4 yv[4][2];
            if (row < TLAT) {
                v4u yw[4];
#pragma unroll
                for (int i = 0; i < 4; ++i) yw[i] = *(const v4u*)(Y + (size_t)row * DM + i * 512 + F.lane * 8);
#pragma unroll
                for (int i = 0; i < 4; ++i) { yv[i][0] = (f32x4){bflo(yw[i].x), bfhi(yw[i].x), bflo(yw[i].y), bfhi(yw[i].y)}; yv[i][1] = (f32x4){bflo(yw[i].z), bfhi(yw[i].z), bflo(yw[i].w), bfhi(yw[i].w)}; }
            } else {
                const int nz = (sub % 3 == 1) ? NZ_OUT : NZ_DOWN; const float* pp = WSP(const float, WS_PART) + (size_t)(row - TLAT) * DM + F.lane * 8;
#pragma unroll
                for (int i = 0; i < 4; ++i) { yv[i][0] = (f32x4){0.f, 0.f, 0.f, 0.f}; yv[i][1] = yv[i][0]; }
#pragma unroll 4
                for (int z = 0; z < nz; ++z) { const float* pz = pp + (size_t)z * TCTX * DM;
#pragma unroll
                    for (int i = 0; i < 4; ++i) { yv[i][0] += *(const f32x4*)(pz + i * 512); yv[i][1] += *(const f32x4*)(pz + i * 512 + 4); } }
            }
#pragma unroll
            for (int i = 0; i < 4; ++i)
#pragma unroll
                for (int h = 0; h < 2; ++h) ss += (yv[i][h][0] * yv[i][h][0] + yv[i][h][1] * yv[i][h][1]) + (yv[i][h][2] * yv[i][h][2] + yv[i][h][3] * yv[i][h][3]);
            const float r = rsqrtf(wave_sum(ss) * (1.0f / DM) + EPS);
#pragma unroll
            for (int i = 0; i < 4; ++i)
#pragma unroll
                for (int h = 0; h < 2; ++h) { const f32x4 a = *(const LAS f32x4*)(vA + v * DM + i * 512 + F.lane * 8 + 4 * h); xv[i][h] += a * (yv[i][h] * r); }
            if (!last) {
#pragma unroll
                for (int i = 0; i < 4; ++i) { v4u w; w.x = pkh2(xv[i][0][0], xv[i][0][1]); w.y = pkh2(xv[i][0][2], xv[i][0][3]); w.z = pkh2(xv[i][1][0], xv[i][1][1]); w.w = pkh2(xv[i][1][2], xv[i][1][3]);
                    *(v4u*)(Xd + (size_t)row * DM + i * 512 + F.lane * 8) = w; }
            } else if (row < TLAT) {
#pragma unroll
                for (int i = 0; i < 4; ++i) { f32x4* p = (f32x4*)(outd + (size_t)row * DM + i * 512 + F.lane * 8); p[0] = xv[i][0]; p[1] = xv[i][1]; }
            }
        }
        if (write_h) {
            float ss = 0.f;
#pragma unroll
            for (int i = 0; i < 4; ++i)
#pragma unroll
                for (int h = 0; h < 2; ++h) ss += (xv[i][h][0] * xv[i][h][0] + xv[i][h][1] * xv[i][h][1]) + (xv[i][h][2] * xv[i][h][2] + xv[i][h][3] * xv[i][h][3]);
            const float r = rsqrtf(wave_sum(ss) * (1.0f / DM) + EPS);
#pragma unroll
            for (int i = 0; i < 4; ++i) { f32x4 o[2];
#pragma unroll
                for (int h = 0; h < 2; ++h) { const f32x4 b = *(const LAS f32x4*)(vB + v * DM + i * 512 + F.lane * 8 + 4 * h), c = *(const LAS f32x4*)(vC + v * DM + i * 512 + F.lane * 8 + 4 * h); o[h] = (xv[i][h] * r) * b + c; }
                v4u w; w.x = pk2(o[0][0], o[0][1]); w.y = pk2(o[0][2], o[0][3]); w.z = pk2(o[1][0], o[1][1]); w.w = pk2(o[1][2], o[1][3]);
                *(v4u*)(H + (size_t)row * DM + i * 512 + F.lane * 8) = w; }
        }
    }
}

namespace s5 {
struct Par { float a_re, a_im; bf16x8 Bre1, Bim1, Bre2, Bim2; };
__device__ __forceinline__ void discretize(float lre, float lim, float dt, float& a_re, float& a_im, float& co_re, float& co_im) {
    const float mag = expf(lre * dt); float sn, cn; sincosf(lim * dt, &sn, &cn);
    a_re = mag * cn; a_im = mag * sn;
    const float inv = 1.0f / (lre * lre + lim * lim);
    co_re = ((a_re - 1.0f) * lre + a_im * lim) * inv; co_im = (a_im * lre - (a_re - 1.0f) * lim) * inv;
}
__device__ __forceinline__ void load_par(const Args& in, int ei, int dir, int g, int lane, Par& P) {
    const int base = (ei * 2 + dir) * S5G + g; const float dt = expf(in.in[14][base]);
    const int r32 = lane & 31, hi = lane >> 5;
    { float cr, ci; discretize(in.in[12][base * S5P + lane], in.in[13][base * S5P + lane], dt, P.a_re, P.a_im, cr, ci); }
#pragma unroll
    for (int q = 0; q < 2; ++q) { const int p = q * 32 + r32; float ar, ai, cr, ci; discretize(in.in[12][base * S5P + p], in.in[13][base * S5P + p], dt, ar, ai, cr, ci);
        const f32x4* br = (const f32x4*)(in.in[15] + ((size_t)base * S5P + p) * S5H + 8 * hi); const f32x4* bi = (const f32x4*)(in.in[16] + ((size_t)base * S5P + p) * S5H + 8 * hi);
        const f32x4 r0 = br[0], r1 = br[1], i0 = bi[0], i1 = bi[1];
        const f32x4 xr0 = r0 * cr - i0 * ci, xr1 = r1 * cr - i1 * ci, xi0 = i0 * cr + r0 * ci, xi1 = i1 * cr + r1 * ci;
        v4u wr, wi; wr.x = pk2(xr0[0], xr0[1]); wr.y = pk2(xr0[2], xr0[3]); wr.z = pk2(xr1[0], xr1[1]); wr.w = pk2(xr1[2], xr1[3]);
        wi.x = pk2(xi0[0], xi0[1]); wi.y = pk2(xi0[2], xi0[3]); wi.z = pk2(xi1[0], xi1[1]); wi.w = pk2(xi1[2], xi1[3]);
        if (q == 0) { P.Bre1 = __builtin_bit_cast(bf16x8, wr); P.Bim1 = __builtin_bit_cast(bf16x8, wi); } else { P.Bre2 = __builtin_bit_cast(bf16x8, wr); P.Bim2 = __builtin_bit_cast(bf16x8, wi); } }
}
constexpr size_t TAB_B = 0, TAB_A = 128 * 4 * 64 * 16, TAB_C = TAB_A + 128 * 64 * 8, TAB_END = TAB_C + 128 * 4 * 64 * 16;
__device__ __forceinline__ void cfrags(const Args& in, int ei, int dir, int g, int lane, bf16x8 (&C)[4]) {
    const int fr = lane & 15, kq = lane >> 4;
#pragma unroll
    for (int ks = 0; ks < 4; ++ks) { const size_t o = ((size_t)((ei * 2 + dir) * S5G + g) * S5H + fr) * S5P + 16 * ks + 4 * kq;
        const f32x4 cr = *(const f32x4*)(in.in[17] + o), ci = *(const f32x4*)(in.in[18] + o);
        v4u w; w.x = pk2(cr[0], -ci[0]); w.y = pk2(cr[1], -ci[1]); w.z = pk2(cr[2], -ci[2]); w.w = pk2(cr[3], -ci[3]);
        C[ks] = __builtin_bit_cast(bf16x8, w); }
}
__device__ __forceinline__ void table_store(unsigned char* tab, int dg, int lane, const Par& P, const bf16x8 (&C)[4]) {
    v4u* tb = (v4u*)(tab + TAB_B) + (size_t)dg * 256 + lane; tb[0] = __builtin_bit_cast(v4u, P.Bre1); tb[64] = __builtin_bit_cast(v4u, P.Bim1); tb[128] = __builtin_bit_cast(v4u, P.Bre2); tb[192] = __builtin_bit_cast(v4u, P.Bim2);
    ((float2*)(tab + TAB_A))[dg * 64 + lane] = make_float2(P.a_re, P.a_im);
    v4u* tc = (v4u*)(tab + TAB_C) + (size_t)dg * 256 + lane;
#pragma unroll
    for (int ks = 0; ks < 4; ++ks) tc[64 * ks] = __builtin_bit_cast(v4u, C[ks]);
}
__device__ __forceinline__ void table_load(const unsigned char* tab, int dg, int lane, Par& P, bf16x8 (&C)[4]) {
    const v4u* tb = (const v4u*)(tab + TAB_B) + (size_t)dg * 256 + lane; P.Bre1 = __builtin_bit_cast(bf16x8, tb[0]); P.Bim1 = __builtin_bit_cast(bf16x8, tb[64]); P.Bre2 = __builtin_bit_cast(bf16x8, tb[128]); P.Bim2 = __builtin_bit_cast(bf16x8, tb[192]);
    const float2 a = ((const float2*)(tab + TAB_A))[dg * 64 + lane]; P.a_re = a.x; P.a_im = a.y;
    const v4u* tc = (const v4u*)(tab + TAB_C) + (size_t)dg * 256 + lane;
#pragma unroll
    for (int ks = 0; ks < 4; ++ks) C[ks] = __builtin_bit_cast(bf16x8, tc[64 * ks]);
}
__device__ __forceinline__ int chunk_row0(int b, int tc) { return tc < 128 ? b * SEQ + 64 * tc : TLAT + b * CTXL + 64 * (tc - 128); }
__device__ __forceinline__ void load_chunk(const bf16* U, int row0, int g, int dir, int lane, bf16x8 (&A2)[2]) {
    const int r32 = lane & 31, hi = lane >> 5;
#pragma unroll
    for (int blk = 0; blk < 2; ++blk) { const int i = 32 * blk + r32, tok = dir ? 63 - i : i; A2[blk] = *(const bf16x8*)(U + (size_t)(row0 + tok) * MIXIN + g * S5H + 8 * hi); }
}
template <bool WRITE_H> __device__ __forceinline__ void run_chunk_pre(const Par& P, const bf16x8 (&A2)[2], int dir, int lane, float& sre, float& sim, LAS unsigned* Hbuf) {
#pragma unroll
    for (int blk = 0; blk < 2; ++blk) {
        const bf16x8 A = A2[blk];
        f32x16 G1r, G1i, G2r, G2i;
        asm volatile("s_nop 1\n\tv_mfma_f32_32x32x16_bf16 %0, %4, %5, 0\n\tv_mfma_f32_32x32x16_bf16 %1, %4, %6, 0\n\tv_mfma_f32_32x32x16_bf16 %2, %4, %7, 0\n\tv_mfma_f32_32x32x16_bf16 %3, %4, %8, 0\n\ts_nop 15"
                     : "=&v"(G1r), "=&v"(G1i), "=&v"(G2r), "=&v"(G2i) : "v"(A), "v"(P.Bre1), "v"(P.Bim1), "v"(P.Bre2), "v"(P.Bim2));
#pragma unroll
        for (int r = 0; r < 16; ++r) {
            auto sr = __builtin_amdgcn_permlane32_swap(__float_as_uint(G1r[r]), __float_as_uint(G2r[r]), false, false); G1r[r] = __uint_as_float(sr[0]); G2r[r] = __uint_as_float(sr[1]);
            auto si = __builtin_amdgcn_permlane32_swap(__float_as_uint(G1i[r]), __float_as_uint(G2i[r]), false, false); G1i[r] = __uint_as_float(si[0]); G2i[r] = __uint_as_float(si[1]); }
#define S5_STEP(XR, XI, STEPI) do { const float nr = fmaf(-P.a_im, sim, fmaf(P.a_re, sre, (XR))); const float ni = fmaf(P.a_im, sre, fmaf(P.a_re, sim, (XI))); sre = nr; sim = ni; \
        if (WRITE_H) { const int st_ = 32 * blk + (STEPI); const int tk_ = dir ? 63 - st_ : st_; Hbuf[tk_ * 68 + lane] = pk2(sre, sim); } } while (0)
#pragma unroll
        for (int j = 0; j < 4; ++j) {
#pragma unroll
            for (int q = 0; q < 4; ++q) S5_STEP(G1r[4 * j + q], G1i[4 * j + q], 8 * j + q);
#pragma unroll
            for (int q = 0; q < 4; ++q) S5_STEP(G2r[4 * j + q], G2i[4 * j + q], 8 * j + 4 + q);
        }
#undef S5_STEP
    }
}
template <bool WRITE_H> __device__ __forceinline__ void run_chunk(const Par& P, const bf16* U, int row0, int g, int dir, int lane, float& sre, float& sim, LAS unsigned* Hbuf) {
    bf16x8 A2[2]; load_chunk(U, row0, g, dir, lane, A2); run_chunk_pre<WRITE_H>(P, A2, dir, lane, sre, sim, Hbuf);
}
}

__device__ __forceinline__ void s1_phase(Frame& F, int ei) {
    const int gw = F.vcu * NWAVES + F.wave, NGW = F.G * NWAVES;
    const bf16* U = WSP(bf16, WS_BIG); float2* SE = WSP(float2, WS_SE);
    int cur = -1; s5::Par P;
    constexpr int NTASK = 2 * S5G * BATCH * NTC;
    for (int task = gw; task < NTASK; task += 2 * NGW) {
        const int dg = task % 128, idx = task / 128, dir = dg >> 6, g = dg & 63, b = idx / NTC, tc = idx % NTC;
        const int task2 = task + NGW; const bool has2 = task2 < NTASK; const int idx2 = has2 ? task2 / 128 : idx, b2 = idx2 / NTC, tc2 = idx2 % NTC;
        bf16x8 Aa[2], Ab[2];
        s5::load_chunk(U, s5::chunk_row0(b, tc), g, dir, F.lane, Aa); s5::load_chunk(U, s5::chunk_row0(b2, tc2), g, dir, F.lane, Ab);
        if (dg != cur) { s5::load_par(F.A, ei, dir, g, F.lane, P); cur = dg;
            if (idx == 0) { bf16x8 C[4]; s5::cfrags(F.A, ei, dir, g, F.lane, C); s5::table_store(F.ws + WS_MODP, dg, F.lane, P, C); } }
        { float sre = 0.f, sim = 0.f;
          s5::run_chunk_pre<false>(P, Aa, dir, F.lane, sre, sim, nullptr);
          SE[(((size_t)(b * 2 + dir) * S5G + g) * NTC + tc) * S5P + F.lane] = make_float2(sre, sim); }
        if (has2) { float sre = 0.f, sim = 0.f;
          s5::run_chunk_pre<false>(P, Ab, dir, F.lane, sre, sim, nullptr);
          SE[(((size_t)(b2 * 2 + dir) * S5G + g) * NTC + tc2) * S5P + F.lane] = make_float2(sre, sim); }
    }
    bf16* MIXA = WSP(bf16, WS_MIXA);
    const float* cw = F.A.in[22] + (size_t)ei * 3 * S5W; const float* cb = F.A.in[23] + (size_t)ei * S5W;
    const int c0 = F.lane * 16;
    f32x4 w0[4], w1[4], w2[4], wb4[4];
#pragma unroll
    for (int q = 0; q < 4; ++q) { w0[q] = *(const f32x4*)(cw + c0 + 4 * q); w1[q] = *(const f32x4*)(cw + S5W + c0 + 4 * q); w2[q] = *(const f32x4*)(cw + 2 * S5W + c0 + 4 * q); wb4[q] = *(const f32x4*)(cb + c0 + 4 * q); }
    for (int row = gw; row < TT; row += NGW) {
        const int t = row < TLAT ? (row & (SEQ - 1)) : ((row - TLAT) & (CTXL - 1)), len = row < TLAT ? SEQ : CTXL;
        const bool hp = t > 0, hn = t < len - 1;
        const bf16* pr = U + (size_t)row * MIXIN;
        v4u bgv[2], cg0v[2], v0v[2], cg1v[2], v1v[2], cg2v[2], v2v[2];
#pragma unroll
        for (int hh = 0; hh < 2; ++hh) { const int c = c0 + 8 * hh;
            bgv[hh] = *(const v4u*)(pr + 1024 + c); cg1v[hh] = *(const v4u*)(pr + 2048 + c); v1v[hh] = *(const v4u*)(pr + 3072 + c);
            cg0v[hh] = (v4u){0, 0, 0, 0}; v0v[hh] = cg0v[hh]; cg2v[hh] = cg0v[hh]; v2v[hh] = cg0v[hh];
            if (hp) { cg0v[hh] = *(const v4u*)(pr - MIXIN + 2048 + c); v0v[hh] = *(const v4u*)(pr - MIXIN + 3072 + c); }
            if (hn) { cg2v[hh] = *(const v4u*)(pr + MIXIN + 2048 + c); v2v[hh] = *(const v4u*)(pr + MIXIN + 3072 + c); } }
#pragma unroll
        for (int hh = 0; hh < 2; ++hh) { const int c = c0 + 8 * hh;
            const v4u bg = bgv[hh], cg0 = cg0v[hh], v0 = v0v[hh], cg1 = cg1v[hh], v1 = v1v[hh], cg2 = cg2v[hh], v2 = v2v[hh];
            float o[8];
#pragma unroll
            for (int e = 0; e < 4; ++e) { const unsigned wb = bg[e], a0 = cg0[e], b0 = v0[e], a1 = cg1[e], b1 = v1[e], a2 = cg2[e], b2 = v2[e]; const int q = 2 * hh + (e >> 1), z = 2 * (e & 1);
                o[2 * e] = bflo(wb) * (w0[q][z] * (bflo(a0) * bflo(b0)) + w1[q][z] * (bflo(a1) * bflo(b1)) + w2[q][z] * (bflo(a2) * bflo(b2)) + wb4[q][z]);
                o[2 * e + 1] = bfhi(wb) * (w0[q][z + 1] * (bfhi(a0) * bfhi(b0)) + w1[q][z + 1] * (bfhi(a1) * bfhi(b1)) + w2[q][z + 1] * (bfhi(a2) * bfhi(b2)) + wb4[q][z + 1]); }
            v4u w; w.x = pk2(o[0], o[1]); w.y = pk2(o[2], o[3]); w.z = pk2(o[4], o[5]); w.w = pk2(o[6], o[7]);
            *(v4u*)(MIXA + (size_t)row * DM + S5W + c) = w; }
    }
}
__device__ __forceinline__ void s2_phase(Frame& F, int ei) {
    if (F.wave != 0) return;
    const float2* SE = WSP(float2, WS_SE); float2* SC = WSP(float2, WS_SC);
    for (int combo = blockIdx.x; combo < BATCH * 2 * S5G; combo += F.G) {
        const int b = combo >> 7, dir = (combo >> 6) & 1, g = combo & 63, base = (ei * 2 + dir) * S5G + g;
        float ar, ai, cr, ci; s5::discretize(F.A.in[12][base * S5P + F.lane], F.A.in[13][base * S5P + F.lane], expf(F.A.in[14][base]), ar, ai, cr, ci);
#pragma unroll
        for (int q = 0; q < 6; ++q) { const float nr = ar * ar - ai * ai, ni = 2.0f * ar * ai; ar = nr; ai = ni; }
        const size_t off = ((size_t)(b * 2 + dir) * S5G + g) * NTC * S5P + F.lane;
        float sre = 0.f, sim = 0.f; asm volatile("" : "+v"(sre), "+v"(sim));
        for (int k0 = 0; k0 < NTC; k0 += 12) {
            float2 e[12];
#pragma unroll
            for (int q = 0; q < 12; ++q) { const int k = k0 + q; const int tc = dir ? (NTC - 1 - k) : (k < 4 ? 128 + k : k - 4); e[q] = SE[off + (size_t)tc * S5P]; }
#pragma unroll
            for (int q = 0; q < 12; ++q) { const int k = k0 + q; const int tc = dir ? (NTC - 1 - k) : (k < 4 ? 128 + k : k - 4);
                SC[off + (size_t)tc * S5P] = make_float2(sre, sim);
                const float nr = ar * sre - ai * sim + e[q].x, ni = ar * sim + ai * sre + e[q].y; sre = nr; sim = ni; }
        }
    }
}
__device__ __forceinline__ float gelu_tanh(float x) { const float p = fmaf(-0.10294324f, x * x, -2.3022082f); return x * __builtin_amdgcn_rcpf(1.0f + __builtin_amdgcn_exp2f(x * p)); }
__device__ __forceinline__ void s3_phase(Frame& F, int ei) {
    const int gw = F.vcu * NWAVES + F.wave, NGW = F.G * NWAVES;
    const bf16* U = WSP(bf16, WS_BIG); const float2* SC = WSP(float2, WS_SC); bf16* Z = WSP(bf16, WS_Z);
    const unsigned char* tab = F.ws + WS_MODP;
    LAS unsigned* Hbuf = (LAS unsigned*)(F.lds + F.wave * (64 * 68 * 4));
    LAS float* Ybuf = (LAS float*)Hbuf;
    const int fr = F.lane & 15, kq = F.lane >> 4;
    constexpr int NTASK = S5G * BATCH * NTC;
    s5::Par Pd[2]; bf16x8 Cd[2][4];
#pragma unroll
    for (int dir = 0; dir < 2; ++dir) s5::table_load(tab, dir * S5G + (gw % S5G), F.lane, Pd[dir], Cd[dir]);
    for (int task = gw; task < NTASK; task += NGW) {
        const int g = task % S5G, idx = task / S5G, b = idx / NTC, tc = idx % NTC;
        const int row0 = s5::chunk_row0(b, tc);
        f32x4 yacc[4] = {{0, 0, 0, 0}, {0, 0, 0, 0}, {0, 0, 0, 0}, {0, 0, 0, 0}};
        bf16x8 Ad[2][2]; s5::load_chunk(U, row0, g, 0, F.lane, Ad[0]); s5::load_chunk(U, row0, g, 1, F.lane, Ad[1]);
        float2 cin[2];
#pragma unroll
        for (int dir = 0; dir < 2; ++dir) cin[dir] = SC[(((size_t)(b * 2 + dir) * S5G + g) * NTC + tc) * S5P + F.lane];
        const v4u u0 = *(const v4u*)(U + (size_t)(row0 + F.lane) * MIXIN + g * S5H), u1 = *(const v4u*)(U + (size_t)(row0 + F.lane) * MIXIN + g * S5H + 8);
#pragma unroll
        for (int dir = 0; dir < 2; ++dir) {
            const s5::Par& P = Pd[dir]; const bf16x8 (&C)[4] = Cd[dir];
            float sre = cin[dir].x, sim = cin[dir].y;
            s5::run_chunk_pre<true>(P, Ad[dir], dir, F.lane, sre, sim, Hbuf);
            LDS_WAIT(); asm volatile("" ::: "memory");
#pragma unroll
            for (int tb = 0; tb < 4; ++tb)
#pragma unroll
                for (int ks = 0; ks < 4; ++ks) { const bf16x8 a = *(const LAS bf16x8*)(Hbuf + (16 * tb + fr) * 68 + 16 * ks + 4 * kq);
                    yacc[tb] = __builtin_amdgcn_mfma_f32_16x16x32_bf16(a, C[ks], yacc[tb], 0, 0, 0); }
            LDS_WAIT(); asm volatile("" ::: "memory");
        }
#pragma unroll
        for (int tb = 0; tb < 4; ++tb)
#pragma unroll
            for (int e = 0; e < 4; ++e) Ybuf[(16 * tb + 4 * kq + e) * 20 + fr] = yacc[tb][e];
        LDS_WAIT(); asm volatile("" ::: "memory");
        { const size_t row = (size_t)(row0 + F.lane);
          const float* dp = F.A.in[19] + ei * S5W + g * S5H;
          float z[16];
#pragma unroll
          for (int q = 0; q < 4; ++q) { const f32x4 y = *(const LAS f32x4*)(Ybuf + F.lane * 20 + 4 * q); const f32x4 d = *(const f32x4*)(dp + 4 * q);
              const unsigned w0 = q < 2 ? u0[2 * q] : u1[2 * q - 4], w1 = q < 2 ? u0[2 * q + 1] : u1[2 * q - 3];
              z[4 * q] = gelu_tanh(y[0] + d[0] * bflo(w0)); z[4 * q + 1] = gelu_tanh(y[1] + d[1] * bfhi(w0)); z[4 * q + 2] = gelu_tanh(y[2] + d[2] * bflo(w1)); z[4 * q + 3] = gelu_tanh(y[3] + d[3] * bfhi(w1)); }
          v4u o0, o1; o0.x = pk2(z[0], z[1]); o0.y = pk2(z[2], z[3]); o0.z = pk2(z[4], z[5]); o0.w = pk2(z[6], z[7]); o1.x = pk2(z[8], z[9]); o1.y = pk2(z[10], z[11]); o1.z = pk2(z[12], z[13]); o1.w = pk2(z[14], z[15]);
          *(v4u*)(Z + row * S5W + g * S5H) = o0; *(v4u*)(Z + row * S5W + g * S5H + 8) = o1; }
        LDS_WAIT(); asm volatile("" ::: "memory");
    }
}

__device__ __forceinline__ void attn_combine_block(Frame& F, const bf16* OC, bf16* AO, int row0, int h, int oi, float lam_init) {
    const int e0 = (F.lane & 15) * 8, sub = F.lane >> 4;
    const float* lv = F.A.in[26] + (size_t)oi * 4 * 64;
    const float lam = expf(wave_sum(lv[F.lane] * lv[64 + F.lane])) - expf(wave_sum(lv[128 + F.lane] * lv[192 + F.lane])) + lam_init;
    float g[8];
    { const float* sl = F.A.in[27] + (size_t)oi * 128 + e0;
#pragma unroll
      for (int e = 0; e < 8; ++e) g[e] = sl[e] * (1.0f - lam_init); }
#pragma unroll 2
    for (int it = 0; it < 8; ++it) { const size_t row = (size_t)(row0 + it * 32 + F.wave * 4 + sub);
        const v4u a = *(const v4u*)(OC + row * 4096 + h * 256 + e0), bq = *(const v4u*)(OC + row * 4096 + h * 256 + 128 + e0);
        float d[8]; float ss = 0.f;
#pragma unroll
        for (int e = 0; e < 4; ++e) { d[2 * e] = bflo(a[e]) - lam * bflo(bq[e]); d[2 * e + 1] = bfhi(a[e]) - lam * bfhi(bq[e]); ss += d[2 * e] * d[2 * e] + d[2 * e + 1] * d[2 * e + 1]; }
        ss += __shfl_xor(ss, 1); ss += __shfl_xor(ss, 2); ss += __shfl_xor(ss, 4); ss += __shfl_xor(ss, 8);
        const float r = rsqrtf(ss * (1.0f / 128.0f) + EPS);
        v4u w; w.x = pk2(d[0] * r * g[0], d[1] * r * g[1]); w.y = pk2(d[2] * r * g[2], d[3] * r * g[3]); w.z = pk2(d[4] * r * g[4], d[5] * r * g[5]); w.w = pk2(d[6] * r * g[6], d[7] * r * g[7]);
        *(v4u*)(AO + row * DM + h * 128 + e0) = w; }
}
__device__ __forceinline__ void attn_phase(Frame& F, int oi, float lam_init, bool ctx_queries) {
    const bf16* QKV = WSP(bf16, WS_BIG); bf16* OC = WSP(bf16, WS_OC); bf16* AO = WSP(bf16, WS_MIXA);
    char* lds = (char*)F.lds;
    const int npairs = BATCH * 16 * 32 + (ctx_queries ? BATCH * 16 : 0);
    for (int pair = F.vcu; pair < npairs; pair += F.G) {
        int qrow0, h, lat0, nlat, ctx0, NT;
        if (pair < BATCH * 16 * 32) { const int qb = pair & 31, hb = pair >> 5, b = hb >> 4; h = hb & 15;
            qrow0 = b * SEQ + qb * 256; lat0 = b * SEQ; nlat = 128; ctx0 = TLAT + b * CTXL; NT = 132; }
        else { const int hb = pair - BATCH * 16 * 32, b = hb >> 4; h = hb & 15;
            qrow0 = TLAT + b * CTXL; lat0 = 0; nlat = 0; ctx0 = TLAT + b * CTXL; NT = 4; }
#pragma unroll 1
        for (int c = 0; c < 2; ++c)
            att::attn_unit(QKV, OC, qrow0, h * 128 + c * 64, DM + h * 128 + c * 64, 2 * DM + h * 128, h * 256 + c * 128, lat0, nlat, ctx0, NT, lds, F.tid);
        attn_combine_block(F, OC, AO, qrow0, h, oi, lam_init);
    }
}
__global__ void __launch_bounds__(NWAVES * 64, 2) mk_fwd(Args args) {
    extern __shared__ __attribute__((aligned(16))) unsigned char lds[];
    Frame F{args};
    F.lds = (LAS unsigned char*)lds;
    F.tid = threadIdx.x; F.lane = F.tid & 63; F.wave = __builtin_amdgcn_readfirstlane(F.tid >> 6);
    F.G = gridDim.x; { const int bx = blockIdx.x; F.vcu = (F.G % 8 == 0) ? (bx % 8) * (F.G / 8) + bx / 8 : bx; }
    F.ws = args.ws; F.out = args.out;
    volatile LAS unsigned* MISC = (volatile LAS unsigned*)(F.lds + MISC_OFF);
    for (int u = F.tid; u < (LDS_BYTES - LDSCTL_OFF) / 4; u += NWAVES * 64) ((LAS unsigned*)(F.lds + LDSCTL_OFF))[u] = 0u;
    __syncthreads();
    const int lo = args.ph_lo, hi = args.ph_hi;
    XcdBarrier bar; bar.bar = (unsigned*)(F.ws + WS_CTL) + CW_BAR; bar.x = 0; bar.st = nullptr;
    if (hi - lo > 1) bar = xcd_barrier_post((unsigned*)(F.ws + WS_CTL) + CW_BAR, MISC + 8);
    int ph = 0;
#define PH_BEGIN if (ph >= lo && ph < hi) { { int t_ = threadIdx.x; asm volatile("" : "+v"(t_)); F.tid = t_; F.lane = t_ & 63; F.wave = __builtin_amdgcn_readfirstlane(t_ >> 6); \
        GAS unsigned char* w_ = (GAS unsigned char*)args.ws; asm volatile("" : "+s"(w_)); F.ws = (unsigned char*)w_; }
#define PH_END   if (ph + 1 < hi) xcd_barrier(bar); } ++ph;

    PH_BEGIN p0_prologue(F); PH_END
    PH_BEGIN p1_ada_reduce(F); PH_END
    PH_BEGIN resid_norm_phase(F, -1); PH_END

    for (int sub = 0; sub < NSUB; ++sub) {
        const int layer = sub / 3, s = sub % 3;
        const bool mix_ctx = layer < DEPTH - 1;
        const bool need_ctx = mix_ctx || s == 0;
        if (s != 1) {
            const int lh = layer * 2 + (s >> 1);
            constexpr int NCG = 2 * (2 * FF / 256), NCS = (TCTX / 256) * (DM / 256) * NZ_DOWN;
            unsigned* hcnt = (unsigned*)(F.ws + WS_CTL) + CW_HOST + 64 * sub;
            for (int part = 0; part < 2; ++part) {
                PH_BEGIN
                    const bool cg = need_ctx && (int)blockIdx.x < NCG;
                    if (part == 0 || cg) {
                        pg8::Gemm g{WSP(const pg8::bf16_t, WS_H), WSP(const pg8::bf16_t, WS_WGU + lh * WGU_ONE), TT, 2 * FF, DM, DM}; pg8::StaticOrder S;
                        if (part == 0) S.init(TLAT, 2 * FF, F.G, (int)blockIdx.x, 0, 8); else S.init(TCTX, 2 * FF, NCG, (int)blockIdx.x, TLAT / 256);
                        pg8::EpiSwiGLU E{WSP(pg8::bf16_t, WS_BIG), FF};
                        pg8::gemm_phase<pg8::EpiSwiGLU, pg8::StaticOrder, true, true>(F.lds, g, S, E);
                    }
                    if (part == 1) {
                        if (cg) host_arrive(hcnt);
                        pg8::Gemm g{WSP(const pg8::bf16_t, WS_BIG), WSP(const pg8::bf16_t, WS_WD + lh * WD_ONE), TLAT, DM, FF, FF}; pg8::StaticOrder S; S.init(TLAT, DM, F.G, (int)blockIdx.x);
                        pg8::EpiPlain E{WSP(pg8::bf16_t, WS_Y), DM};
                        pg8::gemm_phase<pg8::EpiPlain, pg8::StaticOrder, true, true>(F.lds, g, S, E);
                        const int cs = (int)blockIdx.x - NCG;
                        if (need_ctx && cs >= 0 && cs < NCS) {
                            host_wait(hcnt, (unsigned)NCG);
                            pg8::Gemm g2{WSP(const pg8::bf16_t, WS_BIG), WSP(const pg8::bf16_t, WS_WD + lh * WD_ONE), TT, DM, FF / NZ_DOWN, FF}; pg8::SplitOrder S2; S2.init(TLAT / 256, TCTX / 256, DM, NZ_DOWN, NCS, cs);
                            pg8::EpiPartial E2{WSP(float, WS_PART), DM, TLAT, (size_t)TCTX * DM};
                            pg8::gemm_phase<pg8::EpiPartial, pg8::SplitOrder, true, true>(F.lds, g2, S2, E2);
                        }
                    }
                PH_END
            }
        } else if ((layer & 1) == 0) {
            const int ei = layer >> 1;
            PH_BEGIN
                pg8::Gemm g{WSP(const pg8::bf16_t, WS_H), WSP(const pg8::bf16_t, WS_WIN + (size_t)ei * MIXIN * DM * 2), TT, MIXIN, DM, DM}; pg8::StaticOrder S; S.init(TT, MIXIN, F.G, (int)blockIdx.x);
                pg8::EpiPlain E{WSP(pg8::bf16_t, WS_BIG), MIXIN};
                pg8::gemm_phase<pg8::EpiPlain, pg8::StaticOrder, true, true>(F.lds, g, S, E);
            PH_END
            PH_BEGIN s1_phase(F, ei); PH_END
            PH_BEGIN s2_phase(F, ei); PH_END
            PH_BEGIN s3_phase(F, ei); PH_END
            PH_BEGIN
                pg8::Gemm g{WSP(const pg8::bf16_t, WS_Z), WSP(const pg8::bf16_t, WS_WGLU + (size_t)ei * S5W * S5W * 2), TT, S5W, S5W, S5W}; pg8::StaticOrder S; S.init(TT, S5W, F.G, (int)blockIdx.x);
                pg8::EpiGLU E{WSP(const pg8::bf16_t, WS_Z), S5W, F.A.in[21] + (size_t)ei * S5W, WSP(pg8::bf16_t, WS_MIXA), DM};
                pg8::gemm_phase<pg8::EpiGLU, pg8::StaticOrder, true, true>(F.lds, g, S, E);
            PH_END
            PH_BEGIN
                const pg8::bf16_t* Wp = WSP(const pg8::bf16_t, WS_WOUT + (size_t)ei * DM * MIXOUT * 2);
                pg8::Gemm g{WSP(const pg8::bf16_t, WS_MIXA), Wp, TLAT, DM, MIXOUT, MIXOUT}; pg8::StaticOrder S; S.init(TLAT, DM, F.G, (int)blockIdx.x);
                pg8::EpiPlain E{WSP(pg8::bf16_t, WS_Y), DM};
                pg8::gemm_phase<pg8::EpiPlain, pg8::StaticOrder, true, true>(F.lds, g, S, E);
                pg8::Gemm g2{WSP(const pg8::bf16_t, WS_MIXA), Wp, TT, DM, MIXOUT / NZ_OUT, MIXOUT}; pg8::SplitOrder S2; S2.init(TLAT / 256, TCTX / 256, DM, NZ_OUT, F.G, (int)blockIdx.x);
                pg8::EpiPartial E2{WSP(float, WS_PART), DM, TLAT, (size_t)TCTX * DM};
                if (mix_ctx) pg8::gemm_phase<pg8::EpiPartial, pg8::SplitOrder, true, true>(F.lds, g2, S2, E2);
            PH_END
        } else {
            const int oi = layer >> 1;
            PH_BEGIN
                pg8::Gemm g{WSP(const pg8::bf16_t, WS_H), WSP(const pg8::bf16_t, WS_WQKV + (size_t)oi * 3 * DM * DM * 2), TT, 3 * DM, DM, DM}; pg8::StaticOrder S; S.init(TT, 3 * DM, F.G, (int)blockIdx.x);
                pg8::EpiQKV E{WSP(pg8::bf16_t, WS_BIG), 3 * DM, WSP(const float, WS_ROPE), 0.125f * 1.4426950408889634f};
                pg8::gemm_phase<pg8::EpiQKV, pg8::StaticOrder, true, true>(F.lds, g, S, E);
            PH_END
            PH_BEGIN attn_phase(F, oi, oi == 0 ? 0.35550906759096934f : 0.5560582041556406f, mix_ctx); PH_END
            PH_BEGIN
                const pg8::bf16_t* Wp = WSP(const pg8::bf16_t, WS_WO + (size_t)oi * DM * DM * 2);
                pg8::Gemm g{WSP(const pg8::bf16_t, WS_MIXA), Wp, TLAT, DM, DM, DM}; pg8::StaticOrder S; S.init(TLAT, DM, F.G, (int)blockIdx.x);
                pg8::EpiPlain E{WSP(pg8::bf16_t, WS_Y), DM};
                pg8::gemm_phase<pg8::EpiPlain, pg8::StaticOrder, true, true>(F.lds, g, S, E);
                pg8::Gemm g2{WSP(const pg8::bf16_t, WS_MIXA), Wp, TT, DM, DM / NZ_OUT, DM}; pg8::SplitOrder S2; S2.init(TLAT / 256, TCTX / 256, DM, NZ_OUT, F.G, (int)blockIdx.x);
                pg8::EpiPartial E2{WSP(float, WS_PART), DM, TLAT, (size_t)TCTX * DM};
                pg8::gemm_phase<pg8::EpiPartial, pg8::SplitOrder, true, true>(F.lds, g2, S2, E2);
            PH_END
        }
        PH_BEGIN resid_norm_phase(F, sub, (mix_ctx || s == 0) ? TCTX : 0); PH_END
    }
#undef PH_BEGIN
#undef PH_END
}

static int count_phases() { int n = 3; for (int sub = 0; sub < NSUB; ++sub) { const int layer = sub / 3, s = sub % 3; n += (s != 1) ? 2 : ((layer & 1) == 0 ? 6 : 3); n += 1; } return n; }
extern "C" void kernel_launch(void* const* d_in, const int* in_sizes, int n_in, void* d_out, int out_size, void* d_ws, size_t ws_size, hipStream_t stream) {
    static int grid = 0;
    if (grid == 0) {
        if (n_in != 28 || in_sizes[0] != TLAT * DM || out_size != TLAT * DM || ws_size < WS_END) { fprintf(stderr, "kernel_launch: shape mismatch: n_in %d in0 %d out %d ws %zu (need %zu)\n", n_in, n_in > 0 ? in_sizes[0] : -1, out_size, ws_size, (size_t)WS_END); grid = -1; return; }
        int dev = 0, cus = 0, per_cu = 0;
        if (hipGetDevice(&dev) != hipSuccess || hipDeviceGetAttribute(&cus, hipDeviceAttributeMultiprocessorCount, dev) != hipSuccess) { grid = -1; return; }
        if (hipFuncSetAttribute((const void*)mk_fwd, hipFuncAttributeMaxDynamicSharedMemorySize, LDS_BYTES) != hipSuccess) { fprintf(stderr, "kernel_launch: hipFuncSetAttribute failed\n"); grid = -1; return; }
        if (hipOccupancyMaxActiveBlocksPerMultiprocessor(&per_cu, (const void*)mk_fwd, NWAVES * 64, LDS_BYTES) != hipSuccess || per_cu < 1) { fprintf(stderr, "kernel_launch: occupancy query says %d\n", per_cu); }
        (void)hipGetLastError();
        grid = cus;
    }
    if (grid < 0) return;
    if (hipMemsetAsync((char*)d_ws + WS_CTL, 0, CTL_ZERO_BYTES, stream) != hipSuccess) return;
    Args a{};
    for (int i = 0; i < 28; ++i) a.in[i] = (const float*)d_in[i];
    a.out = (float*)d_out; a.ws = (unsigned char*)d_ws;
    const int nph = count_phases();
#if ONE_LAUNCH
    a.ph_lo = 0; a.ph_hi = nph;
    hipLaunchKernelGGL(mk_fwd, dim3(grid), dim3(NWAVES * 64), LDS_BYTES, stream, a);
#else
    for (int p = 0; p < nph; ++p) { a.ph_lo = p; a.ph_hi = p + 1; hipLaunchKernelGGL(mk_fwd, dim3(grid), dim3(NWAVES * 64), LDS_BYTES, stream, a); }
#endif
    const hipError_t le = hipPeekAtLastError();
    if (le != hipSuccess) fprintf(stderr, "kernel_launch: launch failed: %s\n", hipGetErrorName(le));
}
```

```cpp
#include <hip/hip_runtime.h>
#include <cstdio>
#include <cstdint>
#include <cmath>
namespace pg8 {
#define PG8_LAS __attribute__((address_space(3)))
typedef unsigned short bf16_t;
typedef short bf16x8 __attribute__((ext_vector_type(8)));
typedef float f32x4 __attribute__((ext_vector_type(4)));
typedef unsigned u32x4 __attribute__((ext_vector_type(4)));
constexpr int BM = 256, BK = 64, HALF = 128, HTB = HALF * BK * 2  , STAGE_BYTES = 8 * HTB, NXCD = 8, WGM = 4;

__host__ __device__ __forceinline__ int lds_byte(int r, int c) { const int st = (r >> 4) * 2 + (c >> 5), rr = r & 15, cc = c & 31, ob = rr * 64 + cc * 2; return st * 1024 + (ob ^ (((ob >> 9) & 1) << 5)); }
__host__ __device__ __forceinline__ void stage_rc(int b, int& R, int& C) { const int st = b / 1024, sb = b % 1024, swz = sb ^ (((sb >> 9) & 1) << 5); R = (st >> 1) * 16 + swz / 64; C = (st & 1) * 32 + (swz % 64) / 2; }
__host__ __device__ __forceinline__ int perm32(int rho) { const int n = rho >> 4, i = rho & 15; return 8 * (i >> 2) + 4 * n + (i & 3); }

struct Unit { int pm, pn, kz, kind; };
struct Gemm { const bf16_t* A; const bf16_t* Bt; int M, N, K, ld; };

struct StaticOrder {
    int nM, nN, nwg, G, c, pm0, wgm;
    __host__ __device__ void init(int M, int N, int G_, int c_, int pm0_ = 0, int wgm_ = WGM) { nM = M / BM; nN = N / BM; nwg = nM * nN; G = G_; c = c_; pm0 = pm0_; wgm = wgm_; }
    __host__ __device__ bool next(int i, Unit& u) const {
        const long L = (long)i * G + c; if (L >= nwg) return false;
        int wgid = (int)L; { const int q = nwg / NXCD, r = nwg % NXCD, xcd = wgid % NXCD, off = wgid / NXCD; wgid = (xcd < r ? xcd * (q + 1) : r * (q + 1) + (xcd - r) * q) + off; }
        const int nig = wgm * nN, gid = wgid / nig, fm = gid * wgm, gsz = (nM - fm) < wgm ? (nM - fm) : wgm;
        u.pm = pm0 + fm + ((wgid % nig) % gsz); u.pn = (wgid % nig) / gsz; u.kz = 0; u.kind = 0; return true;
    }
    __device__ __forceinline__ void a_ready(const Unit&) const {}
    __device__ __forceinline__ void done(const Unit&) const {}
};

__device__ __forceinline__ unsigned cvt_pk_bf16(float lo, float hi) { unsigned r; asm volatile("v_cvt_pk_bf16_f32 %0, %1, %2" : "=v"(r) : "v"(lo), "v"(hi)); return r; }
typedef float f32x2 __attribute__((ext_vector_type(2)));
typedef unsigned u32x2 __attribute__((ext_vector_type(2)));
__device__ __forceinline__ float sigmoid_f(float v) { return __builtin_amdgcn_rcpf(1.0f + __builtin_amdgcn_exp2f(-1.4426950408889634f * v)); }
__device__ __forceinline__ float bf_lo(unsigned w) { return __uint_as_float(w << 16); }
__device__ __forceinline__ float bf_hi(unsigned w) { return __uint_as_float(w & 0xffff0000u); }
__device__ __forceinline__ u32x4 pack8(const f32x4 v0, const f32x4 v1) { u32x4 w; w.x = cvt_pk_bf16(v0[0], v0[1]); w.y = cvt_pk_bf16(v0[2], v0[3]); w.z = cvt_pk_bf16(v1[0], v1[1]); w.w = cvt_pk_bf16(v1[2], v1[3]); return w; }

struct EpiPlain {
    static constexpr bool PERM = true, AFTER_DRAIN = false;
    bf16_t* O; int ldc;
    __device__ __forceinline__ void operator()(const f32x4 (&acc)[2][2][4][2], const Unit& u, int wr, int wc, int fr, int fq) const {
        const int row0 = u.pm * BM + wr * 64 + fr, col0 = u.pn * BM + wc * 32 + 8 * fq;
#pragma unroll
        for (int ai = 0; ai < 2; ++ai)
#pragma unroll
            for (int m = 0; m < 4; ++m) { bf16_t* rowp = O + (size_t)(row0 + ai * HALF + m * 16) * ldc + col0;
#pragma unroll
                for (int bj = 0; bj < 2; ++bj) *(u32x4*)(rowp + bj * HALF) = pack8(acc[ai][bj][m][0], acc[ai][bj][m][1]); }
    }
};
struct EpiSwiGLU {
    static constexpr bool PERM = true, AFTER_DRAIN = false;
    bf16_t* O; int ldc;
    __device__ __forceinline__ void operator()(const f32x4 (&acc)[2][2][4][2], const Unit& u, int wr, int wc, int fr, int fq) const {
        const int row0 = u.pm * BM + wr * 64 + fr, col0 = u.pn * HALF + wc * 32 + 8 * fq;
#pragma unroll
        for (int ai = 0; ai < 2; ++ai)
#pragma unroll
            for (int m = 0; m < 4; ++m) { bf16_t* rowp = O + (size_t)(row0 + ai * HALF + m * 16) * ldc + col0;
                const f32x4 g0 = acc[ai][0][m][0], g1 = acc[ai][0][m][1];
                f32x4 t0 = g0 * -1.4426950408889634f, t1 = g1 * -1.4426950408889634f;
#pragma unroll
                for (int e = 0; e < 4; ++e) { t0[e] = __builtin_amdgcn_exp2f(t0[e]); t1[e] = __builtin_amdgcn_exp2f(t1[e]); }
                t0 = t0 + 1.0f; t1 = t1 + 1.0f;
#pragma unroll
                for (int e = 0; e < 4; ++e) { t0[e] = __builtin_amdgcn_rcpf(t0[e]); t1[e] = __builtin_amdgcn_rcpf(t1[e]); }
                const f32x4 h0 = (g0 * acc[ai][1][m][0]) * t0, h1 = (g1 * acc[ai][1][m][1]) * t1;
                *(u32x4*)rowp = pack8(h0, h1); }
    }
};
struct EpiGLU {
    static constexpr bool PERM = true, AFTER_DRAIN = false;
    const bf16_t* Z; int ldz; const float* bias; bf16_t* O; int ldo;
    __device__ __forceinline__ void operator()(const f32x4 (&acc)[2][2][4][2], const Unit& u, int wr, int wc, int fr, int fq) const {
        const int row0 = u.pm * BM + wr * 64 + fr, col0 = u.pn * BM + wc * 32 + 8 * fq;
        f32x4 bv[2][2];
#pragma unroll
        for (int bj = 0; bj < 2; ++bj)
#pragma unroll
            for (int n = 0; n < 2; ++n) bv[bj][n] = *(const f32x4*)(bias + col0 + bj * HALF + 4 * n);
#pragma unroll
        for (int ai = 0; ai < 2; ++ai)
#pragma unroll
            for (int m = 0; m < 4; ++m) { const size_t r = (size_t)(row0 + ai * HALF + m * 16);
#pragma unroll
                for (int bj = 0; bj < 2; ++bj) { const u32x4 zw = *(const u32x4*)(Z + r * ldz + col0 + bj * HALF);
                    const f32x4 v0 = acc[ai][bj][m][0] + bv[bj][0], v1 = acc[ai][bj][m][1] + bv[bj][1];
                    f32x4 o0, o1;
                    o0[0] = bf_lo(zw.x) * sigmoid_f(v0[0]); o0[1] = bf_hi(zw.x) * sigmoid_f(v0[1]); o0[2] = bf_lo(zw.y) * sigmoid_f(v0[2]); o0[3] = bf_hi(zw.y) * sigmoid_f(v0[3]);
                    o1[0] = bf_lo(zw.z) * sigmoid_f(v1[0]); o1[1] = bf_hi(zw.z) * sigmoid_f(v1[1]); o1[2] = bf_lo(zw.w) * sigmoid_f(v1[2]); o1[3] = bf_hi(zw.w) * sigmoid_f(v1[3]);
                    *(u32x4*)(O + r * ldo + col0 + bj * HALF) = pack8(o0, o1); } }
    }
};
struct EpiQKV {
    static constexpr bool PERM = true, AFTER_DRAIN = false;
    bf16_t* O; int ldc; const float* cs; float qscale;
    __device__ __forceinline__ void operator()(const f32x4 (&acc)[2][2][4][2], const Unit& u, int wr, int wc, int fr, int fq) const {
        const int row0 = u.pm * BM + wr * 64 + fr;
        if (u.pn >= 16) {
            const int col0 = u.pn * BM + wc * 32 + 8 * fq;
#pragma unroll
            for (int ai = 0; ai < 2; ++ai)
#pragma unroll
                for (int m = 0; m < 4; ++m) { bf16_t* rowp = O + (size_t)(row0 + ai * HALF + m * 16) * ldc + col0;
#pragma unroll
                    for (int bj = 0; bj < 2; ++bj) *(u32x4*)(rowp + bj * HALF) = pack8(acc[ai][bj][m][0], acc[ai][bj][m][1]); }
            return;
        }
        const float sc = (u.pn < 8) ? qscale : 1.0f;
        const bool rope = (u.pm < 64);
        const int col1 = u.pn * BM + 64 * wc + 8 * fq;
#pragma unroll
        for (int ai = 0; ai < 2; ++ai)
#pragma unroll
            for (int m = 0; m < 4; ++m) { const int row = row0 + ai * HALF + m * 16;
                f32x4 c0, s0, c1, s1;
                if (rope) { const int t = row & 8191; const int pos = (fq < 2) ? (t >> 6) : (t & 63);
                    const f32x4* tp = (const f32x4*)(cs + (size_t)(pos * 16 + 8 * (fq & 1)) * 2);
                    const f32x4 a = tp[0], b = tp[1], c = tp[2], d = tp[3];
                    c0 = (f32x4){a[0], a[2], b[0], b[2]}; s0 = (f32x4){a[1], a[3], b[1], b[3]}; c1 = (f32x4){c[0], c[2], d[0], d[2]}; s1 = (f32x4){c[1], c[3], d[1], d[3]};
                } else { c0 = c1 = (f32x4){1.f, 1.f, 1.f, 1.f}; s0 = s1 = (f32x4){0.f, 0.f, 0.f, 0.f}; }
                const f32x4 x10 = acc[ai][0][m][0], x11 = acc[ai][0][m][1], x20 = acc[ai][1][m][0], x21 = acc[ai][1][m][1];
                const f32x4 o10 = (x10 * c0 - x20 * s0) * sc, o11 = (x11 * c1 - x21 * s1) * sc, o20 = (x10 * s0 + x20 * c0) * sc, o21 = (x11 * s1 + x21 * c1) * sc;
                bf16_t* rowp = O + (size_t)row * ldc + col1;
                *(u32x4*)rowp = pack8(o10, o11); *(u32x4*)(rowp + 32) = pack8(o20, o21); }
    }
};

struct SplitOrder {
    int pm0, nN, nz, total, G, c;
    __host__ __device__ void init(int pm0_, int npm, int N, int nz_, int G_, int c_) { pm0 = pm0_; nN = N / BM; nz = nz_; total = npm * nN * nz; G = G_; c = c_; }
    __host__ __device__ bool next(int i, Unit& u) const { const long L = (long)i * G + c; if (L >= total) return false; const int l = (int)L; u.kz = l % nz; const int r = l / nz; u.pn = r % nN; u.pm = pm0 + r / nN; u.kind = 1; return true; }
    __device__ __forceinline__ void a_ready(const Unit&) const {}
    __device__ __forceinline__ void done(const Unit&) const {}
};
struct EpiPartial {
    static constexpr bool PERM = true, AFTER_DRAIN = false;
    float* P; int ldc, row0; size_t zstride;
    __device__ __forceinline__ void operator()(const f32x4 (&acc)[2][2][4][2], const Unit& u, int wr, int wc, int fr, int fq) const {
        const int r0 = u.pm * BM + wr * 64 + fr - row0, col0 = u.pn * BM + wc * 32 + 8 * fq;
        float* base = P + (size_t)u.kz * zstride;
#pragma unroll
        for (int ai = 0; ai < 2; ++ai)
#pragma unroll
            for (int m = 0; m < 4; ++m) { float* rowp = base + (size_t)(r0 + ai * HALF + m * 16) * ldc + col0;
#pragma unroll
                for (int bj = 0; bj < 2; ++bj) { *(f32x4*)(rowp + bj * HALF) = acc[ai][bj][m][0]; *(f32x4*)(rowp + bj * HALF + 4) = acc[ai][bj][m][1]; } }
    }
};

struct MixedOrder {
    StaticOrder A; SplitOrder B; int nA;
    __host__ __device__ void init(int M, int N, int pm0, int npm, int nz, int G, int c) { A.init(M, N, G, c); B.init(pm0, npm, N, nz, G, c); nA = (A.nwg > c) ? (A.nwg - c + G - 1) / G : 0; }
    __host__ __device__ bool next(int i, Unit& u) const { return i < nA ? A.next(i, u) : B.next(i - nA, u); }
    __device__ __forceinline__ void a_ready(const Unit&) const {}
    __device__ __forceinline__ void done(const Unit&) const {}
};

template <class Epi, class Sched, bool ALIGN_EPI = false, bool SP2 = false>
__device__ __forceinline__ void gemm_phase(PG8_LAS unsigned char* lds, const Gemm g, const Sched& S, const Epi& E) {
    int tid_ = threadIdx.x; asm volatile("" : "+v"(tid_));
    const int tid = tid_, wid = __builtin_amdgcn_readfirstlane(tid >> 6), lane = tid & 63, wr = wid >> 2, wc = wid & 3, fr = lane & 15, fq = lane >> 4;
    const int K = g.K, nt = K / BK;
    unsigned voffA[2], voffB[2];
#pragma unroll
    for (int i = 0; i < 2; ++i) { int R, C; stage_rc(tid * 16 + i * 8192, R, C); const int Rb = Epi::PERM ? ((R & ~31) + perm32(R & 31)) : R;
        voffA[i] = (unsigned)(R * g.ld + C) * 2u; voffB[i] = (unsigned)(Rb * g.ld + C) * 2u; }
    const size_t kstep = (size_t)(BK * 2);
    const size_t hstep = (size_t)HALF * g.ld * 2; const size_t zstep = (size_t)K * 2;
    const size_t tstep = 2 * hstep;
    const unsigned ldsw = (unsigned)wid * 1024u;
    const int aoff = lds_byte(wr * 64 + fr, fq * 8), boff = lds_byte(wc * 32 + fr, fq * 8);
#define PG8_SA(b, h) (((b) * 2 + (h)) * HTB)
#define PG8_SB(b, h) ((4 + (b) * 2 + (h)) * HTB)
#define PG8_STAGE(bufoff, gbase, voff) do { _Pragma("unroll") for (int _i = 0; _i < 2; ++_i) \
        __builtin_amdgcn_global_load_lds((const unsigned*)((const char*)(gbase) + (voff)[_i]), (PG8_LAS unsigned*)(lds + (bufoff) + ldsw + _i * 8192), 16, 0, 0); } while (0)
#define PG8_LDA(dst, b, h) do { _Pragma("unroll") for (int m = 0; m < 4; ++m) _Pragma("unroll") for (int k = 0; k < 2; ++k) dst[m][k] = *(const PG8_LAS bf16x8*)(lds + PG8_SA(b, h) + aoff + m * 2048 + k * 1024); } while (0)
#define PG8_LDB(dst, b, h) do { _Pragma("unroll") for (int n = 0; n < 2; ++n) _Pragma("unroll") for (int k = 0; k < 2; ++k) dst[n][k] = *(const PG8_LAS bf16x8*)(lds + PG8_SB(b, h) + boff + n * 2048 + k * 1024); } while (0)
#define PG8_MMA(ai, bj, At, Bt) do { __builtin_amdgcn_s_setprio(1); _Pragma("unroll") for (int m = 0; m < 4; ++m) _Pragma("unroll") for (int n = 0; n < 2; ++n) _Pragma("unroll") for (int k = 0; k < 2; ++k) \
        acc[ai][bj][m][n] = __builtin_amdgcn_mfma_f32_16x16x32_bf16(Bt[n][k], At[m][k], acc[ai][bj][m][n], 0, 0, 0); __builtin_amdgcn_s_setprio(0); } while (0)
#define PG8_WAIT_V(n) asm volatile("s_waitcnt vmcnt(" #n ")" ::: "memory")
#define PG8_WAIT_L(n) asm volatile("s_waitcnt lgkmcnt(" #n ")" ::: "memory")
#define PG8_BAR __builtin_amdgcn_s_barrier()
#define PG8_SCHED __builtin_amdgcn_sched_barrier(0)
    Unit cur, nxt; int ui = 0;
    if (!S.next(0, cur)) return;
    f32x4 acc[2][2][4][2];
#pragma unroll
    for (int a = 0; a < 2; ++a)
#pragma unroll
        for (int b = 0; b < 2; ++b)
#pragma unroll
            for (int m = 0; m < 4; ++m)
#pragma unroll
                for (int n = 0; n < 2; ++n) acc[a][b][m][n] = (f32x4){0.f, 0.f, 0.f, 0.f};
    bf16x8 At[4][2], B0[2][2], B1[2][2];
    const char* cA = (const char*)g.A + (size_t)cur.pm * tstep + (size_t)cur.kz * zstep; const char* cB = (const char*)g.Bt + (size_t)cur.pn * tstep + (size_t)cur.kz * zstep;
    S.a_ready(cur);
    if constexpr (SP2) {
        PG8_STAGE(PG8_SB(0, 0), cB, voffB); PG8_STAGE(PG8_SB(0, 1), cB + hstep, voffB); PG8_STAGE(PG8_SA(0, 0), cA, voffA); PG8_STAGE(PG8_SA(0, 1), cA + hstep, voffA);
        if (wr == 1) PG8_BAR;
        PG8_WAIT_V(2); PG8_BAR;
        PG8_STAGE(PG8_SB(1, 0), cB + kstep, voffB); PG8_STAGE(PG8_SA(1, 0), cA + kstep, voffA); PG8_STAGE(PG8_SB(1, 1), cB + hstep + kstep, voffB);
        PG8_WAIT_V(6); PG8_BAR;
    } else {
        PG8_STAGE(PG8_SB(0, 0), cB, voffB); PG8_STAGE(PG8_SA(0, 0), cA, voffA); PG8_STAGE(PG8_SB(0, 1), cB + hstep, voffB); PG8_STAGE(PG8_SA(0, 1), cA + hstep, voffA);
        if (wr == 1) PG8_BAR;
        PG8_WAIT_V(4); PG8_BAR;
        PG8_STAGE(PG8_SB(1, 0), cB + kstep, voffB); PG8_STAGE(PG8_SA(1, 0), cA + kstep, voffA); PG8_STAGE(PG8_SB(1, 1), cB + hstep + kstep, voffB);
        PG8_WAIT_V(6); PG8_BAR;
    }
    for (;;) {
        const bool has_next = S.next(ui + 1, nxt);
        const char* nA = has_next ? (const char*)g.A + (size_t)nxt.pm * tstep + (size_t)nxt.kz * zstep : cA; const char* nB = has_next ? (const char*)g.Bt + (size_t)nxt.pn * tstep + (size_t)nxt.kz * zstep : cB;
        for (int t = 0; t < nt; t += 2) {
            const bool last = (t == nt - 2);
            const char* a1 = cA + (size_t)(t + 1) * kstep;
            const char* a2 = last ? nA : cA + (size_t)(t + 2) * kstep; const char* b2 = last ? nB : cB + (size_t)(t + 2) * kstep;
            const char* a3 = a2 + kstep; const char* b3 = b2 + kstep;
            if (last && has_next) S.a_ready(nxt);
            if constexpr (SP2) {
            PG8_LDB(B0, 0, 0); PG8_LDB(B1, 0, 1); PG8_SCHED; PG8_LDA(At, 0, 0); PG8_STAGE(PG8_SA(1, 1), a1 + hstep, voffA);
            PG8_WAIT_V(8); PG8_WAIT_L(0); PG8_BAR; PG8_MMA(0, 0, At, B0); PG8_MMA(0, 1, At, B1); PG8_BAR; PG8_SCHED;
            PG8_LDA(At, 0, 1); PG8_STAGE(PG8_SB(0, 0), b2, voffB); PG8_STAGE(PG8_SB(0, 1), b2 + hstep, voffB); PG8_STAGE(PG8_SA(0, 0), a2, voffA);
            PG8_WAIT_V(8); PG8_WAIT_L(0); PG8_BAR; PG8_MMA(1, 0, At, B0); PG8_MMA(1, 1, At, B1); PG8_BAR; PG8_SCHED;
            PG8_LDB(B0, 1, 0); PG8_LDB(B1, 1, 1); PG8_SCHED; PG8_LDA(At, 1, 0); PG8_STAGE(PG8_SA(0, 1), a2 + hstep, voffA);
            PG8_WAIT_V(8); PG8_WAIT_L(0); PG8_BAR; PG8_MMA(0, 0, At, B0); PG8_MMA(0, 1, At, B1); PG8_BAR; PG8_SCHED;
            PG8_LDA(At, 1, 1); PG8_STAGE(PG8_SB(1, 0), b3, voffB); PG8_STAGE(PG8_SB(1, 1), b3 + hstep, voffB); PG8_STAGE(PG8_SA(1, 0), a3, voffA);
            PG8_WAIT_V(8); PG8_WAIT_L(0); PG8_BAR; PG8_MMA(1, 0, At, B0); PG8_MMA(1, 1, At, B1); PG8_BAR; PG8_SCHED;
            } else {
            PG8_LDB(B0, 0, 0); PG8_SCHED; PG8_LDA(At, 0, 0); PG8_STAGE(PG8_SA(1, 1), a1 + hstep, voffA);
            PG8_WAIT_L(8); PG8_BAR; PG8_WAIT_L(0); PG8_MMA(0, 0, At, B0); PG8_BAR; PG8_SCHED;
            PG8_LDB(B1, 0, 1); PG8_STAGE(PG8_SB(0, 0), b2, voffB);
            PG8_BAR; PG8_WAIT_L(0); PG8_MMA(0, 1, At, B1); PG8_BAR;
            PG8_LDA(At, 0, 1); PG8_STAGE(PG8_SA(0, 0), a2, voffA);
            PG8_BAR; PG8_WAIT_L(0); PG8_MMA(1, 0, At, B0); PG8_BAR; PG8_SCHED;
            PG8_STAGE(PG8_SB(0, 1), b2 + hstep, voffB);
            PG8_WAIT_V(6); PG8_BAR; PG8_MMA(1, 1, At, B1); PG8_BAR;
            PG8_LDB(B0, 1, 0); PG8_SCHED; PG8_LDA(At, 1, 0); PG8_STAGE(PG8_SA(0, 1), a2 + hstep, voffA);
            PG8_WAIT_L(8); PG8_BAR; PG8_WAIT_L(0); PG8_MMA(0, 0, At, B0); PG8_BAR; PG8_SCHED;
            PG8_LDB(B1, 1, 1); PG8_STAGE(PG8_SB(1, 0), b3, voffB);
            PG8_BAR; PG8_WAIT_L(0); PG8_MMA(0, 1, At, B1); PG8_BAR;
            PG8_LDA(At, 1, 1); PG8_STAGE(PG8_SA(1, 0), a3, voffA);
            PG8_BAR; PG8_WAIT_L(0); PG8_MMA(1, 0, At, B0); PG8_BAR; PG8_SCHED;
            PG8_STAGE(PG8_SB(1, 1), b3 + hstep, voffB);
            PG8_WAIT_V(6); PG8_BAR; PG8_MMA(1, 1, At, B1); PG8_BAR;
            }
        }
        if constexpr (ALIGN_EPI) { if (wr == 0) PG8_BAR; }
        if constexpr (!Epi::AFTER_DRAIN) { E(acc, cur, wr, wc, fr, fq); S.done(cur); }
        if (!has_next) break;
#pragma unroll
        for (int a = 0; a < 2; ++a)
#pragma unroll
            for (int b = 0; b < 2; ++b)
#pragma unroll
                for (int m = 0; m < 4; ++m)
#pragma unroll
                    for (int n = 0; n < 2; ++n) acc[a][b][m][n] = (f32x4){0.f, 0.f, 0.f, 0.f};
        cur = nxt; cA = nA; cB = nB; ++ui;
        if constexpr (ALIGN_EPI) { if (wr == 1) PG8_BAR; }
    }
    PG8_WAIT_V(0);
    if constexpr (!ALIGN_EPI) { if (wr == 0) PG8_BAR; }
    PG8_BAR;
    if constexpr (Epi::AFTER_DRAIN) { E.fused(acc, cur, wr, wc, fr, fq, lds, wid, lane); S.done(cur); }
#undef PG8_SA
#undef PG8_SB
#undef PG8_STAGE
#undef PG8_LDA
#undef PG8_LDB
#undef PG8_MMA
#undef PG8_WAIT_V
#undef PG8_WAIT_L
#undef PG8_BAR
#undef PG8_SCHED
}
}
namespace att {
typedef unsigned short bf16_t;
using bf16x8 = __attribute__((ext_vector_type(8))) short;
using s16x4  = __attribute__((ext_vector_type(4))) short;
using f32x16 = __attribute__((ext_vector_type(16))) float;
using u32x4  = __attribute__((ext_vector_type(4))) unsigned;
constexpr int NW = 8, QBLK = 32, KVBLK = 64;
constexpr int LDQ = 6144, LDO = 4096;
constexpr int SHM_V = KVBLK * 128 * 2, SHM_K = KVBLK * 64 * 2;
constexpr float THR = 8.f;
#define ASBAR() __builtin_amdgcn_sched_barrier(0)
__device__ __forceinline__ int crow(int r, int hi) { return (r & 3) + 8 * (r >> 2) + 4 * hi; }
__device__ __forceinline__ unsigned cvtpk(float lo, float hi) { unsigned r; asm volatile("v_cvt_pk_bf16_f32 %0, %1, %2" : "=v"(r) : "v"(lo), "v"(hi)); return r; }
template <bool FIRST = false> __device__ __forceinline__ void partialSM(f32x16& p0, f32x16& p1, float& m_reg, float& alpha, f32x16& negm) {
  float pmax = p0[0];
#pragma unroll
  for (int r = 1; r < 16; ++r) pmax = fmaxf(pmax, p0[r]);
#pragma unroll
  for (int r = 0; r < 16; ++r) pmax = fmaxf(pmax, p1[r]);
  { auto rr = __builtin_amdgcn_permlane32_swap(__float_as_uint(pmax), __float_as_uint(pmax), false, false);
    pmax = fmaxf(__uint_as_float(rr[0]), __uint_as_float(rr[1])); }
  if (!FIRST && __builtin_expect(__all(pmax <= THR), 1)) { alpha = 1.f; }
  else { const float dl = FIRST ? pmax : fmaxf(pmax, 0.f); m_reg += dl;
#pragma unroll
    for (int r = 0; r < 16; ++r) { p0[r] -= dl; p1[r] -= dl; }
#pragma unroll
    for (int r = 0; r < 16; ++r) negm[r] = -m_reg;
    asm volatile("" : "+v"(negm));
    alpha = __builtin_amdgcn_exp2f(-dl); }
#pragma unroll
  for (int r = 0; r < 16; ++r) p0[r] = __builtin_amdgcn_exp2f(p0[r]);
}
__device__ __forceinline__ void finishSM(f32x16& p0, f32x16& p1, float alpha, float& l_reg, bf16x8& pa0, bf16x8& pa1, bf16x8& pa2, bf16x8& pa3) {
#pragma unroll
  for (int r = 0; r < 16; ++r) p1[r] = __builtin_amdgcn_exp2f(p1[r]);
  float ps = 0;
#pragma unroll
  for (int r = 0; r < 16; ++r) ps += p0[r];
#pragma unroll
  for (int r = 0; r < 16; ++r) ps += p1[r];
  { auto rr = __builtin_amdgcn_permlane32_swap(__float_as_uint(ps), __float_as_uint(ps), false, false);
    ps = __uint_as_float(rr[0]) + __uint_as_float(rr[1]); }
  l_reg = l_reg * alpha + ps;
#define PK4(P, BASE, OUT) do { unsigned a0 = cvtpk(P[BASE + 0], P[BASE + 1]), a1 = cvtpk(P[BASE + 2], P[BASE + 3]);   \
    unsigned b0 = cvtpk(P[BASE + 4], P[BASE + 5]), b1 = cvtpk(P[BASE + 6], P[BASE + 7]);                              \
    auto r0 = __builtin_amdgcn_permlane32_swap(a0, b0, false, false); auto r1 = __builtin_amdgcn_permlane32_swap(a1, b1, false, false); \
    u32x4 w = {r0[0], r1[0], r0[1], r1[1]}; OUT = *reinterpret_cast<bf16x8*>(&w); } while (0)
  PK4(p0, 0, pa0); PK4(p0, 8, pa1); PK4(p1, 0, pa2); PK4(p1, 8, pa3);
#undef PK4
}
__device__ __forceinline__ int k_off(int key, int ch) { return ch * 1024 + (key << 4); }
__device__ __forceinline__ void kload8(bf16x8 (&kf)[8], const char* Ks, int r32, int hi) {
#pragma unroll
  for (int d0 = 0; d0 < 4; ++d0) { const int ch = 2 * d0 + hi;
    kf[2 * d0] = *reinterpret_cast<const bf16x8*>(Ks + k_off(r32, ch)); kf[2 * d0 + 1] = *reinterpret_cast<const bf16x8*>(Ks + k_off(32 + r32, ch)); }
}
__device__ __forceinline__ void qkt(f32x16& p0, f32x16& p1, const bf16x8 (&kf)[8], const bf16x8* qr, const f32x16& negm) {
  p0 = __builtin_amdgcn_mfma_f32_32x32x16_bf16(kf[0], qr[0], negm, 0, 0, 0); p1 = __builtin_amdgcn_mfma_f32_32x32x16_bf16(kf[1], qr[0], negm, 0, 0, 0);
  asm volatile("" :: "v"(kf[0]), "v"(kf[1]));
#pragma unroll
  for (int d0 = 1; d0 < 4; ++d0) { p0 = __builtin_amdgcn_mfma_f32_32x32x16_bf16(kf[2 * d0], qr[d0], p0, 0, 0, 0); p1 = __builtin_amdgcn_mfma_f32_32x32x16_bf16(kf[2 * d0 + 1], qr[d0], p1, 0, 0, 0); }
}
__device__ __forceinline__ int v_st(int k, int c) { const int kk = (k & ~0xC) | ((k & 4) << 1) | ((k & 8) >> 1); return ((kk >> 3) * 4 + (c >> 5)) * 512 + ((kk & 7) * 32 + (c & 31)) * 2; }
__device__ __forceinline__ int v_rd_base(int lane) { return ((lane & 3) << 3) | (((lane >> 2) & 3) << 6) | (((lane >> 4) & 1) << 5) | (((lane >> 5) & 1) << 8); }
constexpr int v_rd_off(int d0, int ks, int half) { return d0 * 512 + ks * 4096 + half * 2048; }
template <int OFF> __device__ __forceinline__ s16x4 tr_read(int vb) {
  s16x4 r; asm volatile("ds_read_b64_tr_b16 %0, %1 offset:%2" : "=&v"(r) : "v"(vb), "i"(OFF) : "memory"); return r;
}
template <int D0> __device__ __forceinline__ void pv_one(f32x16& od, int vb, bf16x8 pa0, bf16x8 pa1, bf16x8 pa2, bf16x8 pa3) {
  const s16x4 l0 = tr_read<v_rd_off(D0, 0, 0)>(vb), h0 = tr_read<v_rd_off(D0, 0, 1)>(vb), l1 = tr_read<v_rd_off(D0, 1, 0)>(vb), h1 = tr_read<v_rd_off(D0, 1, 1)>(vb);
  const s16x4 l2 = tr_read<v_rd_off(D0, 2, 0)>(vb), h2 = tr_read<v_rd_off(D0, 2, 1)>(vb), l3 = tr_read<v_rd_off(D0, 3, 0)>(vb), h3 = tr_read<v_rd_off(D0, 3, 1)>(vb);
  asm volatile("s_waitcnt lgkmcnt(0)" ::: "memory"); ASBAR();
#define PK(L, H) (bf16x8){L[0], L[1], L[2], L[3], H[0], H[1], H[2], H[3]}
  od = __builtin_amdgcn_mfma_f32_32x32x16_bf16(PK(l0, h0), pa0, od, 0, 0, 0);
  od = __builtin_amdgcn_mfma_f32_32x32x16_bf16(PK(l1, h1), pa1, od, 0, 0, 0);
  od = __builtin_amdgcn_mfma_f32_32x32x16_bf16(PK(l2, h2), pa2, od, 0, 0, 0);
  od = __builtin_amdgcn_mfma_f32_32x32x16_bf16(PK(l3, h3), pa3, od, 0, 0, 0);
#undef PK
}
__device__ __forceinline__ void pv_d0(f32x16* o, int vb, bf16x8 pa0, bf16x8 pa1, bf16x8 pa2, bf16x8 pa3) {
  pv_one<0>(o[0], vb, pa0, pa1, pa2, pa3); pv_one<1>(o[1], vb, pa0, pa1, pa2, pa3); pv_one<2>(o[2], vb, pa0, pa1, pa2, pa3); pv_one<3>(o[3], vb, pa0, pa1, pa2, pa3);
}
constexpr int NSLOT = 3, LDS_KR = 0, LDS_VR = NSLOT * SHM_K, LDS_WS = LDS_VR + NSLOT * SHM_V;
constexpr int SHM_ATTN = LDS_WS + NW * 64 * 4;
#define AT_LAS __attribute__((address_space(3)))
__device__ __forceinline__ void attn_unit(const bf16_t* __restrict__ QKV, bf16_t* __restrict__ OC, int qrow0, int qcol, int kcol, int vcol, int ocol,
                                          int lat0, int nlat, int ctx0, int NT, char* lds, int tid) {
  const int wid = __builtin_amdgcn_readfirstlane(tid >> 6), lane = tid & 63, r32 = lane & 31, hi = lane >> 5;
  char* K_lds = lds + LDS_KR; char* V_lds = lds + LDS_VR;
  float m_reg = 0.f, l_reg = 0; f32x16 o[4] = {}; f32x16 negm = {}; asm volatile("" : "+v"(negm)); bf16x8 qr[4];
  const unsigned voffK = (unsigned)(lane * LDQ + wid * 8) * 2u;
  unsigned voffV[2];
#pragma unroll
  for (int i = 0; i < 2; ++i) { const int p = 2 * wid + i, s = 2 * p + (lane >> 5), kk = (s >> 2) * 8 + ((lane & 31) >> 2), c = (s & 3) * 32 + (lane & 3) * 8;
    const int k = (kk & ~0xC) | ((kk & 4) << 1) | ((kk & 8) >> 1); voffV[i] = (unsigned)(k * LDQ + c) * 2u; }
#define TROW(j) ((j) < nlat ? lat0 + 64 * (j) : ctx0 + 64 * ((j) - nlat))
#define DMA_K(j) do { const char* tb_ = (const char*)QKV + (size_t)TROW(j) * (LDQ * 2) + kcol * 2; \
    __builtin_amdgcn_global_load_lds((const unsigned*)(tb_ + voffK), (AT_LAS unsigned*)(K_lds + ((j) % NSLOT) * SHM_K + wid * 1024), 16, 0, 0); } while (0)
#define DMA_V(j) do { const char* tb_ = (const char*)QKV + (size_t)TROW(j) * (LDQ * 2) + vcol * 2; \
    __builtin_amdgcn_global_load_lds((const unsigned*)(tb_ + voffV[0]), (AT_LAS unsigned*)(V_lds + ((j) % NSLOT) * SHM_V + (2 * wid) * 1024), 16, 0, 0); \
    __builtin_amdgcn_global_load_lds((const unsigned*)(tb_ + voffV[1]), (AT_LAS unsigned*)(V_lds + ((j) % NSLOT) * SHM_V + (2 * wid + 1) * 1024), 16, 0, 0); } while (0)
#define WAITBAR(N) asm volatile("s_waitcnt vmcnt(" #N ") lgkmcnt(0)\n\ts_barrier" ::: "memory")
#define RESC(a) do { if (__any((a) < 1.f)) { _Pragma("unroll") for (int d = 0; d < 4; ++d) _Pragma("unroll") for (int r = 0; r < 16; ++r) o[d][r] *= (a); } } while (0)
  DMA_K(0); DMA_V(0); DMA_K(1);
  const bf16_t* Qw = QKV + (size_t)(qrow0 + wid * QBLK + r32) * LDQ + qcol + hi * 8;
#pragma unroll
  for (int d0 = 0; d0 < 4; ++d0) qr[d0] = *reinterpret_cast<const bf16x8*>(Qw + d0 * 16);
  const int vb0 = (int)(uintptr_t)V_lds + v_rd_base(lane);
  f32x16 pA0, pA1, pB0, pB1; float alA, alB; bf16x8 pa0, pa1, pa2, pa3;
#define BAR_A(j) do { if ((j) + 2 < NT) { WAITBAR(3); DMA_K((j) + 2); } else { WAITBAR(0); } } while (0)
#define BAR_B(j) do { if ((j) + 2 < NT) { WAITBAR(3); } else { WAITBAR(0); } if ((j) + 1 < NT) DMA_V((j) + 1); } while (0)
  asm volatile("s_waitcnt vmcnt(0)" ::: "memory");
  if (wid >= 4) asm volatile("s_barrier" ::: "memory");
  WAITBAR(0); DMA_K(2);
  bf16x8 kf[8]; kload8(kf, K_lds, r32, hi); ASBAR(); qkt(pA0, pA1, kf, qr, negm); ASBAR();
  BAR_B(0);
  partialSM<true>(pA0, pA1, m_reg, alA, negm);
  int sk = 1, sv = 0;
#define ROT() do { sk = (sk == NSLOT - 1) ? 0 : sk + 1; sv = (sv == NSLOT - 1) ? 0 : sv + 1; } while (0)
  for (int j = 1; j + 1 < NT; j += 2) {
    BAR_A(j);
    kload8(kf, K_lds + sk * SHM_K, r32, hi); ASBAR(); qkt(pB0, pB1, kf, qr, negm);
    finishSM(pA0, pA1, alA, l_reg, pa0, pa1, pa2, pa3); ASBAR();
    BAR_B(j);
    pv_d0(o, vb0 + sv * SHM_V, pa0, pa1, pa2, pa3); partialSM(pB0, pB1, m_reg, alB, negm);
    RESC(alB); ROT();
    BAR_A(j + 1);
    kload8(kf, K_lds + sk * SHM_K, r32, hi); ASBAR(); qkt(pA0, pA1, kf, qr, negm);
    finishSM(pB0, pB1, alB, l_reg, pa0, pa1, pa2, pa3); ASBAR();
    BAR_B(j + 1);
    pv_d0(o, vb0 + sv * SHM_V, pa0, pa1, pa2, pa3); partialSM(pA0, pA1, m_reg, alA, negm);
    RESC(alA); ROT();
  }
  BAR_A(NT - 1);
  kload8(kf, K_lds + sk * SHM_K, r32, hi); ASBAR(); qkt(pB0, pB1, kf, qr, negm);
  finishSM(pA0, pA1, alA, l_reg, pa0, pa1, pa2, pa3); ASBAR();
  BAR_B(NT - 1);
  pv_d0(o, vb0 + sv * SHM_V, pa0, pa1, pa2, pa3); partialSM(pB0, pB1, m_reg, alB, negm);
  RESC(alB); ROT();
  finishSM(pB0, pB1, alB, l_reg, pa0, pa1, pa2, pa3); ASBAR();
  pv_d0(o, vb0 + sv * SHM_V, pa0, pa1, pa2, pa3);
  if (wid < 4) asm volatile("s_barrier" ::: "memory");
#undef BAR_A
#undef BAR_B
  const float rl = __builtin_amdgcn_rcpf(l_reg);
  bf16_t* Ow = OC + (size_t)(qrow0 + wid * QBLK + r32) * LDO + ocol + 8 * hi;
#pragma unroll
  for (int d0 = 0; d0 < 4; ++d0)
#pragma unroll
    for (int t = 0; t < 2; ++t) {
      const unsigned x0 = cvtpk(o[d0][8 * t + 0] * rl, o[d0][8 * t + 1] * rl), x1 = cvtpk(o[d0][8 * t + 2] * rl, o[d0][8 * t + 3] * rl);
      const unsigned y0 = cvtpk(o[d0][8 * t + 4] * rl, o[d0][8 * t + 5] * rl), y1 = cvtpk(o[d0][8 * t + 6] * rl, o[d0][8 * t + 7] * rl);
      auto s0 = __builtin_amdgcn_permlane32_swap(x0, y0, false, false); auto s1 = __builtin_amdgcn_permlane32_swap(x1, y1, false, false);
      u32x4 w = {s0[0], s1[0], s0[1], s1[1]};
      *reinterpret_cast<u32x4*>(Ow + d0 * 32 + 16 * t) = w; }
  WAITBAR(0);
#undef TROW
#undef DMA_K
#undef DMA_V
#undef WAITBAR
#undef ROT
#undef RESC
}
#undef ASBAR
}

constexpr int DM = 2048, BATCH = 2, SEQ = 8192, DEPTH = 4, CTXL = 256, FF = 5632;
constexpr int TLAT = BATCH * SEQ, TCTX = BATCH * CTXL, TT = TLAT + TCTX;
constexpr int NMOD = 9, MODW = NMOD * DM;
constexpr int S5W = 1024, S5H = 16, S5G = 64, S5P = 64, MIXIN = 4096, MIXOUT = 2048;
constexpr int NTC = (SEQ + CTXL) / 64;
constexpr float EPS = 1e-6f;
#ifndef NSUB
#define NSUB 12
#endif
#ifndef ONE_LAUNCH
#define ONE_LAUNCH 1
#endif

constexpr size_t MiB = 1u << 20;
constexpr size_t al(size_t x) { return (x + MiB - 1) / MiB * MiB; }
constexpr size_t WS_CTL = 0, CTL_ZERO_BYTES = 1 * MiB;
constexpr size_t WS_MOD   = WS_CTL + CTL_ZERO_BYTES;
constexpr size_t WS_ROPE  = WS_MOD + al((size_t)DEPTH * 3 * MODW * 4);
constexpr size_t WS_MODP  = WS_ROPE + MiB;
constexpr int    ADA_KC = 32;
constexpr size_t WS_SE    = WS_MODP + al((size_t)DEPTH * ADA_KC * 3 * MODW * 4);
constexpr size_t SCAN_BYTES = (size_t)BATCH * 2 * S5G * NTC * S5P * 8;
constexpr size_t WS_SC    = WS_SE + al(SCAN_BYTES);
constexpr size_t WS_WGU   = WS_SC + al(SCAN_BYTES);
constexpr size_t WGU_ONE  = (size_t)2 * FF * DM * 2;
constexpr size_t WS_WD    = WS_WGU + al(8 * WGU_ONE);
constexpr size_t WD_ONE   = (size_t)DM * FF * 2;
constexpr size_t WS_WIN   = WS_WD + al(8 * WD_ONE);
constexpr size_t WS_WOUT  = WS_WIN + al((size_t)2 * MIXIN * DM * 2);
constexpr size_t WS_WGLU  = WS_WOUT + al((size_t)2 * DM * MIXOUT * 2);
constexpr size_t WS_WQKV  = WS_WGLU + al((size_t)2 * S5W * S5W * 2);
constexpr size_t WS_WO    = WS_WQKV + al((size_t)2 * 3 * DM * DM * 2);
constexpr size_t WS_X     = WS_WO + al((size_t)2 * DM * DM * 2);
constexpr size_t WS_H     = WS_X + al((size_t)TT * DM * 4);
constexpr size_t WS_Y     = WS_H + al((size_t)TT * DM * 2);
constexpr size_t WS_BIG   = WS_Y + al((size_t)TT * DM * 2);
constexpr size_t WS_Z     = WS_BIG + al((size_t)TT * 6144 * 2);
constexpr size_t WS_MIXA  = WS_Z + al((size_t)TT * S5W * 2);
constexpr size_t WS_OC    = WS_MIXA + al((size_t)TT * DM * 2);
constexpr size_t WS_PART  = WS_OC + al((size_t)TT * 4096 * 2);
constexpr int    NZ_DOWN = 4, NZ_OUT = 4;
constexpr size_t WS_END   = WS_PART + al((size_t)11 * TCTX * DM * 4);

constexpr int CW_BAR = 4096;
constexpr int CW_HOST = 16384;

constexpr int SCRATCH_BYTES = 143360;
constexpr int LDSCTL_OFF = SCRATCH_BYTES, MISC_OFF = LDSCTL_OFF + 320;
constexpr int LDS_BYTES = 147456;
static_assert(pg8::STAGE_BYTES <= SCRATCH_BYTES && att::SHM_ATTN <= SCRATCH_BYTES && MISC_OFF + 128 <= LDS_BYTES, "LDS map");

#define GAS __attribute__((address_space(1)))
#define LAS __attribute__((address_space(3)))
typedef unsigned short bf16;
typedef unsigned v4u __attribute__((ext_vector_type(4)));
typedef float f32x4 __attribute__((ext_vector_type(4)));
typedef float f32x16 __attribute__((ext_vector_type(16)));
typedef short bf16x8 __attribute__((ext_vector_type(8)));
#define LDS_WAIT() asm volatile("s_waitcnt lgkmcnt(0)" ::: "memory")
#define VM_WAIT() asm volatile("s_waitcnt vmcnt(0)" ::: "memory")
__device__ __forceinline__ unsigned pk2(float lo, float hi) { unsigned r; asm volatile("v_cvt_pk_bf16_f32 %0, %1, %2" : "=v"(r) : "v"(lo), "v"(hi)); return r; }
typedef _Float16 h16x2 __attribute__((ext_vector_type(2)));
__device__ __forceinline__ unsigned pkh2(float lo, float hi) { const float L = 65504.f; h16x2 v = {(_Float16)__builtin_fminf(__builtin_fmaxf(lo, -L), L), (_Float16)__builtin_fminf(__builtin_fmaxf(hi, -L), L)}; return __builtin_bit_cast(unsigned, v); }
__device__ __forceinline__ float hlo(unsigned w) { return (float)__builtin_bit_cast(h16x2, w)[0]; }
__device__ __forceinline__ float hhi(unsigned w) { return (float)__builtin_bit_cast(h16x2, w)[1]; }
__device__ __forceinline__ float bflo(unsigned w) { return __uint_as_float(w << 16); }
__device__ __forceinline__ float bfhi(unsigned w) { return __uint_as_float(w & 0xffff0000u); }
__device__ __forceinline__ float wave_sum(float v) {
#pragma unroll
    for (int o = 1; o < 64; o <<= 1) v += __shfl_xor(v, o);
    return v;
}
#define XB_TMO      128
#define XB_XCNT(j)  (256  + 64 * (j))
#define XB_XSUB(j)  (1280 + 64 * (j))
#define XB_XGEN(j)  (2304 + 64 * (j))
#define XB_TOP      3328
#define XB_TOPGEN   3392
#define XCD_BAR_WORDS 3456
#define XB_SPIN_CAP (1u << 18)

__device__ __forceinline__ unsigned xb_ld(unsigned* p)              { return __hip_atomic_load(p, __ATOMIC_RELAXED, __HIP_MEMORY_SCOPE_AGENT); }
__device__ __forceinline__ unsigned xb_add(unsigned* p, unsigned v) { return __hip_atomic_fetch_add(p, v, __ATOMIC_RELAXED, __HIP_MEMORY_SCOPE_AGENT); }
__device__ __forceinline__ unsigned xb_xcc_id() { return (unsigned)__builtin_amdgcn_s_getreg((3 << 11) | 20) & 0xFu; }
#define XB_SPIN(cond, bar) do { unsigned _sp = 0; while (cond) { __builtin_amdgcn_s_sleep(1); \
    if ((++_sp & 255u) == 0u) { if (xb_ld(&(bar)[XB_TMO])) break; if (_sp > XB_SPIN_CAP) { atomicAdd(&(bar)[XB_TMO], 1u); break; } } } } while (0)

struct XcdBarrier {
    unsigned* bar; unsigned x;
    volatile LAS unsigned* st;
};

__device__ __forceinline__ XcdBarrier xcd_barrier_post(unsigned* bar, volatile LAS unsigned* st) {
    XcdBarrier b; b.bar = bar; b.x = xb_xcc_id(); b.st = st;
    if (threadIdx.x == 0) (void)xb_add(&bar[XB_XCNT(b.x)], 1u);
    return b;
}
__device__ __forceinline__ void xcd_barrier_complete(unsigned* bar, unsigned x, unsigned& nloc, unsigned& nx) {
    const unsigned G = gridDim.x * gridDim.y * gridDim.z;
    unsigned sum, cnt, mine, sp = 0u;
    for (;;) {
        sum = 0u; cnt = 0u; mine = 0u;
#pragma unroll
        for (unsigned j = 0; j < 16; ++j) { const unsigned c = xb_ld(&bar[XB_XCNT(j)]); sum += c; cnt += (c > 0u) ? 1u : 0u; mine = (j == x) ? c : mine; }
        if (sum == G) break;
        __builtin_amdgcn_s_sleep(1);
        if ((++sp & 255u) == 0u) { if (xb_ld(&bar[XB_TMO])) break; if (sp > XB_SPIN_CAP) { atomicAdd(&bar[XB_TMO], 1u); break; } }
    }
    nloc = mine > 0u ? mine : 1u; nx = cnt > 0u ? cnt : 1u;
}

__device__ __forceinline__ void xcd_barrier(const XcdBarrier& b) {
    asm volatile("s_waitcnt vmcnt(0)" ::: "memory");
    __syncthreads();
    if (threadIdx.x == 0) {
        unsigned* bar = b.bar;
        __builtin_amdgcn_s_waitcnt(0);
        unsigned nloc = b.st[0], nx = b.st[1];
        if (nloc == 0u) { xcd_barrier_complete(bar, b.x, nloc, nx); b.st[0] = nloc; b.st[1] = nx; }
        const unsigned old = xb_add(&bar[XB_XSUB(b.x)], 1u);
        const unsigned gen = old / nloc;
        if (old + 1u == (gen + 1u) * nloc) {
            __builtin_amdgcn_fence(__ATOMIC_RELEASE, "agent");
            asm volatile("s_waitcnt vmcnt(0)" ::: "memory");
            const unsigned og = xb_add(&bar[XB_TOP], 1u);
            const unsigned tg = og / nx;
            if (og + 1u == (tg + 1u) * nx) xb_add(&bar[XB_TOPGEN], 1u);
            else XB_SPIN(xb_ld(&bar[XB_TOPGEN]) == tg, bar);
            __builtin_amdgcn_fence(__ATOMIC_ACQUIRE, "agent");
            xb_add(&bar[XB_XGEN(b.x)], 1u);
            asm volatile("s_waitcnt vmcnt(0)" ::: "memory");
        } else {
            XB_SPIN(xb_ld(&bar[XB_XGEN(b.x)]) == gen, bar);
            __builtin_amdgcn_fence(__ATOMIC_ACQUIRE, "agent");
            asm volatile("s_waitcnt vmcnt(0)" ::: "memory");
        }
    }
    __syncthreads();
}
constexpr int NWAVES = 8;
struct Args { const float* in[28]; float* out; unsigned char* ws; int ph_lo, ph_hi; };
struct Frame {
    const Args& A;
    LAS unsigned char* lds;
    int tid, lane, wave, vcu, G;
    float* out; unsigned char* ws;
};
#define WSP(T, off) ((T*)(F.ws + (off)))

template <int MAP> __device__ __forceinline__ int rowmap(int n) {
    if (MAP == 1) return ((n >> 7) << 8) + (n & 127);
    if (MAP == 2) return ((n >> 7) << 8) + 128 + (n & 127);
    if (MAP == 3) { if (n >= 4096) return n; const int i = n & 255, beta = i >> 6, d = i & 63; return (n & ~255) + (d < 32 ? 32 * beta + d : 128 + 32 * beta + (d - 32)); }
    return n;
}
template <int MAP> __device__ __forceinline__ void transpose_item(const float* W, int K, int N, bf16* WT, LAS float* scr, int item, int lane) {
    const int nblk = N / 32, kb = item / nblk, nb = item % nblk, k0 = 64 * kb, n0 = 32 * nb;
#pragma unroll 8
    for (int i = 0; i < 32; ++i) { const int kk = 2 * i + (lane >> 5); scr[kk * 33 + (lane & 31)] = W[(size_t)(k0 + kk) * N + n0 + (lane & 31)]; }
    LDS_WAIT(); asm volatile("" ::: "memory");
    const int c = lane & 7;
#pragma unroll
    for (int j = 0; j < 4; ++j) { const int n = (lane >> 3) + 8 * j; const LAS float* s = scr + (8 * c) * 33 + n;
        v4u o; o.x = pk2(s[0 * 33], s[1 * 33]); o.y = pk2(s[2 * 33], s[3 * 33]); o.z = pk2(s[4 * 33], s[5 * 33]); o.w = pk2(s[6 * 33], s[7 * 33]);
        *(GAS v4u*)(WT + (size_t)rowmap<MAP>(n0 + n) * K + k0 + 8 * c) = o; }
    LDS_WAIT(); asm volatile("" ::: "memory");
}
__device__ __forceinline__ float silu_f(float v) { return v / (1.0f + __expf(-v)); }

__device__ __forceinline__ void p0_prologue(Frame& F) {
    const int gw = F.vcu * NWAVES + F.wave, NGW = F.G * NWAVES;
    LAS float* sv = (LAS float*)(F.lds + 8 * 8704);
    for (int i = F.tid; i < 3 * DM; i += NWAVES * 64) { const int v = i / DM, k = i % DM; sv[i] = silu_f(v < 2 ? F.A.in[1][v * DM + k] : F.A.in[3][k]); }
    { const int gt = (F.vcu * NWAVES * 64) + F.tid; if (gt < 128 * 16) { const int pos = gt >> 4, j = gt & 15; const float fr = powf(10000.0f, -(float)j / 16.0f); const float ang = (float)pos * fr;
            float* cs = WSP(float, WS_ROPE); cs[2 * gt] = cosf(ang); cs[2 * gt + 1] = sinf(ang); } }
    __syncthreads();
    { float* part = WSP(float, WS_MODP);
      constexpr int NCB = MODW / 256, NU = DEPTH * ADA_KC * NCB;
      for (int u = gw; u < NU; u += NGW) { const int cb = u % NCB, kc = (u / NCB) % ADA_KC, l = u / (NCB * ADA_KC);
          const float* W = F.A.in[4] + ((size_t)l * DM + kc * 64) * MODW + cb * 256 + F.lane * 4;
          f32x4 a0 = {0, 0, 0, 0}, a1 = a0, a2 = a0;
#pragma unroll 8
          for (int k = 0; k < 64; ++k) { const f32x4 w = *(const f32x4*)(W + (size_t)k * MODW); const int kk = kc * 64 + k;
              a0 += w * sv[kk]; a1 += w * sv[DM + kk]; a2 += w * sv[2 * DM + kk]; }
          float* o = part + ((size_t)(l * ADA_KC + kc) * 3) * MODW + cb * 256 + F.lane * 4;
          *(f32x4*)o = a0; *(f32x4*)(o + MODW) = a1; *(f32x4*)(o + 2 * MODW) = a2; } }
    LAS float* scr = (LAS float*)(F.lds + F.wave * 8704);
    constexpr int I_FF = (DM / 64) * (FF / 32);
    constexpr int I_IN = (DM / 64) * (MIXIN / 32), I_OUT = (MIXOUT / 64) * (DM / 32), I_GLU = (S5W / 64) * (S5W / 32), I_QKV = (DM / 64) * (3 * DM / 32), I_O = (DM / 64) * (DM / 32);
    constexpr int N_FFN = 24 * I_FF, N_EV = I_IN + I_OUT + I_GLU, N_OD = I_QKV + I_O, NITEMS = N_FFN + 2 * N_EV + 2 * N_OD;
    for (int it = gw; it < NITEMS; it += NGW) {
        int r = it;
        if (r < N_FFN) { const int q = r / I_FF, item = r % I_FF, lh = q / 3, kind = q % 3;
            if (kind == 0) transpose_item<1>(F.A.in[7] + (size_t)lh * DM * FF, DM, FF, WSP(bf16, WS_WGU + lh * WGU_ONE), scr, item, F.lane);
            else if (kind == 1) transpose_item<2>(F.A.in[8] + (size_t)lh * DM * FF, DM, FF, WSP(bf16, WS_WGU + lh * WGU_ONE), scr, item, F.lane);
            else transpose_item<0>(F.A.in[9] + (size_t)lh * FF * DM, FF, DM, WSP(bf16, WS_WD + lh * WD_ONE), scr, item, F.lane);
            continue; }
        r -= N_FFN;
        if (r < 2 * N_EV) { const int i = r / N_EV; r %= N_EV;
            if (r < I_IN) { transpose_item<0>(F.A.in[10] + (size_t)i * DM * MIXIN, DM, MIXIN, WSP(bf16, WS_WIN + (size_t)i * MIXIN * DM * 2), scr, r, F.lane); continue; } r -= I_IN;
            if (r < I_OUT) { transpose_item<0>(F.A.in[11] + (size_t)i * MIXOUT * DM, MIXOUT, DM, WSP(bf16, WS_WOUT + (size_t)i * DM * MIXOUT * 2), scr, r, F.lane); continue; } r -= I_OUT;
            transpose_item<0>(F.A.in[20] + (size_t)i * S5W * S5W, S5W, S5W, WSP(bf16, WS_WGLU + (size_t)i * S5W * S5W * 2), scr, r, F.lane); continue; }
        r -= 2 * N_EV;
        { const int i = r / N_OD; r %= N_OD;
            if (r < I_QKV) { transpose_item<3>(F.A.in[24] + (size_t)i * DM * 3 * DM, DM, 3 * DM, WSP(bf16, WS_WQKV + (size_t)i * 3 * DM * DM * 2), scr, r, F.lane); continue; } r -= I_QKV;
            transpose_item<0>(F.A.in[25] + (size_t)i * DM * DM, DM, DM, WSP(bf16, WS_WO + (size_t)i * DM * DM * 2), scr, r, F.lane); }
    }
}
__device__ __forceinline__ void p1_ada_reduce(Frame& F) {
    const float* part = WSP(float, WS_MODP); float* mod = WSP(float, WS_MOD);
    const int gt = F.vcu * NWAVES * 64 + F.tid, NGT = F.G * NWAVES * 64;
    for (int i = gt; i < DEPTH * 3 * MODW; i += NGT) { const int n = i % MODW, v = (i / MODW) % 3, l = i / (3 * MODW);
        float s = F.A.in[5][l * MODW + n];
#pragma unroll 8
        for (int kc = 0; kc < ADA_KC; ++kc) s += part[((size_t)(l * ADA_KC + kc) * 3 + v) * MODW + n];
        mod[i] = s; }
}

__device__ __forceinline__ void host_arrive(unsigned* cnt) {
    VM_WAIT(); __syncthreads();
    if (threadIdx.x == 0) { __builtin_amdgcn_fence(__ATOMIC_RELEASE, "agent"); VM_WAIT(); (void)__hip_atomic_fetch_add(cnt, 1u, __ATOMIC_RELAXED, __HIP_MEMORY_SCOPE_AGENT); }
}
__device__ __forceinline__ void host_wait(unsigned* cnt, unsigned want) {
    if (threadIdx.x == 0) { unsigned sp = 0; while (__hip_atomic_load(cnt, __ATOMIC_RELAXED, __HIP_MEMORY_SCOPE_AGENT) < want) { __builtin_amdgcn_s_sleep(4); if (++sp > (1u << 22)) break; }
        __builtin_amdgcn_fence(__ATOMIC_ACQUIRE, "agent"); VM_WAIT(); }
    __syncthreads();
}
__device__ __forceinline__ void resid_norm_phase(Frame& F, int sub, int nctx = TCTX, bool dry = false) {
    LAS float* vA = (LAS float*)F.lds; LAS float* vB = vA + 3 * DM; LAS float* vC = vB + 3 * DM;
    const float* mod = WSP(float, WS_MOD);
    const bool has_y = sub >= 0, from_input = sub <= 0, last = (sub == NSUB - 1), write_h = !last;
    const int nsub = sub + 1, nl = nsub / 3, ns = nsub % 3;
    for (int i = F.tid; i < 3 * DM; i += NWAVES * 64) { const int v = i / DM, c = i % DM;
        if (has_y) { const int l = sub / 3, s = sub % 3; const float wgt = (s == 1) ? 1.0f : 0.5f;
            vA[i] = wgt * mod[((size_t)(l * 3 + v) * NMOD + 3 * s + 2) * DM + c] * F.A.in[6][((size_t)l * 6 + 2 * s + 1) * DM + c]; }
        if (write_h) { vB[i] = F.A.in[6][((size_t)nl * 6 + 2 * ns) * DM + c] * (1.0f + mod[((size_t)(nl * 3 + v) * NMOD + 3 * ns + 1) * DM + c]);
            vC[i] = mod[((size_t)(nl * 3 + v) * NMOD + 3 * ns) * DM + c]; } }
    __syncthreads();
    const bf16* Y = WSP(bf16, WS_Y); const bf16* X = WSP(bf16, WS_X); bf16* Xd = dry ? WSP(bf16, WS_OC) : WSP(bf16, WS_X); bf16* H = dry ? WSP(bf16, WS_MIXA) : WSP(bf16, WS_H); float* outd = dry ? WSP(float, WS_OC) : F.out;
    const int lp = (TLAT + F.G - 1) / F.G, cp = (TCTX + F.G - 1) / F.G;
    const int l0 = blockIdx.x * lp, l1 = (l0 + lp < TLAT) ? l0 + lp : TLAT, nl_ = l1 > l0 ? l1 - l0 : 0;
    const int c0 = blockIdx.x * cp, c1 = (c0 + cp < nctx) ? c0 + cp : nctx, nc_ = c1 > c0 ? c1 - c0 : 0;
    for (int j = F.wave; j < nl_ + nc_; j += NWAVES) {
        const int row = j < nl_ ? l0 + j : TLAT + c0 + (j - nl_);
        const int v = row < SEQ ? 0 : (row < TLAT ? 1 : 2);
        f32x4 xv[4][2];
        if (from_input) {
            const float* xs = row < TLAT ? F.A.in[0] + (size_t)row * DM : F.A.in[2] + (size_t)(row - TLAT) * DM;
#pragma unroll
            for (int i = 0; i < 4; ++i) { const f32x4* p = (const f32x4*)(xs + i * 512 + F.lane * 8); xv[i][0] = p[0]; xv[i][1] = p[1]; }
        } else {
            v4u xw[4];
#pragma unroll
            for (int i = 0; i < 4; ++i) xw[i] = *(const v4u*)(X + (size_t)row * DM + i * 512 + F.lane * 8);
#pragma unroll
            for (int i = 0; i < 4; ++i) { xv[i][0] = (f32x4){hlo(xw[i].x), hhi(xw[i].x), hlo(xw[i].y), hhi(xw[i].y)}; xv[i][1] = (f32x4){hlo(xw[i].z), hhi(xw[i].z), hlo(xw[i].w), hhi(xw[i].w)}; }
        }
        if (has_y) {
            float ss = 0.f; f32x4 yv[4][2];
            if (row < TLAT) {
                v4u yw[4];
#pragma unroll
                for (int i = 0; i < 4; ++i) yw[i] = *(const v4u*)(Y + (size_t)row * DM + i * 512 + F.lane * 8);
#pragma unroll
                for (int i = 0; i < 4; ++i) { yv[i][0] = (f32x4){bflo(yw[i].x), bfhi(yw[i].x), bflo(yw[i].y), bfhi(yw[i].y)}; yv[i][1] = (f32x4){bflo(yw[i].z), bfhi(yw[i].z), bflo(yw[i].w), bfhi(yw[i].w)}; }
            } else {
                const int nz = (sub % 3 == 1) ? NZ_OUT : NZ_DOWN; const float* pp = WSP(const float, WS_PART) + (size_t)(row - TLAT) * DM + F.lane * 8;
#pragma unroll
                for (int i = 0; i < 4; ++i) { yv[i][0] = (f32x4){0.f, 0.f, 0.f, 0.f}; yv[i][1] = yv[i][0]; }
#pragma unroll 4
                for (int z = 0; z < nz; ++z) { const float* pz = pp + (size_t)z * TCTX * DM;
#pragma unroll
                    for (int i = 0; i < 4; ++i) { yv[i][0] += *(const f32x4*)(pz + i * 512); yv[i][1] += *(const f32x4*)(pz + i * 512 + 4); } }
            }
#pragma unroll
            for (int i = 0; i < 4; ++i)
#pragma unroll
                for (int h = 0; h < 2; ++h) ss += (yv[i][h][0] * yv[i][h][0] + yv[i][h][1] * yv[i][h][1]) + (yv[i][h][2] * yv[i][h][2] + yv[i][h][3] * yv[i][h][3]);
            const float r = rsqrtf(wave_sum(ss) * (1.0f / DM) + EPS);
#pragma unroll
            for (int i = 0; i < 4; ++i)
#pragma unroll
                for (int h = 0; h < 2; ++h) { const f32x4 a = *(const LAS f32x4*)(vA + v * DM + i * 512 + F.lane * 8 + 4 * h); xv[i][h] += a * (yv[i][h] * r); }
            if (!last) {
#pragma unroll
                for (int i = 0; i < 4; ++i) { v4u w; w.x = pkh2(xv[i][0][0], xv[i][0][1]); w.y = pkh2(xv[i][0][2], xv[i][0][3]); w.z = pkh2(xv[i][1][0], xv[i][1][1]); w.w = pkh2(xv[i][1][2], xv[i][1][3]);
                    *(v4u*)(Xd + (size_t)row * DM + i * 512 + F.lane * 8) = w; }
            } else if (row < TLAT) {
#pragma unroll
                for (int i = 0; i < 4; ++i) { f32x4* p = (f32x4*)(outd + (size_t)row * DM + i * 512 + F.lane * 8); p[0] = xv[i][0]; p[1] = xv[i][1]; }
            }
        }
        if (write_h) {
            float ss = 0.f;
#pragma unroll
            for (int i = 0; i < 4; ++i)
#pragma unroll
                for (int h = 0; h < 2; ++h) ss += (xv[i][h][0] * xv[i][h][0] + xv[i][h][1] * xv[i][h][1]) + (xv[i][h][2] * xv[i][h][2] + xv[i][h][3] * xv[i][h][3]);
            const float r = rsqrtf(wave_sum(ss) * (1.0f / DM) + EPS);
#pragma unroll
            for (int i = 0; i < 4; ++i) { f32x4 o[2];
#pragma unroll
                for (int h = 0; h < 2; ++h) { const f32x4 b = *(const LAS f32x4*)(vB + v * DM + i * 512 + F.lane * 8 + 4 * h), c = *(const LAS f32x4*)(vC + v * DM + i * 512 + F.lane * 8 + 4 * h); o[h] = (xv[i][h] * r) * b + c; }
                v4u w; w.x = pk2(o[0][0], o[0][1]); w.y = pk2(o[0][2], o[0][3]); w.z = pk2(o[1][0], o[1][1]); w.w = pk2(o[1][2], o[1][3]);
                *(v4u*)(H + (size_t)row * DM + i * 512 + F.lane * 8) = w; }
        }
    }
}

namespace s5 {
struct Par { float a_re, a_im; bf16x8 Bre1, Bim1, Bre2, Bim2; };
__device__ __forceinline__ void discretize(float lre, float lim, float dt, float& a_re, float& a_im, float& co_re, float& co_im) {
    const float mag = expf(lre * dt); float sn, cn; sincosf(lim * dt, &sn, &cn);
    a_re = mag * cn; a_im = mag * sn;
    const float inv = 1.0f / (lre * lre + lim * lim);
    co_re = ((a_re - 1.0f) * lre + a_im * lim) * inv; co_im = (a_im * lre - (a_re - 1.0f) * lim) * inv;
}
__device__ __forceinline__ void load_par(const Args& in, int ei, int dir, int g, int lane, Par& P) {
    const int base = (ei * 2 + dir) * S5G + g; const float dt = expf(in.in[14][base]);
    const int r32 = lane & 31, hi = lane >> 5;
    { float cr, ci; discretize(in.in[12][base * S5P + lane], in.in[13][base * S5P + lane], dt, P.a_re, P.a_im, cr, ci); }
#pragma unroll
    for (int q = 0; q < 2; ++q) { const int p = q * 32 + r32; float ar, ai, cr, ci; discretize(in.in[12][base * S5P + p], in.in[13][base * S5P + p], dt, ar, ai, cr, ci);
        const f32x4* br = (const f32x4*)(in.in[15] + ((size_t)base * S5P + p) * S5H + 8 * hi); const f32x4* bi = (const f32x4*)(in.in[16] + ((size_t)base * S5P + p) * S5H + 8 * hi);
        const f32x4 r0 = br[0], r1 = br[1], i0 = bi[0], i1 = bi[1];
        const f32x4 xr0 = r0 * cr - i0 * ci, xr1 = r1 * cr - i1 * ci, xi0 = i0 * cr + r0 * ci, xi1 = i1 * cr + r1 * ci;
        v4u wr, wi; wr.x = pk2(xr0[0], xr0[1]); wr.y = pk2(xr0[2], xr0[3]); wr.z = pk2(xr1[0], xr1[1]); wr.w = pk2(xr1[2], xr1[3]);
        wi.x = pk2(xi0[0], xi0[1]); wi.y = pk2(xi0[2], xi0[3]); wi.z = pk2(xi1[0], xi1[1]); wi.w = pk2(xi1[2], xi1[3]);
        if (q == 0) { P.Bre1 = __builtin_bit_cast(bf16x8, wr); P.Bim1 = __builtin_bit_cast(bf16x8, wi); } else { P.Bre2 = __builtin_bit_cast(bf16x8, wr); P.Bim2 = __builtin_bit_cast(bf16x8, wi); } }
}
constexpr size_t TAB_B = 0, TAB_A = 128 * 4 * 64 * 16, TAB_C = TAB_A + 128 * 64 * 8, TAB_END = TAB_C + 128 * 4 * 64 * 16;
__device__ __forceinline__ void cfrags(const Args& in, int ei, int dir, int g, int lane, bf16x8 (&C)[4]) {
    const int fr = lane & 15, kq = lane >> 4;
#pragma unroll
    for (int ks = 0; ks < 4; ++ks) { const size_t o = ((size_t)((ei * 2 + dir) * S5G + g) * S5H + fr) * S5P + 16 * ks + 4 * kq;
        const f32x4 cr = *(const f32x4*)(in.in[17] + o), ci = *(const f32x4*)(in.in[18] + o);
        v4u w; w.x = pk2(cr[0], -ci[0]); w.y = pk2(cr[1], -ci[1]); w.z = pk2(cr[2], -ci[2]); w.w = pk2(cr[3], -ci[3]);
        C[ks] = __builtin_bit_cast(bf16x8, w); }
}
__device__ __forceinline__ void table_store(unsigned char* tab, int dg, int lane, const Par& P, const bf16x8 (&C)[4]) {
    v4u* tb = (v4u*)(tab + TAB_B) + (size_t)dg * 256 + lane; tb[0] = __builtin_bit_cast(v4u, P.Bre1); tb[64] = __builtin_bit_cast(v4u, P.Bim1); tb[128] = __builtin_bit_cast(v4u, P.Bre2); tb[192] = __builtin_bit_cast(v4u, P.Bim2);
    ((float2*)(tab + TAB_A))[dg * 64 + lane] = make_float2(P.a_re, P.a_im);
    v4u* tc = (v4u*)(tab + TAB_C) + (size_t)dg * 256 + lane;
#pragma unroll
    for (int ks = 0; ks < 4; ++ks) tc[64 * ks] = __builtin_bit_cast(v4u, C[ks]);
}
__device__ __forceinline__ void table_load(const unsigned char* tab, int dg, int lane, Par& P, bf16x8 (&C)[4]) {
    const v4u* tb = (const v4u*)(tab + TAB_B) + (size_t)dg * 256 + lane; P.Bre1 = __builtin_bit_cast(bf16x8, tb[0]); P.Bim1 = __builtin_bit_cast(bf16x8, tb[64]); P.Bre2 = __builtin_bit_cast(bf16x8, tb[128]); P.Bim2 = __builtin_bit_cast(bf16x8, tb[192]);
    const float2 a = ((const float2*)(tab + TAB_A))[dg * 64 + lane]; P.a_re = a.x; P.a_im = a.y;
    const v4u* tc = (const v4u*)(tab + TAB_C) + (size_t)dg * 256 + lane;
#pragma unroll
    for (int ks = 0; ks < 4; ++ks) C[ks] = __builtin_bit_cast(bf16x8, tc[64 * ks]);
}
__device__ __forceinline__ int chunk_row0(int b, int tc) { return tc < 128 ? b * SEQ + 64 * tc : TLAT + b * CTXL + 64 * (tc - 128); }
__device__ __forceinline__ void load_chunk(const bf16* U, int row0, int g, int dir, int lane, bf16x8 (&A2)[2]) {
    const int r32 = lane & 31, hi = lane >> 5;
#pragma unroll
    for (int blk = 0; blk < 2; ++blk) { const int i = 32 * blk + r32, tok = dir ? 63 - i : i; A2[blk] = *(const bf16x8*)(U + (size_t)(row0 + tok) * MIXIN + g * S5H + 8 * hi); }
}
template <bool WRITE_H> __device__ __forceinline__ void run_chunk_pre(const Par& P, const bf16x8 (&A2)[2], int dir, int lane, float& sre, float& sim, LAS unsigned* Hbuf) {
#pragma unroll
    for (int blk = 0; blk < 2; ++blk) {
        const bf16x8 A = A2[blk];
        f32x16 G1r, G1i, G2r, G2i;
        asm volatile("s_nop 1\n\tv_mfma_f32_32x32x16_bf16 %0, %4, %5, 0\n\tv_mfma_f32_32x32x16_bf16 %1, %4, %6, 0\n\tv_mfma_f32_32x32x16_bf16 %2, %4, %7, 0\n\tv_mfma_f32_32x32x16_bf16 %3, %4, %8, 0\n\ts_nop 15"
                     : "=&v"(G1r), "=&v"(G1i), "=&v"(G2r), "=&v"(G2i) : "v"(A), "v"(P.Bre1), "v"(P.Bim1), "v"(P.Bre2), "v"(P.Bim2));
#pragma unroll
        for (int r = 0; r < 16; ++r) {
            auto sr = __builtin_amdgcn_permlane32_swap(__float_as_uint(G1r[r]), __float_as_uint(G2r[r]), false, false); G1r[r] = __uint_as_float(sr[0]); G2r[r] = __uint_as_float(sr[1]);
            auto si = __builtin_amdgcn_permlane32_swap(__float_as_uint(G1i[r]), __float_as_uint(G2i[r]), false, false); G1i[r] = __uint_as_float(si[0]); G2i[r] = __uint_as_float(si[1]); }
#define S5_STEP(XR, XI, STEPI) do { const float nr = fmaf(-P.a_im, sim, fmaf(P.a_re, sre, (XR))); const float ni = fmaf(P.a_im, sre, fmaf(P.a_re, sim, (XI))); sre = nr; sim = ni; \
        if (WRITE_H) { const int st_ = 32 * blk + (STEPI); const int tk_ = dir ? 63 - st_ : st_; Hbuf[tk_ * 68 + lane] = pk2(sre, sim); } } while (0)
#pragma unroll
        for (int j = 0; j < 4; ++j) {
#pragma unroll
            for (int q = 0; q < 4; ++q) S5_STEP(G1r[4 * j + q], G1i[4 * j + q], 8 * j + q);
#pragma unroll
            for (int q = 0; q < 4; ++q) S5_STEP(G2r[4 * j + q], G2i[4 * j + q], 8 * j + 4 + q);
        }
#undef S5_STEP
    }
}
template <bool WRITE_H> __device__ __forceinline__ void run_chunk(const Par& P, const bf16* U, int row0, int g, int dir, int lane, float& sre, float& sim, LAS unsigned* Hbuf) {
    bf16x8 A2[2]; load_chunk(U, row0, g, dir, lane, A2); run_chunk_pre<WRITE_H>(P, A2, dir, lane, sre, sim, Hbuf);
}
}

__device__ __forceinline__ void s1_phase(Frame& F, int ei) {
    const int gw = F.vcu * NWAVES + F.wave, NGW = F.G * NWAVES;
    const bf16* U = WSP(bf16, WS_BIG); float2* SE = WSP(float2, WS_SE);
    int cur = -1; s5::Par P;
    constexpr int NTASK = 2 * S5G * BATCH * NTC;
    for (int task = gw; task < NTASK; task += 2 * NGW) {
        const int dg = task % 128, idx = task / 128, dir = dg >> 6, g = dg & 63, b = idx / NTC, tc = idx % NTC;
        const int task2 = task + NGW; const bool has2 = task2 < NTASK; const int idx2 = has2 ? task2 / 128 : idx, b2 = idx2 / NTC, tc2 = idx2 % NTC;
        bf16x8 Aa[2], Ab[2];
        s5::load_chunk(U, s5::chunk_row0(b, tc), g, dir, F.lane, Aa); s5::load_chunk(U, s5::chunk_row0(b2, tc2), g, dir, F.lane, Ab);
        if (dg != cur) { s5::load_par(F.A, ei, dir, g, F.lane, P); cur = dg;
            if (idx == 0) { bf16x8 C[4]; s5::cfrags(F.A, ei, dir, g, F.lane, C); s5::table_store(F.ws + WS_MODP, dg, F.lane, P, C); } }
        { float sre = 0.f, sim = 0.f;
          s5::run_chunk_pre<false>(P, Aa, dir, F.lane, sre, sim, nullptr);
          SE[(((size_t)(b * 2 + dir) * S5G + g) * NTC + tc) * S5P + F.lane] = make_float2(sre, sim); }
        if (has2) { float sre = 0.f, sim = 0.f;
          s5::run_chunk_pre<false>(P, Ab, dir, F.lane, sre, sim, nullptr);
          SE[(((size_t)(b2 * 2 + dir) * S5G + g) * NTC + tc2) * S5P + F.lane] = make_float2(sre, sim); }
    }
    bf16* MIXA = WSP(bf16, WS_MIXA);
    const float* cw = F.A.in[22] + (size_t)ei * 3 * S5W; const float* cb = F.A.in[23] + (size_t)ei * S5W;
    const int c0 = F.lane * 16;
    f32x4 w0[4], w1[4], w2[4], wb4[4];
#pragma unroll
    for (int q = 0; q < 4; ++q) { w0[q] = *(const f32x4*)(cw + c0 + 4 * q); w1[q] = *(const f32x4*)(cw + S5W + c0 + 4 * q); w2[q] = *(const f32x4*)(cw + 2 * S5W + c0 + 4 * q); wb4[q] = *(const f32x4*)(cb + c0 + 4 * q); }
    for (int row = gw; row < TT; row += NGW) {
        const int t = row < TLAT ? (row & (SEQ - 1)) : ((row - TLAT) & (CTXL - 1)), len = row < TLAT ? SEQ : CTXL;
        const bool hp = t > 0, hn = t < len - 1;
        const bf16* pr = U + (size_t)row * MIXIN;
        v4u bgv[2], cg0v[2], v0v[2], cg1v[2], v1v[2], cg2v[2], v2v[2];
#pragma unroll
        for (int hh = 0; hh < 2; ++hh) { const int c = c0 + 8 * hh;
            bgv[hh] = *(const v4u*)(pr + 1024 + c); cg1v[hh] = *(const v4u*)(pr + 2048 + c); v1v[hh] = *(const v4u*)(pr + 3072 + c);
            cg0v[hh] = (v4u){0, 0, 0, 0}; v0v[hh] = cg0v[hh]; cg2v[hh] = cg0v[hh]; v2v[hh] = cg0v[hh];
            if (hp) { cg0v[hh] = *(const v4u*)(pr - MIXIN + 2048 + c); v0v[hh] = *(const v4u*)(pr - MIXIN + 3072 + c); }
            if (hn) { cg2v[hh] = *(const v4u*)(pr + MIXIN + 2048 + c); v2v[hh] = *(const v4u*)(pr + MIXIN + 3072 + c); } }
#pragma unroll
        for (int hh = 0; hh < 2; ++hh) { const int c = c0 + 8 * hh;
            const v4u bg = bgv[hh], cg0 = cg0v[hh], v0 = v0v[hh], cg1 = cg1v[hh], v1 = v1v[hh], cg2 = cg2v[hh], v2 = v2v[hh];
            float o[8];
#pragma unroll
            for (int e = 0; e < 4; ++e) { const unsigned wb = bg[e], a0 = cg0[e], b0 = v0[e], a1 = cg1[e], b1 = v1[e], a2 = cg2[e], b2 = v2[e]; const int q = 2 * hh + (e >> 1), z = 2 * (e & 1);
                o[2 * e] = bflo(wb) * (w0[q][z] * (bflo(a0) * bflo(b0)) + w1[q][z] * (bflo(a1) * bflo(b1)) + w2[q][z] * (bflo(a2) * bflo(b2)) + wb4[q][z]);
                o[2 * e + 1] = bfhi(wb) * (w0[q][z + 1] * (bfhi(a0) * bfhi(b0)) + w1[q][z + 1] * (bfhi(a1) * bfhi(b1)) + w2[q][z + 1] * (bfhi(a2) * bfhi(b2)) + wb4[q][z + 1]); }
            v4u w; w.x = pk2(o[0], o[1]); w.y = pk2(o[2], o[3]); w.z = pk2(o[4], o[5]); w.w = pk2(o[6], o[7]);
            *(v4u*)(MIXA + (size_t)row * DM + S5W + c) = w; }
    }
}
__device__ __forceinline__ void s2_phase(Frame& F, int ei) {
    if (F.wave != 0) return;
    const float2* SE = WSP(float2, WS_SE); float2* SC = WSP(float2, WS_SC);
    for (int combo = blockIdx.x; combo < BATCH * 2 * S5G; combo += F.G) {
        const int b = combo >> 7, dir = (combo >> 6) & 1, g = combo & 63, base = (ei * 2 + dir) * S5G + g;
        float ar, ai, cr, ci; s5::discretize(F.A.in[12][base * S5P + F.lane], F.A.in[13][base * S5P + F.lane], expf(F.A.in[14][base]), ar, ai, cr, ci);
#pragma unroll
        for (int q = 0; q < 6; ++q) { const float nr = ar * ar - ai * ai, ni = 2.0f * ar * ai; ar = nr; ai = ni; }
        const size_t off = ((size_t)(b * 2 + dir) * S5G + g) * NTC * S5P + F.lane;
        float sre = 0.f, sim = 0.f; asm volatile("" : "+v"(sre), "+v"(sim));
        for (int k0 = 0; k0 < NTC; k0 += 12) {
            float2 e[12];
#pragma unroll
            for (int q = 0; q < 12; ++q) { const int k = k0 + q; const int tc = dir ? (NTC - 1 - k) : (k < 4 ? 128 + k : k - 4); e[q] = SE[off + (size_t)tc * S5P]; }
#pragma unroll
            for (int q = 0; q < 12; ++q) { const int k = k0 + q; const int tc = dir ? (NTC - 1 - k) : (k < 4 ? 128 + k : k - 4);
                SC[off + (size_t)tc * S5P] = make_float2(sre, sim);
                const float nr = ar * sre - ai * sim + e[q].x, ni = ar * sim + ai * sre + e[q].y; sre = nr; sim = ni; }
        }
    }
}
__device__ __forceinline__ float gelu_tanh(float x) { const float p = fmaf(-0.10294324f, x * x, -2.3022082f); return x * __builtin_amdgcn_rcpf(1.0f + __builtin_amdgcn_exp2f(x * p)); }
__device__ __forceinline__ void s3_phase(Frame& F, int ei) {
    const int gw = F.vcu * NWAVES + F.wave, NGW = F.G * NWAVES;
    const bf16* U = WSP(bf16, WS_BIG); const float2* SC = WSP(float2, WS_SC); bf16* Z = WSP(bf16, WS_Z);
    const unsigned char* tab = F.ws + WS_MODP;
    LAS unsigned* Hbuf = (LAS unsigned*)(F.lds + F.wave * (64 * 68 * 4));
    LAS float* Ybuf = (LAS float*)Hbuf;
    const int fr = F.lane & 15, kq = F.lane >> 4;
    constexpr int NTASK = S5G * BATCH * NTC;
    s5::Par Pd[2]; bf16x8 Cd[2][4];
#pragma unroll
    for (int dir = 0; dir < 2; ++dir) s5::table_load(tab, dir * S5G + (gw % S5G), F.lane, Pd[dir], Cd[dir]);
    for (int task = gw; task < NTASK; task += NGW) {
        const int g = task % S5G, idx = task / S5G, b = idx / NTC, tc = idx % NTC;
        const int row0 = s5::chunk_row0(b, tc);
        f32x4 yacc[4] = {{0, 0, 0, 0}, {0, 0, 0, 0}, {0, 0, 0, 0}, {0, 0, 0, 0}};
        bf16x8 Ad[2][2]; s5::load_chunk(U, row0, g, 0, F.lane, Ad[0]); s5::load_chunk(U, row0, g, 1, F.lane, Ad[1]);
        float2 cin[2];
#pragma unroll
        for (int dir = 0; dir < 2; ++dir) cin[dir] = SC[(((size_t)(b * 2 + dir) * S5G + g) * NTC + tc) * S5P + F.lane];
        const v4u u0 = *(const v4u*)(U + (size_t)(row0 + F.lane) * MIXIN + g * S5H), u1 = *(const v4u*)(U + (size_t)(row0 + F.lane) * MIXIN + g * S5H + 8);
#pragma unroll
        for (int dir = 0; dir < 2; ++dir) {
            const s5::Par& P = Pd[dir]; const bf16x8 (&C)[4] = Cd[dir];
            float sre = cin[dir].x, sim = cin[dir].y;
            s5::run_chunk_pre<true>(P, Ad[dir], dir, F.lane, sre, sim, Hbuf);
            asm volatile("" ::: "memory");
#pragma unroll
            for (int tb = 0; tb < 4; ++tb)
#pragma unroll
                for (int ks = 0; ks < 4; ++ks) { const bf16x8 a = *(const LAS bf16x8*)(Hbuf + (16 * tb + fr) * 68 + 16 * ks + 4 * kq);
                    yacc[tb] = __builtin_amdgcn_mfma_f32_16x16x32_bf16(a, C[ks], yacc[tb], 0, 0, 0); }
            asm volatile("" ::: "memory");
        }
#pragma unroll
        for (int tb = 0; tb < 4; ++tb)
#pragma unroll
            for (int e = 0; e < 4; ++e) Ybuf[(16 * tb + 4 * kq + e) * 20 + fr] = yacc[tb][e];
        asm volatile("" ::: "memory");
        { const size_t row = (size_t)(row0 + F.lane);
          const float* dp = F.A.in[19] + ei * S5W + g * S5H;
          float z[16];
#pragma unroll
          for (int q = 0; q < 4; ++q) { const f32x4 y = *(const LAS f32x4*)(Ybuf + F.lane * 20 + 4 * q); const f32x4 d = *(const f32x4*)(dp + 4 * q);
              const unsigned w0 = q < 2 ? u0[2 * q] : u1[2 * q - 4], w1 = q < 2 ? u0[2 * q + 1] : u1[2 * q - 3];
              z[4 * q] = gelu_tanh(y[0] + d[0] * bflo(w0)); z[4 * q + 1] = gelu_tanh(y[1] + d[1] * bfhi(w0)); z[4 * q + 2] = gelu_tanh(y[2] + d[2] * bflo(w1)); z[4 * q + 3] = gelu_tanh(y[3] + d[3] * bfhi(w1)); }
          v4u o0, o1; o0.x = pk2(z[0], z[1]); o0.y = pk2(z[2], z[3]); o0.z = pk2(z[4], z[5]); o0.w = pk2(z[6], z[7]); o1.x = pk2(z[8], z[9]); o1.y = pk2(z[10], z[11]); o1.z = pk2(z[12], z[13]); o1.w = pk2(z[14], z[15]);
          *(v4u*)(Z + row * S5W + g * S5H) = o0; *(v4u*)(Z + row * S5W + g * S5H + 8) = o1; }
        asm volatile("" ::: "memory");
    }
}

__device__ __forceinline__ void attn_combine_block(Frame& F, const bf16* OC, bf16* AO, int row0, int h, int oi, float lam_init) {
    const int e0 = (F.lane & 15) * 8, sub = F.lane >> 4;
    const float* lv = F.A.in[26] + (size_t)oi * 4 * 64;
    const float lam = expf(wave_sum(lv[F.lane] * lv[64 + F.lane])) - expf(wave_sum(lv[128 + F.lane] * lv[192 + F.lane])) + lam_init;
    float g[8];
    { const float* sl = F.A.in[27] + (size_t)oi * 128 + e0;
#pragma unroll
      for (int e = 0; e < 8; ++e) g[e] = sl[e] * (1.0f - lam_init); }
#pragma unroll 2
    for (int it = 0; it < 8; ++it) { const size_t row = (size_t)(row0 + it * 32 + F.wave * 4 + sub);
        const v4u a = *(const v4u*)(OC + row * 4096 + h * 256 + e0), bq = *(const v4u*)(OC + row * 4096 + h * 256 + 128 + e0);
        float d[8]; float ss = 0.f;
#pragma unroll
        for (int e = 0; e < 4; ++e) { d[2 * e] = bflo(a[e]) - lam * bflo(bq[e]); d[2 * e + 1] = bfhi(a[e]) - lam * bfhi(bq[e]); ss += d[2 * e] * d[2 * e] + d[2 * e + 1] * d[2 * e + 1]; }
        ss += __shfl_xor(ss, 1); ss += __shfl_xor(ss, 2); ss += __shfl_xor(ss, 4); ss += __shfl_xor(ss, 8);
        const float r = rsqrtf(ss * (1.0f / 128.0f) + EPS);
        v4u w; w.x = pk2(d[0] * r * g[0], d[1] * r * g[1]); w.y = pk2(d[2] * r * g[2], d[3] * r * g[3]); w.z = pk2(d[4] * r * g[4], d[5] * r * g[5]); w.w = pk2(d[6] * r * g[6], d[7] * r * g[7]);
        *(v4u*)(AO + row * DM + h * 128 + e0) = w; }
}
__device__ __forceinline__ void attn_phase(Frame& F, int oi, float lam_init, bool ctx_queries) {
    const bf16* QKV = WSP(bf16, WS_BIG); bf16* OC = WSP(bf16, WS_OC); bf16* AO = WSP(bf16, WS_MIXA);
    char* lds = (char*)F.lds;
    const int npairs = BATCH * 16 * 32 + (ctx_queries ? BATCH * 16 : 0);
    for (int pair = F.vcu; pair < npairs; pair += F.G) {
        int qrow0, h, lat0, nlat, ctx0, NT;
        if (pair < BATCH * 16 * 32) { const int qb = pair & 31, hb = pair >> 5, b = hb >> 4; h = hb & 15;
            qrow0 = b * SEQ + qb * 256; lat0 = b * SEQ; nlat = 128; ctx0 = TLAT + b * CTXL; NT = 132; }
        else { const int hb = pair - BATCH * 16 * 32, b = hb >> 4; h = hb & 15;
            qrow0 = TLAT + b * CTXL; lat0 = 0; nlat = 0; ctx0 = TLAT + b * CTXL; NT = 4; }
#pragma unroll 1
        for (int c = 0; c < 2; ++c)
            att::attn_unit(QKV, OC, qrow0, h * 128 + c * 64, DM + h * 128 + c * 64, 2 * DM + h * 128, h * 256 + c * 128, lat0, nlat, ctx0, NT, lds, F.tid);
        attn_combine_block(F, OC, AO, qrow0, h, oi, lam_init);
    }
}
__global__ void __launch_bounds__(NWAVES * 64, 2) mk_fwd(Args args) {
    extern __shared__ __attribute__((aligned(16))) unsigned char lds[];
    Frame F{args};
    F.lds = (LAS unsigned char*)lds;
    F.tid = threadIdx.x; F.lane = F.tid & 63; F.wave = __builtin_amdgcn_readfirstlane(F.tid >> 6);
    F.G = gridDim.x; { const int bx = blockIdx.x; F.vcu = (F.G % 8 == 0) ? (bx % 8) * (F.G / 8) + bx / 8 : bx; }
    F.ws = args.ws; F.out = args.out;
    volatile LAS unsigned* MISC = (volatile LAS unsigned*)(F.lds + MISC_OFF);
    for (int u = F.tid; u < (LDS_BYTES - LDSCTL_OFF) / 4; u += NWAVES * 64) ((LAS unsigned*)(F.lds + LDSCTL_OFF))[u] = 0u;
    __syncthreads();
    const int lo = args.ph_lo, hi = args.ph_hi;
    XcdBarrier bar; bar.bar = (unsigned*)(F.ws + WS_CTL) + CW_BAR; bar.x = 0; bar.st = nullptr;
    if (hi - lo > 1) bar = xcd_barrier_post((unsigned*)(F.ws + WS_CTL) + CW_BAR, MISC + 8);
    int ph = 0;
#define PH_BEGIN if (ph >= lo && ph < hi) { { int t_ = threadIdx.x; asm volatile("" : "+v"(t_)); F.tid = t_; F.lane = t_ & 63; F.wave = __builtin_amdgcn_readfirstlane(t_ >> 6); \
        GAS unsigned char* w_ = (GAS unsigned char*)args.ws; asm volatile("" : "+s"(w_)); F.ws = (unsigned char*)w_; }
#define PH_END   if (ph + 1 < hi) xcd_barrier(bar); } ++ph;

    PH_BEGIN p0_prologue(F); PH_END
    PH_BEGIN p1_ada_reduce(F); PH_END
    PH_BEGIN resid_norm_phase(F, -1); PH_END

    for (int sub = 0; sub < NSUB; ++sub) {
        const int layer = sub / 3, s = sub % 3;
        const bool mix_ctx = layer < DEPTH - 1;
        const bool need_ctx = mix_ctx || s == 0;
        if (s != 1) {
            const int lh = layer * 2 + (s >> 1);
            constexpr int NCG = 2 * (2 * FF / 256), NCS = (TCTX / 256) * (DM / 256) * NZ_DOWN;
            unsigned* hcnt = (unsigned*)(F.ws + WS_CTL) + CW_HOST + 64 * sub;
            for (int part = 0; part < 2; ++part) {
                PH_BEGIN
                    const bool cg = need_ctx && (int)blockIdx.x < NCG;
                    if (part == 0 || cg) {
                        pg8::Gemm g{WSP(const pg8::bf16_t, WS_H), WSP(const pg8::bf16_t, WS_WGU + lh * WGU_ONE), TT, 2 * FF, DM, DM}; pg8::StaticOrder S;
                        if (part == 0) S.init(TLAT, 2 * FF, F.G, (int)blockIdx.x, 0, 8); else S.init(TCTX, 2 * FF, NCG, (int)blockIdx.x, TLAT / 256);
                        pg8::EpiSwiGLU E{WSP(pg8::bf16_t, WS_BIG), FF};
                        pg8::gemm_phase<pg8::EpiSwiGLU, pg8::StaticOrder, true, true>(F.lds, g, S, E);
                    }
                    if (part == 1) {
                        if (cg) host_arrive(hcnt);
                        pg8::Gemm g{WSP(const pg8::bf16_t, WS_BIG), WSP(const pg8::bf16_t, WS_WD + lh * WD_ONE), TLAT, DM, FF, FF}; pg8::StaticOrder S; S.init(TLAT, DM, F.G, (int)blockIdx.x);
                        pg8::EpiPlain E{WSP(pg8::bf16_t, WS_Y), DM};
                        pg8::gemm_phase<pg8::EpiPlain, pg8::StaticOrder, true, true>(F.lds, g, S, E);
                        const int cs = (int)blockIdx.x - NCG;
                        if (need_ctx && cs >= 0 && cs < NCS) {
                            host_wait(hcnt, (unsigned)NCG);
                            pg8::Gemm g2{WSP(const pg8::bf16_t, WS_BIG), WSP(const pg8::bf16_t, WS_WD + lh * WD_ONE), TT, DM, FF / NZ_DOWN, FF}; pg8::SplitOrder S2; S2.init(TLAT / 256, TCTX / 256, DM, NZ_DOWN, NCS, cs);
                            pg8::EpiPartial E2{WSP(float, WS_PART), DM, TLAT, (size_t)TCTX * DM};
                            pg8::gemm_phase<pg8::EpiPartial, pg8::SplitOrder, true, true>(F.lds, g2, S2, E2);
                        }
                    }
                PH_END
            }
        } else if ((layer & 1) == 0) {
            const int ei = layer >> 1;
            PH_BEGIN
                pg8::Gemm g{WSP(const pg8::bf16_t, WS_H), WSP(const pg8::bf16_t, WS_WIN + (size_t)ei * MIXIN * DM * 2), TT, MIXIN, DM, DM}; pg8::StaticOrder S; S.init(TT, MIXIN, F.G, (int)blockIdx.x);
                pg8::EpiPlain E{WSP(pg8::bf16_t, WS_BIG), MIXIN};
                pg8::gemm_phase<pg8::EpiPlain, pg8::StaticOrder, true, true>(F.lds, g, S, E);
            PH_END
            PH_BEGIN s1_phase(F, ei); PH_END
            PH_BEGIN s2_phase(F, ei); PH_END
            PH_BEGIN s3_phase(F, ei); PH_END
            PH_BEGIN
                pg8::Gemm g{WSP(const pg8::bf16_t, WS_Z), WSP(const pg8::bf16_t, WS_WGLU + (size_t)ei * S5W * S5W * 2), TT, S5W, S5W, S5W}; pg8::StaticOrder S; S.init(TT, S5W, F.G, (int)blockIdx.x);
                pg8::EpiGLU E{WSP(const pg8::bf16_t, WS_Z), S5W, F.A.in[21] + (size_t)ei * S5W, WSP(pg8::bf16_t, WS_MIXA), DM};
                pg8::gemm_phase<pg8::EpiGLU, pg8::StaticOrder, true, true>(F.lds, g, S, E);
            PH_END
            PH_BEGIN
                const pg8::bf16_t* Wp = WSP(const pg8::bf16_t, WS_WOUT + (size_t)ei * DM * MIXOUT * 2);
                pg8::Gemm g{WSP(const pg8::bf16_t, WS_MIXA), Wp, TLAT, DM, MIXOUT, MIXOUT}; pg8::StaticOrder S; S.init(TLAT, DM, F.G, (int)blockIdx.x);
                pg8::EpiPlain E{WSP(pg8::bf16_t, WS_Y), DM};
                pg8::gemm_phase<pg8::EpiPlain, pg8::StaticOrder, true, true>(F.lds, g, S, E);
                pg8::Gemm g2{WSP(const pg8::bf16_t, WS_MIXA), Wp, TT, DM, MIXOUT / NZ_OUT, MIXOUT}; pg8::SplitOrder S2; S2.init(TLAT / 256, TCTX / 256, DM, NZ_OUT, F.G, (int)blockIdx.x);
                pg8::EpiPartial E2{WSP(float, WS_PART), DM, TLAT, (size_t)TCTX * DM};
                if (mix_ctx) pg8::gemm_phase<pg8::EpiPartial, pg8::SplitOrder, true, true>(F.lds, g2, S2, E2);
            PH_END
        } else {
            const int oi = layer >> 1;
            PH_BEGIN
                pg8::Gemm g{WSP(const pg8::bf16_t, WS_H), WSP(const pg8::bf16_t, WS_WQKV + (size_t)oi * 3 * DM * DM * 2), TT, 3 * DM, DM, DM}; pg8::StaticOrder S; S.init(TT, 3 * DM, F.G, (int)blockIdx.x);
                pg8::EpiQKV E{WSP(pg8::bf16_t, WS_BIG), 3 * DM, WSP(const float, WS_ROPE), 0.125f * 1.4426950408889634f};
                pg8::gemm_phase<pg8::EpiQKV, pg8::StaticOrder, true, true>(F.lds, g, S, E);
            PH_END
            PH_BEGIN attn_phase(F, oi, oi == 0 ? 0.35550906759096934f : 0.5560582041556406f, mix_ctx); PH_END
            PH_BEGIN
                const pg8::bf16_t* Wp = WSP(const pg8::bf16_t, WS_WO + (size_t)oi * DM * DM * 2);
                pg8::Gemm g{WSP(const pg8::bf16_t, WS_MIXA), Wp, TLAT, DM, DM, DM}; pg8::StaticOrder S; S.init(TLAT, DM, F.G, (int)blockIdx.x);
                pg8::EpiPlain E{WSP(pg8::bf16_t, WS_Y), DM};
                pg8::gemm_phase<pg8::EpiPlain, pg8::StaticOrder, true, true>(F.lds, g, S, E);
                pg8::Gemm g2{WSP(const pg8::bf16_t, WS_MIXA), Wp, TT, DM, DM / NZ_OUT, DM}; pg8::SplitOrder S2; S2.init(TLAT / 256, TCTX / 256, DM, NZ_OUT, F.G, (int)blockIdx.x);
                pg8::EpiPartial E2{WSP(float, WS_PART), DM, TLAT, (size_t)TCTX * DM};
                pg8::gemm_phase<pg8::EpiPartial, pg8::SplitOrder, true, true>(F.lds, g2, S2, E2);
            PH_END
        }
        PH_BEGIN resid_norm_phase(F, sub, (mix_ctx || s == 0) ? TCTX : 0); PH_END
    }
#undef PH_BEGIN
#undef PH_END
}

static int count_phases() { int n = 3; for (int sub = 0; sub < NSUB; ++sub) { const int layer = sub / 3, s = sub % 3; n += (s != 1) ? 2 : ((layer & 1) == 0 ? 6 : 3); n += 1; } return n; }
extern "C" void kernel_launch(void* const* d_in, const int* in_sizes, int n_in, void* d_out, int out_size, void* d_ws, size_t ws_size, hipStream_t stream) {
    static int grid = 0;
    if (grid == 0) {
        if (n_in != 28 || in_sizes[0] != TLAT * DM || out_size != TLAT * DM || ws_size < WS_END) { fprintf(stderr, "kernel_launch: shape mismatch: n_in %d in0 %d out %d ws %zu (need %zu)\n", n_in, n_in > 0 ? in_sizes[0] : -1, out_size, ws_size, (size_t)WS_END); grid = -1; return; }
        int dev = 0, cus = 0, per_cu = 0;
        if (hipGetDevice(&dev) != hipSuccess || hipDeviceGetAttribute(&cus, hipDeviceAttributeMultiprocessorCount, dev) != hipSuccess) { grid = -1; return; }
        if (hipFuncSetAttribute((const void*)mk_fwd, hipFuncAttributeMaxDynamicSharedMemorySize, LDS_BYTES) != hipSuccess) { fprintf(stderr, "kernel_launch: hipFuncSetAttribute failed\n"); grid = -1; return; }
        if (hipOccupancyMaxActiveBlocksPerMultiprocessor(&per_cu, (const void*)mk_fwd, NWAVES * 64, LDS_BYTES) != hipSuccess || per_cu < 1) { fprintf(stderr, "kernel_launch: occupancy query says %d\n", per_cu); }
        (void)hipGetLastError();
        grid = cus;
    }
    if (grid < 0) return;
    if (hipMemsetAsync((char*)d_ws + WS_CTL, 0, CTL_ZERO_BYTES, stream) != hipSuccess) return;
    Args a{};
    for (int i = 0; i < 28; ++i) a.in[i] = (const float*)d_in[i];
    a.out = (float*)d_out; a.ws = (unsigned char*)d_ws;
    const int nph = count_phases();
#if ONE_LAUNCH
    a.ph_lo = 0; a.ph_hi = nph;
    hipLaunchKernelGGL(mk_fwd, dim3(grid), dim3(NWAVES * 64), LDS_BYTES, stream, a);
#else
    for (int p = 0; p < nph; ++p) { a.ph_lo = p; a.ph_hi = p + 1; hipLaunchKernelGGL(mk_fwd, dim3(grid), dim3(NWAVES * 64), LDS_BYTES, stream, a); }
#endif
    const hipError_t le = hipPeekAtLastError();
    if (le != hipSuccess) fprintf(stderr, "kernel_launch: launch failed: %s\n", hipGetErrorName(le));
}
```
